# Optimizing an MI355X kernel written in HIP

```python
import jax, jax.numpy as jnp
from jax import lax
import numpy as np

D_MODEL = 1024
BATCH = 8
SEQ = 2048
DEPTH = 1
DEC_BATCH = 128
DEC_SEQ = 1
PAST_LEN = 8192
PAGE_SIZE = 128

POOL_WINDOWS = (2, 4, 8, 16)
POOL_GROUPS = len(POOL_WINDOWS)
POOL_GROUP_WIDTH = 128
POOL_WIDTH = POOL_GROUPS * POOL_GROUP_WIDTH
POOL_BUF = max(POOL_WINDOWS) - 1
N_HEADS = 8
N_KV_HEADS = 2
HEAD_DIM = 64
GROUP = N_HEADS // N_KV_HEADS
Q_WIDTH = N_HEADS * HEAD_DIM
KV_WIDTH = N_KV_HEADS * HEAD_DIM
WINDOW = 128
BLOCK = WINDOW
D_FF = ((8 * D_MODEL + 3 * 256 - 1) // (3 * 256)) * 256
IN_WIDTH = POOL_WIDTH + Q_WIDTH + 2 * KV_WIDTH + 2 * D_MODEL
EPS = 1e-6
NEG = -1e30

kernel_name = "gated_pool_swa_hybrid_step"


def rms_norm(x, g):
    xf = x.astype(jnp.float32)
    y = xf * lax.rsqrt(jnp.mean(xf * xf, axis=-1, keepdims=True) + EPS)
    return (y * g.astype(jnp.float32)).astype(x.dtype)


def split_in(h, w_in, q_norm, k_norm):
    z = h @ w_in
    idx = np.cumsum([POOL_WIDTH, Q_WIDTH, KV_WIDTH, KV_WIDTH, D_MODEL]).tolist()
    u, q, k, v, ga, gb = jnp.split(z, idx, axis=-1)
    lead = z.shape[:-1]
    q = rms_norm(q.reshape(*lead, N_HEADS, HEAD_DIM), q_norm)
    k = rms_norm(k.reshape(*lead, N_KV_HEADS, HEAD_DIM), k_norm)
    v = v.reshape(*lead, N_KV_HEADS, HEAD_DIM)
    return u, q, k, v, ga, gb


def pool_mix(u_ext, pos, mix_w, scale):
    n, _, c = u_ext.shape
    t = pos.shape[0]
    uf = u_ext.astype(jnp.float32)
    cs = jnp.concatenate([jnp.zeros((n, 1, c), jnp.float32), jnp.cumsum(uf, axis=1)], axis=1)
    end = cs[:, POOL_BUF + 1:]
    u_new = uf[:, POOL_BUF:]
    outs = []
    for g, w in enumerate(POOL_WINDOWS):
        sl = slice(g * POOL_GROUP_WIDTH, (g + 1) * POOL_GROUP_WIDTH)
        start = cs[:, POOL_BUF + 1 - w: POOL_BUF + 1 - w + t, sl]
        cnt = jnp.minimum(pos + 1, w).astype(jnp.float32)[None, :, None]
        outs.append((end[..., sl] - start) / cnt - u_new[..., sl])
    y = jnp.stack(outs, axis=2).astype(u_ext.dtype)
    y = jnp.einsum("ntgc,gcd->ntgd", y, mix_w).reshape(n, t, POOL_WIDTH)
    return y * scale


def sink_attention(q, k, v, mask, sinks):
    n, tq = q.shape[:2]
    qg = q.reshape(n, tq, N_KV_HEADS, GROUP, HEAD_DIM)
    s = jnp.einsum("nqkgd,nskd->nkgqs", qg, k).astype(jnp.float32) * (HEAD_DIM ** -0.5)
    s = jnp.where(mask, s, NEG)
    sink = sinks.astype(jnp.float32).reshape(N_KV_HEADS, GROUP)[None, :, :, None, None]
    m = jnp.maximum(jnp.max(s, axis=-1, keepdims=True), sink)
    p = jnp.exp(s - m)
    denom = jnp.sum(p, axis=-1, keepdims=True) + jnp.exp(sink - m)
    o = jnp.einsum("nkgqs,nskd->nqkgd", (p / denom).astype(v.dtype), v)
    return o.reshape(n, tq, Q_WIDTH)


def merge_branches(y_pool, y_attn, ga, gb, w_pool_proj, w_attn_proj, w_out):
    merged = jax.nn.sigmoid(ga) * (y_pool @ w_pool_proj) + jax.nn.sigmoid(gb) * (y_attn @ w_attn_proj)
    return merged @ w_out


def swiglu(h, w_gate, w_up, w_down):
    return (jax.nn.silu(h @ w_gate) * (h @ w_up)) @ w_down


def prompt_layer(x, w_buf, norm1, w_in, q_norm, k_norm, sinks, pool_mix_w, pool_scale,
                 w_pool_proj, w_attn_proj, w_out, norm2, w_gate, w_up, w_down):
    b, s, _ = x.shape
    h = rms_norm(x, norm1)
    u, q, k, v, ga, gb = split_in(h, w_in, q_norm, k_norm)
    pos = jnp.arange(s)
    u_ext = jnp.concatenate([jnp.zeros((b, POOL_BUF, POOL_WIDTH), u.dtype), u], axis=1)
    y_pool = pool_mix(u_ext, pos, pool_mix_w, pool_scale)
    nb = s // BLOCK
    qb = q.reshape(b * nb, BLOCK, N_HEADS, HEAD_DIM)

    def band(a):
        ab = a.reshape(b, nb, BLOCK, N_KV_HEADS, HEAD_DIM)
        prev = jnp.concatenate([jnp.zeros_like(ab[:, :1]), ab[:, :-1]], axis=1)
        return jnp.concatenate([prev, ab], axis=2).reshape(b * nb, 2 * BLOCK, N_KV_HEADS, HEAD_DIM)

    kk, vv = band(k), band(v)
    blk = jnp.arange(nb)[:, None]
    qpos = blk * BLOCK + jnp.arange(BLOCK)[None, :]
    kpos = (blk - 1) * BLOCK + jnp.arange(2 * BLOCK)[None, :]
    d = qpos[:, :, None] - kpos[:, None, :]
    mask = (kpos[:, None, :] >= 0) & (d >= 0) & (d <= WINDOW)
    mask = jnp.broadcast_to(mask[None], (b, nb, BLOCK, 2 * BLOCK)).reshape(b * nb, 1, 1, BLOCK, 2 * BLOCK)
    y_attn = sink_attention(qb, kk, vv, mask, sinks).reshape(b, s, Q_WIDTH)
    x = x + merge_branches(y_pool, y_attn, ga, gb, w_pool_proj, w_attn_proj, w_out)
    x = x + swiglu(rms_norm(x, norm2), w_gate, w_up, w_down)
    return x, k[:, s - w_buf:], v[:, s - w_buf:], u[:, s - POOL_BUF:]


def sample_layer(x, cache_k, cache_v, state_pool, norm1, w_in, q_norm, k_norm, sinks, pool_mix_w,
                 pool_scale, w_pool_proj, w_attn_proj, w_out, norm2, w_gate, w_up, w_down):
    _, t, _ = x.shape
    w_buf = cache_k.shape[1]
    h = rms_norm(x, norm1)
    u, q, k, v, ga, gb = split_in(h, w_in, q_norm, k_norm)
    pos = PAST_LEN + jnp.arange(t)
    u_ext = jnp.concatenate([state_pool, u], axis=1)
    y_pool = pool_mix(u_ext, pos, pool_mix_w, pool_scale)
    kk = jnp.concatenate([cache_k, k], axis=1)
    vv = jnp.concatenate([cache_v, v], axis=1)
    kpos = jnp.concatenate([PAST_LEN - w_buf + jnp.arange(w_buf), pos])
    d = pos[:, None] - kpos[None, :]
    mask = ((d >= 0) & (d <= WINDOW))[None, None, None]
    y_attn = sink_attention(q, kk, vv, mask, sinks)
    x = x + merge_branches(y_pool, y_attn, ga, gb, w_pool_proj, w_attn_proj, w_out)
    x = x + swiglu(rms_norm(x, norm2), w_gate, w_up, w_down)
    return x, kk[:, -w_buf:], vv[:, -w_buf:], u_ext[:, -POOL_BUF:]


def setup_inputs(seed: int = 0) -> dict:
    key = jax.random.key(seed)
    ks = jax.random.split(key, 20)
    w_buf = min(WINDOW, PAST_LEN)
    f32 = jnp.float32

    def nrm(k, shape, scale):
        return jax.random.normal(k, shape, f32) * scale

    return {
        "x_prompt": nrm(ks[0], (BATCH, SEQ, D_MODEL), 1.0),
        "x_sample": nrm(ks[1], (DEC_BATCH, DEC_SEQ, D_MODEL), 1.0),
        "cache_k": nrm(ks[2], (DEPTH, DEC_BATCH, w_buf, N_KV_HEADS, HEAD_DIM), 1.0),
        "cache_v": nrm(ks[3], (DEPTH, DEC_BATCH, w_buf, N_KV_HEADS, HEAD_DIM), 1.0),
        "state_pool": nrm(ks[4], (DEPTH, DEC_BATCH, POOL_BUF, POOL_WIDTH), 1.0),
        "norm1": 1.0 + nrm(ks[5], (DEPTH, D_MODEL), 0.05),
        "w_in": nrm(ks[6], (DEPTH, D_MODEL, IN_WIDTH), D_MODEL ** -0.5),
        "q_norm": 1.0 + nrm(ks[7], (DEPTH, HEAD_DIM), 0.05),
        "k_norm": 1.0 + nrm(ks[8], (DEPTH, HEAD_DIM), 0.05),
        "sinks": nrm(ks[9], (DEPTH, N_HEADS), 0.5),
        "pool_mix_w": nrm(ks[10], (DEPTH, POOL_GROUPS, POOL_GROUP_WIDTH, POOL_GROUP_WIDTH), POOL_GROUP_WIDTH ** -0.5),
        "pool_scale": 1.0 + nrm(ks[11], (DEPTH, POOL_WIDTH), 0.1),
        "w_pool_proj": nrm(ks[12], (DEPTH, POOL_WIDTH, D_MODEL), POOL_WIDTH ** -0.5),
        "w_attn_proj": nrm(ks[13], (DEPTH, Q_WIDTH, D_MODEL), Q_WIDTH ** -0.5),
        "w_out": nrm(ks[14], (DEPTH, D_MODEL, D_MODEL), D_MODEL ** -0.5),
        "norm2": 1.0 + nrm(ks[15], (DEPTH, D_MODEL), 0.05),
        "w_gate": nrm(ks[16], (DEPTH, D_MODEL, D_FF), D_MODEL ** -0.5),
        "w_up": nrm(ks[17], (DEPTH, D_MODEL, D_FF), D_MODEL ** -0.5),
        "w_down": nrm(ks[18], (DEPTH, D_FF, D_MODEL), D_FF ** -0.5),
    }


def reference(x_prompt, x_sample, cache_k, cache_v, state_pool, norm1, w_in, q_norm, k_norm, sinks,
              pool_mix_w, pool_scale, w_pool_proj, w_attn_proj, w_out, norm2, w_gate, w_up, w_down):
    w_buf = cache_k.shape[2]
    xp, xs = x_prompt, x_sample
    kp, vp, pp, ksn, vsn, psn = [], [], [], [], [], []
    for l in range(DEPTH):
        shared = (norm1[l], w_in[l], q_norm[l], k_norm[l], sinks[l], pool_mix_w[l], pool_scale[l],
                  w_pool_proj[l], w_attn_proj[l], w_out[l], norm2[l], w_gate[l], w_up[l], w_down[l])
        xp, k_l, v_l, p_l = prompt_layer(xp, w_buf, *shared)
        xs, ks_l, vs_l, ps_l = sample_layer(xs, cache_k[l], cache_v[l], state_pool[l], *shared)
        kp.append(k_l); vp.append(v_l); pp.append(p_l)
        ksn.append(ks_l); vsn.append(vs_l); psn.append(ps_l)
    return (xp, xs, jnp.stack(kp), jnp.stack(vp), jnp.stack(pp), jnp.stack(ksn), jnp.stack(vsn), jnp.stack(psn))
```

```cpp
#include <hip/hip_runtime.h>
#include <hip/hip_cooperative_groups.h>
#include <cstdio>
#include <cstdint>
namespace cg = cooperative_groups;

#define LAS __attribute__((address_space(3)))
typedef unsigned short bf16_t;
typedef short bf16x8 __attribute__((ext_vector_type(8)));
typedef short s16x4 __attribute__((ext_vector_type(4)));
typedef float f32x4 __attribute__((ext_vector_type(4)));
typedef float f32x16 __attribute__((ext_vector_type(16)));
typedef unsigned u32x4 __attribute__((ext_vector_type(4)));
typedef unsigned u32x2 __attribute__((ext_vector_type(2)));

constexpr int D = 1024, SEQ = 2048, NB = 8, MP = NB * SEQ, NS = 128, MV = MP + NS, MPAD = 16640;
constexpr int INW = 3328, FF = 2816, PW = 512;
constexpr int ZC_Q = 512, ZC_K = 1024, ZC_V = 1152, ZC_GA = 1280, ZC_GB = 2304;
constexpr float EPS = 1e-6f;
constexpr float LOG2E = 1.4426950408889634f;
constexpr float C2 = 0.125f * LOG2E;
constexpr size_t O_Y = 0, O_KP = 16908288, O_VP = 17039360, O_PP = 17170432, O_KS = 17231872, O_VS = 19329024, O_PS = 21426176;
constexpr size_t MiB = 1u << 20;
constexpr size_t WS_SUMSQ = 0;
constexpr size_t WS_WIN = 2 * MiB, WS_MIX = 9 * MiB, WS_WCAT = 10 * MiB, WS_WOUT = 12 * MiB, WS_WGU = 14 * MiB, WS_WDN = 25 * MiB;
constexpr size_t WS_RA = 32 * MiB;
constexpr size_t WS_RB = 65 * MiB;
constexpr size_t WS_YPRE = 98 * MiB;
constexpr size_t WS_Z = 115 * MiB;
constexpr size_t WS_END = 222 * MiB;
constexpr int LDS_BYTES = 147456;

__device__ __forceinline__ unsigned cvt_pk_bf16(float lo, float hi) { unsigned r; asm("v_cvt_pk_bf16_f32 %0, %1, %2" : "=v"(r) : "v"(lo), "v"(hi)); return r; }
__device__ __forceinline__ float bflo(unsigned u) { return __uint_as_float(u << 16); }
__device__ __forceinline__ float bfhi(unsigned u) { return __uint_as_float(u & 0xffff0000u); }
__device__ __forceinline__ float bf1(bf16_t u) { return __uint_as_float(((unsigned)u) << 16); }
__device__ __forceinline__ float fsigmoid(float x) { return __builtin_amdgcn_rcpf(1.0f + __builtin_amdgcn_exp2f(-x * LOG2E)); }
__device__ __forceinline__ float wave_sum(float v) {
#pragma unroll
    for (int o = 1; o < 64; o <<= 1) v += __shfl_xor(v, o);
    return v;
}
__device__ __forceinline__ float wave_max(float v) {
#pragma unroll
    for (int o = 1; o < 64; o <<= 1) v = fmaxf(v, __shfl_xor(v, o));
    return v;
}
#define LDS_WAIT() asm volatile("s_waitcnt lgkmcnt(0)" ::: "memory")

namespace pg8 {
constexpr int BM = 256, BK = 64, HALF = 128, HTB = HALF * BK * 2, STAGE_BYTES = 8 * HTB, NXCD = 8, WGM = 8;
__host__ __device__ __forceinline__ int lds_byte(int r, int c) { const int st = (r >> 4) * 2 + (c >> 5), rr = r & 15, cc = c & 31, ob = rr * 64 + cc * 2; return st * 1024 + (ob ^ (((ob >> 9) & 1) << 5)); }
__host__ __device__ __forceinline__ void stage_rc(int b, int& R, int& C) { const int st = b / 1024, sb = b % 1024, swz = sb ^ (((sb >> 9) & 1) << 5); R = (st >> 1) * 16 + swz / 64; C = (st & 1) * 32 + (swz % 64) / 2; }
__host__ __device__ __forceinline__ int perm32(int rho) { const int n = rho >> 4, i = rho & 15; return 8 * (i >> 2) + 4 * n + (i & 3); }

struct Unit { int pm, pn; };
struct Gemm { const bf16_t* A; const bf16_t* Bt; int lda, ldb, K, a_pn_bytes, midt; };

struct StaticOrder {
    int nM, nN, nwg, G, c;
    __device__ void init(int M, int N, int G_, int c_) { nM = M / BM; nN = N / BM; nwg = nM * nN; G = G_; c = c_; }
    __device__ bool next(int i, Unit& u) const {
        const long L = (long)i * G + c; if (L >= nwg) return false;
        int wgid = (int)L; { const int q = nwg / NXCD, r = nwg % NXCD, xcd = wgid % NXCD, off = wgid / NXCD; wgid = (xcd < r ? xcd * (q + 1) : r * (q + 1) + (xcd - r) * q) + off; }
        const int nig = WGM * nN, gid = wgid / nig, fm = gid * WGM, gsz = (nM - fm) < WGM ? (nM - fm) : WGM;
        u.pm = fm + ((wgid % nig) % gsz); u.pn = (wgid % nig) / gsz; return true;
    }
};

template <class Epi>
__device__ __forceinline__ void gemm_phase(LAS unsigned char* lds, const Gemm g, const StaticOrder& S, const Epi& E) {
    const int tid = threadIdx.x, wid = __builtin_amdgcn_readfirstlane(tid >> 6), lane = tid & 63, wr = wid >> 2, wc = wid & 3, fr = lane & 15, fq = lane >> 4;
    const int K = g.K, nt = K / BK;
    unsigned voffA[2], voffB[2];
#pragma unroll
    for (int i = 0; i < 2; ++i) { int R, C; stage_rc(tid * 16 + i * 8192, R, C); const int Rb = (R & ~31) + perm32(R & 31);
        voffA[i] = (unsigned)(R * g.lda + C) * 2u; voffB[i] = (unsigned)(Rb * g.ldb + C) * 2u; }
    const size_t kstep = (size_t)(BK * 2);
    const size_t hstepA = (size_t)HALF * g.lda * 2, hstepB = (size_t)HALF * g.ldb * 2;
    const size_t tstepA = 2 * hstepA, tstepB = 2 * hstepB;
    const unsigned ldsw = (unsigned)wid * 1024u;
    const int aoff = lds_byte(wr * 64 + fr, fq * 8), boff = lds_byte(wc * 32 + fr, fq * 8);
#define PG8_SA(b, h) (((b) * 2 + (h)) * HTB)
#define PG8_SB(b, h) ((4 + (b) * 2 + (h)) * HTB)
#define PG8_STAGE(bufoff, gbase, voff) do { _Pragma("unroll") for (int _i = 0; _i < 2; ++_i) \
        __builtin_amdgcn_global_load_lds((const unsigned*)((const char*)(gbase) + (voff)[_i]), (LAS unsigned*)(lds + (bufoff) + ldsw + _i * 8192), 16, 0, 0); } while (0)
#define PG8_LDA(dst, b, h) do { _Pragma("unroll") for (int m = 0; m < 4; ++m) _Pragma("unroll") for (int k = 0; k < 2; ++k) dst[m][k] = *(const LAS bf16x8*)(lds + PG8_SA(b, h) + aoff + m * 2048 + k * 1024); } while (0)
#define PG8_LDB(dst, b, h) do { _Pragma("unroll") for (int n = 0; n < 2; ++n) _Pragma("unroll") for (int k = 0; k < 2; ++k) dst[n][k] = *(const LAS bf16x8*)(lds + PG8_SB(b, h) + boff + n * 2048 + k * 1024); } while (0)
#define PG8_MMA(ai, bj, At, Bt) do { __builtin_amdgcn_s_setprio(1); _Pragma("unroll") for (int m = 0; m < 4; ++m) _Pragma("unroll") for (int n = 0; n < 2; ++n) _Pragma("unroll") for (int k = 0; k < 2; ++k) \
        acc[ai][bj][m][n] = __builtin_amdgcn_mfma_f32_16x16x32_bf16(Bt[n][k], At[m][k], acc[ai][bj][m][n], 0, 0, 0); __builtin_amdgcn_s_setprio(0); } while (0)
#define PG8_WAIT_V(n) asm volatile("s_waitcnt vmcnt(" #n ")" ::: "memory")
#define PG8_WAIT_L(n) asm volatile("s_waitcnt lgkmcnt(" #n ")" ::: "memory")
#define PG8_BAR __builtin_amdgcn_s_barrier()
#define PG8_SCHED __builtin_amdgcn_sched_barrier(0)
    Unit cur, nxt; int ui = 0;
    if (!S.next(0, cur)) return;
    f32x4 acc[2][2][4][2];
#pragma unroll
    for (int a = 0; a < 2; ++a)
#pragma unroll
        for (int b = 0; b < 2; ++b)
#pragma unroll
            for (int m = 0; m < 4; ++m)
#pragma unroll
                for (int n = 0; n < 2; ++n) acc[a][b][m][n] = (f32x4){0.f, 0.f, 0.f, 0.f};
    bf16x8 At[4][2], B0[2][2], B1[2][2];
    const char* cA = (const char*)g.A + (size_t)cur.pm * tstepA + (size_t)cur.pn * g.a_pn_bytes; const char* cB = (const char*)g.Bt + (size_t)cur.pn * tstepB;
    PG8_STAGE(PG8_SB(0, 0), cB, voffB); PG8_STAGE(PG8_SB(0, 1), cB + hstepB, voffB); PG8_STAGE(PG8_SA(0, 0), cA, voffA); PG8_STAGE(PG8_SA(0, 1), cA + hstepA, voffA);
    if (wr == 1) PG8_BAR;
    PG8_WAIT_V(2); PG8_BAR;
    PG8_STAGE(PG8_SB(1, 0), cB + kstep, voffB); PG8_STAGE(PG8_SA(1, 0), cA + kstep, voffA); PG8_STAGE(PG8_SB(1, 1), cB + hstepB + kstep, voffB);
    PG8_WAIT_V(6); PG8_BAR;
    for (;;) {
        const bool has_next = S.next(ui + 1, nxt);
        const char* nA = has_next ? (const char*)g.A + (size_t)nxt.pm * tstepA + (size_t)nxt.pn * g.a_pn_bytes : cA; const char* nB = has_next ? (const char*)g.Bt + (size_t)nxt.pn * tstepB : cB;
#pragma unroll 1
        for (int t = 0; t < nt; t += 2) {
            const bool last = (t == nt - 2);
            if constexpr (Epi::HAS_MID) { if (t == g.midt) { E.mid(acc, cur, wr, wc, fr, fq); } PG8_SCHED; }
            const char* a1 = cA + (size_t)(t + 1) * kstep;
            const char* a2 = last ? nA : cA + (size_t)(t + 2) * kstep; const char* b2 = last ? nB : cB + (size_t)(t + 2) * kstep;
            const char* a3 = a2 + kstep; const char* b3 = b2 + kstep;
            PG8_LDB(B0, 0, 0); PG8_LDB(B1, 0, 1); PG8_SCHED; PG8_LDA(At, 0, 0); PG8_STAGE(PG8_SA(1, 1), a1 + hstepA, voffA);
            PG8_WAIT_V(8); PG8_WAIT_L(0); PG8_BAR; PG8_MMA(0, 0, At, B0); PG8_MMA(0, 1, At, B1); PG8_BAR; PG8_SCHED;
            PG8_LDA(At, 0, 1); PG8_STAGE(PG8_SB(0, 0), b2, voffB); PG8_STAGE(PG8_SB(0, 1), b2 + hstepB, voffB); PG8_STAGE(PG8_SA(0, 0), a2, voffA);
            PG8_WAIT_V(8); PG8_WAIT_L(0); PG8_BAR; PG8_MMA(1, 0, At, B0); PG8_MMA(1, 1, At, B1); PG8_BAR; PG8_SCHED;
            PG8_LDB(B0, 1, 0); PG8_LDB(B1, 1, 1); PG8_SCHED; PG8_LDA(At, 1, 0); PG8_STAGE(PG8_SA(0, 1), a2 + hstepA, voffA);
            PG8_WAIT_V(8); PG8_WAIT_L(0); PG8_BAR; PG8_MMA(0, 0, At, B0); PG8_MMA(0, 1, At, B1); PG8_BAR; PG8_SCHED;
            PG8_LDA(At, 1, 1); PG8_STAGE(PG8_SB(1, 0), b3, voffB); PG8_STAGE(PG8_SB(1, 1), b3 + hstepB, voffB); PG8_STAGE(PG8_SA(1, 0), a3, voffA);
            PG8_WAIT_V(8); PG8_WAIT_L(0); PG8_BAR; PG8_MMA(1, 0, At, B0); PG8_MMA(1, 1, At, B1); PG8_BAR; PG8_SCHED;
        }
        if (wr == 0) PG8_BAR;
        E(acc, cur, wr, wc, fr, fq);
        if (!has_next) break;
#pragma unroll
        for (int a = 0; a < 2; ++a)
#pragma unroll
            for (int b = 0; b < 2; ++b)
#pragma unroll
                for (int m = 0; m < 4; ++m)
#pragma unroll
                    for (int n = 0; n < 2; ++n) acc[a][b][m][n] = (f32x4){0.f, 0.f, 0.f, 0.f};
        cur = nxt; cA = nA; cB = nB; ++ui;
        if (wr == 1) PG8_BAR;
    }
    PG8_WAIT_V(0);
    PG8_BAR;
#undef PG8_SA
#undef PG8_SB
#undef PG8_STAGE
#undef PG8_LDA
#undef PG8_LDB
#undef PG8_MMA
#undef PG8_WAIT_V
#undef PG8_WAIT_L
#undef PG8_BAR
#undef PG8_SCHED
}

typedef f32x4 Acc[2][2][4][2];
__device__ __forceinline__ u32x4 pack8(const f32x4 v0, const f32x4 v1) { u32x4 w; w.x = cvt_pk_bf16(v0[0], v0[1]); w.y = cvt_pk_bf16(v0[2], v0[3]); w.z = cvt_pk_bf16(v1[0], v1[1]); w.w = cvt_pk_bf16(v1[2], v1[3]); return w; }

struct EpiZ {
    static constexpr bool HAS_MID = false;
    bf16_t* Z;
    __device__ __forceinline__ void operator()(Acc& acc, const Unit& u, int wr, int wc, int fr, int fq) const {
        int row0 = u.pm * BM + wr * 64 + fr; asm volatile("" : "+v"(row0)); const int col0 = u.pn * BM + wc * 32 + 8 * fq; const bool sig = u.pn >= 5;
#pragma unroll
        for (int ai = 0; ai < 2; ++ai)
#pragma unroll
            for (int m = 0; m < 4; ++m) { bf16_t* rowp = Z + (size_t)(row0 + ai * HALF + m * 16) * INW + col0;
#pragma unroll
                for (int bj = 0; bj < 2; ++bj) { f32x4 v0 = acc[ai][bj][m][0], v1 = acc[ai][bj][m][1];
                    if (sig) {
#pragma unroll
                        for (int e = 0; e < 4; ++e) { v0[e] = fsigmoid(v0[e]); v1[e] = fsigmoid(v1[e]); } }
                    *(u32x4*)(rowp + bj * HALF) = pack8(v0, v1); } }
    }
};
struct EpiBf {
    static constexpr bool HAS_MID = false;
    bf16_t* O; int ldc;
    __device__ __forceinline__ void operator()(Acc& acc, const Unit& u, int wr, int wc, int fr, int fq) const {
        int row0 = u.pm * BM + wr * 64 + fr; asm volatile("" : "+v"(row0)); const int col0 = u.pn * BM + wc * 32 + 8 * fq;
#pragma unroll
        for (int ai = 0; ai < 2; ++ai)
#pragma unroll
            for (int m = 0; m < 4; ++m) { bf16_t* rowp = O + (size_t)(row0 + ai * HALF + m * 16) * ldc + col0;
#pragma unroll
                for (int bj = 0; bj < 2; ++bj) *(u32x4*)(rowp + bj * HALF) = pack8(acc[ai][bj][m][0], acc[ai][bj][m][1]); }
    }
};
struct EpiMerge {
    static constexpr bool HAS_MID = true;
    const bf16_t* Z; bf16_t* O;
    __device__ __forceinline__ void mid(Acc& acc, const Unit& u, int wr, int wc, int fr, int fq) const {
        int row0 = u.pm * BM + wr * 64 + fr; asm volatile("" : "+v"(row0)); const int col0 = u.pn * BM + wc * 32 + 8 * fq;
#pragma unroll
        for (int ai = 0; ai < 2; ++ai)
#pragma unroll
            for (int m = 0; m < 4; ++m) { const bf16_t* zr = Z + (size_t)(row0 + ai * HALF + m * 16) * INW + col0;
#pragma unroll
                for (int bj = 0; bj < 2; ++bj) { const u32x4 a = *(const u32x4*)(zr + ZC_GA + bj * HALF), b = *(const u32x4*)(zr + ZC_GB + bj * HALF);
#pragma unroll
                    for (int e = 0; e < 4; ++e) { const float r0 = bflo(a[e]) * __builtin_amdgcn_rcpf(bflo(b[e])), r1 = bfhi(a[e]) * __builtin_amdgcn_rcpf(bfhi(b[e]));
                        acc[ai][bj][m][e >> 1][(e & 1) * 2] *= r0; acc[ai][bj][m][e >> 1][(e & 1) * 2 + 1] *= r1; } }
                asm volatile("" ::: "memory"); }
    }
    __device__ __forceinline__ void operator()(Acc& acc, const Unit& u, int wr, int wc, int fr, int fq) const {
        int row0 = u.pm * BM + wr * 64 + fr; asm volatile("" : "+v"(row0)); const int col0 = u.pn * BM + wc * 32 + 8 * fq;
#pragma unroll
        for (int ai = 0; ai < 2; ++ai)
#pragma unroll
            for (int m = 0; m < 4; ++m) { const size_t row = (size_t)(row0 + ai * HALF + m * 16); const bf16_t* zr = Z + row * INW + col0; bf16_t* rowp = O + row * D + col0;
#pragma unroll
                for (int bj = 0; bj < 2; ++bj) { const u32x4 b = *(const u32x4*)(zr + ZC_GB + bj * HALF); f32x4 v0 = acc[ai][bj][m][0], v1 = acc[ai][bj][m][1];
                    v0[0] *= bflo(b[0]); v0[1] *= bfhi(b[0]); v0[2] *= bflo(b[1]); v0[3] *= bfhi(b[1]); v1[0] *= bflo(b[2]); v1[1] *= bfhi(b[2]); v1[2] *= bflo(b[3]); v1[3] *= bfhi(b[3]);
                    *(u32x4*)(rowp + bj * HALF) = pack8(v0, v1); } }
    }
};
struct EpiX1 {
    static constexpr bool HAS_MID = false;
    const float* xp; const float* xs; float* out; bf16_t* X1B; float* sumsq;
    __device__ __forceinline__ void operator()(Acc& acc, const Unit& u, int wr, int wc, int fr, int fq) const {
        int row0 = u.pm * BM + wr * 64 + fr; asm volatile("" : "+v"(row0)); const int col0 = u.pn * BM + wc * 32 + 8 * fq;
#pragma unroll
        for (int ai = 0; ai < 2; ++ai)
#pragma unroll
            for (int m = 0; m < 4; ++m) { const int row = row0 + ai * HALF + m * 16; const bool valid = row < MV;
                const float* xr = (row < MP ? xp + (size_t)row * D : xs + (size_t)(valid ? row - MP : 0) * D) + col0;
                float ss = 0.f;
#pragma unroll
                for (int bj = 0; bj < 2; ++bj) { f32x4 v0 = acc[ai][bj][m][0], v1 = acc[ai][bj][m][1];
                    if (valid) { v0 += *(const f32x4*)(xr + bj * HALF); v1 += *(const f32x4*)(xr + bj * HALF + 4);
                        *(f32x4*)(out + (size_t)row * D + col0 + bj * HALF) = v0; *(f32x4*)(out + (size_t)row * D + col0 + bj * HALF + 4) = v1; }
                    ss += (v0[0] * v0[0] + v0[1] * v0[1]) + (v0[2] * v0[2] + v0[3] * v0[3]) + (v1[0] * v1[0] + v1[1] * v1[1]) + (v1[2] * v1[2] + v1[3] * v1[3]);
                    *(u32x4*)(X1B + (size_t)row * D + col0 + bj * HALF) = pack8(v0, v1); }
                ss += __shfl_xor(ss, 16); ss += __shfl_xor(ss, 32);
                if (fq == 0) atomicAdd(sumsq + row, ss); }
    }
};
struct EpiAct {
    static constexpr bool HAS_MID = false;
    const float* sumsq; bf16_t* ACT;
    __device__ __forceinline__ void operator()(Acc& acc, const Unit& u, int wr, int wc, int fr, int fq) const {
        int row0 = u.pm * BM + wr * 64 + fr; asm volatile("" : "+v"(row0)); const int col0 = u.pn * HALF + wc * 32 + 8 * fq;
#pragma unroll
        for (int ai = 0; ai < 2; ++ai)
#pragma unroll
            for (int m = 0; m < 4; ++m) { const int row = row0 + ai * HALF + m * 16; const float rstd = __builtin_amdgcn_rsqf(sumsq[row] * (1.0f / D) + EPS);
                f32x4 o[2];
#pragma unroll
                for (int n = 0; n < 2; ++n)
#pragma unroll
                    for (int e = 0; e < 4; ++e) { const float gt = acc[ai][0][m][n][e] * rstd, up = acc[ai][1][m][n][e] * rstd; o[n][e] = gt * up * fsigmoid(gt); }
                *(u32x4*)(ACT + (size_t)row * FF + col0) = pack8(o[0], o[1]); }
    }
};
struct EpiY {
    static constexpr bool HAS_MID = false;
    float* out;
    __device__ __forceinline__ void operator()(Acc& acc, const Unit& u, int wr, int wc, int fr, int fq) const {
        int row0 = u.pm * BM + wr * 64 + fr; asm volatile("" : "+v"(row0)); const int col0 = u.pn * BM + wc * 32 + 8 * fq;
#pragma unroll
        for (int ai = 0; ai < 2; ++ai)
#pragma unroll
            for (int m = 0; m < 4; ++m) { const int row = row0 + ai * HALF + m * 16;
                if (row < MV) { float* orow = out + (size_t)row * D + col0;
#pragma unroll
                    for (int bj = 0; bj < 2; ++bj) { const f32x4 a = *(const f32x4*)(orow + bj * HALF), b = *(const f32x4*)(orow + bj * HALF + 4);
                        *(f32x4*)(orow + bj * HALF) = a + acc[ai][bj][m][0]; *(f32x4*)(orow + bj * HALF + 4) = b + acc[ai][bj][m][1]; } } }
    }
};
}

struct SrcPlain { const float* W; int N; __device__ __forceinline__ float operator()(int k, int n) const { return W[(size_t)k * N + n]; } };
struct SrcMix { const float* mix; const float* scale;
    __device__ __forceinline__ float operator()(int kk, int n) const { const int g = n >> 7, j = n & 127; return ((kk >> 7) == (g & 1)) ? mix[((size_t)g * 128 + (kk & 127)) * 128 + j] * scale[n] : 0.f; } };
struct SrcCat { const float* wp; const float* wa;
    __device__ __forceinline__ float operator()(int k, int n) const { return k < 512 ? wp[(size_t)k * D + n] : wa[(size_t)(k - 512) * D + n]; } };
struct SrcGU { const float* wg; const float* wu; const float* nrm;
    __device__ __forceinline__ float operator()(int k, int n) const { const int t = n >> 8, j = n & 255, col = 128 * t + (j & 127); const float* w = (const float*)((uintptr_t)wg + (uintptr_t)(j >> 7) * ((uintptr_t)wu - (uintptr_t)wg)); return w[(size_t)k * FF + col] * nrm[k]; } };

template <class Src>
__device__ __forceinline__ void transpose_item(const Src src, bf16_t* WT, int ldk, int nblk, int item, LAS float* scr, int lane) {
    const int kb = item / nblk, nb = item % nblk, k0 = 64 * kb, n0 = 32 * nb;
#pragma unroll 8
    for (int i = 0; i < 32; ++i) { const int kk = 2 * i + (lane >> 5); scr[kk * 33 + (lane & 31)] = src(k0 + kk, n0 + (lane & 31)); }
    LDS_WAIT();
    const int c = lane & 7;
#pragma unroll
    for (int j = 0; j < 4; ++j) { const int n = (lane >> 3) + 8 * j; const LAS float* s = scr + (8 * c) * 33 + n;
        u32x4 o; o.x = cvt_pk_bf16(s[0 * 33], s[1 * 33]); o.y = cvt_pk_bf16(s[2 * 33], s[3 * 33]); o.z = cvt_pk_bf16(s[4 * 33], s[5 * 33]); o.w = cvt_pk_bf16(s[6 * 33], s[7 * 33]);
        *(u32x4*)(WT + (size_t)(n0 + n) * ldk + k0 + 8 * c) = o; }
    LDS_WAIT();
}

struct Args { const float* in[19]; float* out; unsigned char* ws; int ph_lo, ph_hi; };

__device__ __forceinline__ int crow(int r, int hi) { return (r & 3) + 8 * (r >> 2) + 4 * hi; }
constexpr int KS_STRIDE = 144, VT_STRIDE = 520, LDS_VT = 256 * KS_STRIDE  , LDS_SMP = 73728;

__device__ __forceinline__ void attn_prompt_unit(const Args& a, LAS unsigned char* lds, int unit) {
    const int tid = threadIdx.x, lane = tid & 63, wave = __builtin_amdgcn_readfirstlane(tid >> 6);
    const int kh = unit & 1, qb = (unit >> 1) & 15, b = unit >> 5;
    const bf16_t* Z = (const bf16_t*)(a.ws + WS_Z); bf16_t* YY = (bf16_t*)(a.ws + WS_RB);
    const float* qnw = a.in[7]; const float* knw = a.in[8]; const float* sinks = a.in[9];
    const size_t rowbase = (size_t)b * SEQ; const int key0 = (qb - 1) * 128;
    {
        const int j = tid >> 1, half = tid & 1, pos = key0 + j; float v[32];
        if (pos >= 0) { const u32x4* src = (const u32x4*)(Z + (rowbase + pos) * INW + ZC_K + kh * 64 + 32 * half);
#pragma unroll
            for (int c = 0; c < 4; ++c) { const u32x4 w = src[c];
#pragma unroll
                for (int e = 0; e < 4; ++e) { v[c * 8 + 2 * e] = bflo(w[e]); v[c * 8 + 2 * e + 1] = bfhi(w[e]); } } }
        else {
#pragma unroll
            for (int i = 0; i < 32; ++i) v[i] = 0.f; }
        float ss = 0.f;
#pragma unroll
        for (int i = 0; i < 32; ++i) ss += v[i] * v[i];
        ss += __shfl_xor(ss, 1);
        const float rstd = __builtin_amdgcn_rsqf(ss * (1.0f / 64) + EPS);
#pragma unroll
        for (int c = 0; c < 8; ++c) { const f32x4 w = *(const f32x4*)(knw + 32 * half + 4 * c);
#pragma unroll
            for (int e = 0; e < 4; ++e) v[4 * c + e] = v[4 * c + e] * rstd * w[e]; }
        LAS u32x4* dst = (LAS u32x4*)(lds + j * KS_STRIDE + 64 * half);
#pragma unroll
        for (int c = 0; c < 4; ++c) { u32x4 w;
#pragma unroll
            for (int e = 0; e < 4; ++e) w[e] = cvt_pk_bf16(v[c * 8 + 2 * e], v[c * 8 + 2 * e + 1]);
            dst[c] = w; }
        if (qb == 15 && j >= 128) { float* o = a.out + O_KP + ((size_t)(b * 128 + (j - 128)) * 2 + kh) * 64 + 32 * half;
#pragma unroll
            for (int c = 0; c < 8; ++c) *(f32x4*)(o + 4 * c) = (f32x4){v[4 * c], v[4 * c + 1], v[4 * c + 2], v[4 * c + 3]}; }
    }
#pragma unroll
    for (int i = 0; i < 4; ++i) { const int c = tid + 512 * i, key = c & 255, dch = c >> 8, pos = key0 + key;
        u32x4 w = (u32x4){0u, 0u, 0u, 0u};
        if (pos >= 0) w = *(const u32x4*)(Z + (rowbase + pos) * INW + ZC_V + kh * 64 + 8 * dch);
        LAS bf16_t* vt = (LAS bf16_t*)(lds + LDS_VT) + key;
#pragma unroll
        for (int e = 0; e < 4; ++e) { vt[(8 * dch + 2 * e) * (VT_STRIDE / 2)] = (bf16_t)(w[e] & 0xffffu); vt[(8 * dch + 2 * e + 1) * (VT_STRIDE / 2)] = (bf16_t)(w[e] >> 16); }
        if (qb == 15 && key >= 128) { float* o = a.out + O_VP + ((size_t)(b * 128 + (key - 128)) * 2 + kh) * 64 + 8 * dch;
            *(f32x4*)o = (f32x4){bflo(w[0]), bfhi(w[0]), bflo(w[1]), bfhi(w[1])}; *(f32x4*)(o + 4) = (f32x4){bflo(w[2]), bfhi(w[2]), bflo(w[3]), bfhi(w[3])}; } }
    __syncthreads();
    const int hq = 4 * kh + (wave >> 1), ql = lane & 31, h = lane >> 5;
    const float sink2 = sinks[hq] * LOG2E;
#pragma unroll 1
    for (int gi = 0; gi < 2; ++gi) {
        const int g = 2 * (wave & 1) + gi; const size_t qrow = rowbase + (size_t)qb * 128 + 32 * g + ql;
        bf16x8 qf[4];
        { float v[32]; const bf16_t* qp = Z + qrow * INW + ZC_Q + hq * 64 + 8 * h;
#pragma unroll
            for (int ds = 0; ds < 4; ++ds) { const u32x4 w = *(const u32x4*)(qp + 16 * ds);
#pragma unroll
                for (int e = 0; e < 4; ++e) { v[ds * 8 + 2 * e] = bflo(w[e]); v[ds * 8 + 2 * e + 1] = bfhi(w[e]); } }
            float ss = 0.f;
#pragma unroll
            for (int i = 0; i < 32; ++i) ss += v[i] * v[i];
            ss += __shfl_xor(ss, 32);
            const float sc = __builtin_amdgcn_rsqf(ss * (1.0f / 64) + EPS) * C2;
#pragma unroll
            for (int ds = 0; ds < 4; ++ds) { const f32x4 w0 = *(const f32x4*)(qnw + 16 * ds + 8 * h), w1 = *(const f32x4*)(qnw + 16 * ds + 8 * h + 4); u32x4 p;
                p.x = cvt_pk_bf16(v[ds * 8 + 0] * sc * w0[0], v[ds * 8 + 1] * sc * w0[1]); p.y = cvt_pk_bf16(v[ds * 8 + 2] * sc * w0[2], v[ds * 8 + 3] * sc * w0[3]);
                p.z = cvt_pk_bf16(v[ds * 8 + 4] * sc * w1[0], v[ds * 8 + 5] * sc * w1[1]); p.w = cvt_pk_bf16(v[ds * 8 + 6] * sc * w1[2], v[ds * 8 + 7] * sc * w1[3]);
                qf[ds] = __builtin_bit_cast(bf16x8, p); } }
        f32x16 sc[5];
#pragma unroll
        for (int i = 0; i < 5; ++i) { f32x16 acc = {};
#pragma unroll
            for (int ds = 0; ds < 4; ++ds) { const bf16x8 kf = *(const LAS bf16x8*)(lds + (32 * (g + i) + ql) * KS_STRIDE + 32 * ds + 16 * h);
                acc = __builtin_amdgcn_mfma_f32_32x32x16_bf16(kf, qf[ds], acc, 0, 0, 0); }
            sc[i] = acc; }
        const int qr = 32 * g + ql; float mx = -1e30f;
#pragma unroll
        for (int i = 0; i < 5; ++i)
#pragma unroll
            for (int r = 0; r < 16; ++r) { const int j = 32 * (g + i) + crow(r, h); const bool valid = (j >= qr) && (j <= qr + 128) && (qb > 0 || j >= 128);
                const float s = valid ? sc[i][r] : -1e30f; sc[i][r] = s; mx = fmaxf(mx, s); }
        mx = fmaxf(mx, __shfl_xor(mx, 32));
        const float mref = fmaxf(mx, sink2); float lsum = 0.f;
#pragma unroll
        for (int i = 0; i < 5; ++i)
#pragma unroll
            for (int r = 0; r < 16; ++r) { const float p = __builtin_amdgcn_exp2f(sc[i][r] - mref); sc[i][r] = p; lsum += p; }
        lsum += __shfl_xor(lsum, 32);
        const float inv = 1.0f / (lsum + __builtin_amdgcn_exp2f(sink2 - mref));
        f32x16 o[2]; o[0] = (f32x16){}; o[1] = (f32x16){};
#pragma unroll
        for (int i = 0; i < 5; ++i)
#pragma unroll
            for (int s2 = 0; s2 < 2; ++s2) { u32x4 pw;
#pragma unroll
                for (int e = 0; e < 4; ++e) pw[e] = cvt_pk_bf16(sc[i][8 * s2 + 2 * e], sc[i][8 * s2 + 2 * e + 1]);
                const bf16x8 pf = __builtin_bit_cast(bf16x8, pw);
#pragma unroll
                for (int dt = 0; dt < 2; ++dt) { const LAS unsigned char* vp = lds + LDS_VT + (32 * dt + ql) * VT_STRIDE + 2 * (32 * (g + i) + 16 * s2 + 4 * h);
                    const u32x2 lo = *(const LAS u32x2*)vp, hi2 = *(const LAS u32x2*)(vp + 16);
                    const u32x4 vw = (u32x4){lo.x, lo.y, hi2.x, hi2.y};
                    o[dt] = __builtin_amdgcn_mfma_f32_32x32x16_bf16(__builtin_bit_cast(bf16x8, vw), pf, o[dt], 0, 0, 0); } }
        bf16_t* yp = YY + qrow * D + 512 + hq * 64 + 4 * h;
#pragma unroll
        for (int dt = 0; dt < 2; ++dt)
#pragma unroll
            for (int rq = 0; rq < 4; ++rq) { u32x2 w; w.x = cvt_pk_bf16(o[dt][4 * rq] * inv, o[dt][4 * rq + 1] * inv); w.y = cvt_pk_bf16(o[dt][4 * rq + 2] * inv, o[dt][4 * rq + 3] * inv);
                *(u32x2*)(yp + 32 * dt + 8 * rq) = w; }
    }
    __syncthreads();
}

__device__ __forceinline__ void attn_sample_unit(const Args& a, LAS unsigned char* lds, int n) {
    const int tid = threadIdx.x, lane = tid & 63, wave = __builtin_amdgcn_readfirstlane(tid >> 6);
    const int hq = wave, kh = wave >> 2;
    const bf16_t* zrow = (const bf16_t*)(a.ws + WS_Z) + (size_t)(MP + n) * INW; bf16_t* YY = (bf16_t*)(a.ws + WS_RB);
    const float* ck = a.in[2] + (size_t)n * 16384; const float* cv = a.in[3] + (size_t)n * 16384;
    LAS float* qs = (LAS float*)(lds + LDS_SMP + wave * 1024); LAS float* ps = qs + 64;
    const float xq = bf1(zrow[ZC_Q + hq * 64 + lane]); const float ssq = wave_sum(xq * xq);
    const float qn = xq * __builtin_amdgcn_rsqf(ssq * (1.0f / 64) + EPS) * a.in[7][lane] * C2;
    const float xk = bf1(zrow[ZC_K + kh * 64 + lane]); const float ssk = wave_sum(xk * xk);
    const float kn = xk * __builtin_amdgcn_rsqf(ssk * (1.0f / 64) + EPS) * a.in[8][lane];
    const float vn = bf1(zrow[ZC_V + kh * 64 + lane]);
    const float s_new = wave_sum(qn * kn);
    if ((wave & 3) == 0) { a.out[O_KS + (size_t)n * 16384 + (127 * 2 + kh) * 64 + lane] = kn; a.out[O_VS + (size_t)n * 16384 + (127 * 2 + kh) * 64 + lane] = vn; }
    qs[lane] = qn; LDS_WAIT();
    float s0 = 0.f, s1 = 0.f;
    { const f32x4* k0 = (const f32x4*)(ck + (size_t)(lane * 2 + kh) * 64); const f32x4* k1 = (const f32x4*)(ck + (size_t)((lane + 64) * 2 + kh) * 64);
#pragma unroll
        for (int c = 0; c < 16; ++c) { const f32x4 q4 = *(const LAS f32x4*)(qs + 4 * c), x0 = k0[c], x1 = k1[c];
            s0 += (q4[0] * x0[0] + q4[1] * x0[1]) + (q4[2] * x0[2] + q4[3] * x0[3]); s1 += (q4[0] * x1[0] + q4[1] * x1[1]) + (q4[2] * x1[2] + q4[3] * x1[3]); } }
    const float sink2 = a.in[9][hq] * LOG2E;
    const float mref = fmaxf(fmaxf(wave_max(fmaxf(s0, s1)), s_new), sink2);
    const float p0 = __builtin_amdgcn_exp2f(s0 - mref), p1 = __builtin_amdgcn_exp2f(s1 - mref), pn = __builtin_amdgcn_exp2f(s_new - mref);
    const float l = wave_sum(p0 + p1) + pn + __builtin_amdgcn_exp2f(sink2 - mref);
    ps[lane] = p0; ps[lane + 64] = p1; LDS_WAIT();
    float o = pn * vn;
#pragma unroll 8
    for (int j = 0; j < 128; ++j) o += ps[j] * cv[(size_t)(j * 2 + kh) * 64 + lane];
    YY[(size_t)(MP + n) * D + 512 + hq * 64 + lane] = (bf16_t)(cvt_pk_bf16(o / l, 0.f) & 0xffffu);
    { const f32x4* sk = (const f32x4*)(ck + 128); const f32x4* sv = (const f32x4*)(cv + 128); f32x4* dk = (f32x4*)(a.out + O_KS + (size_t)n * 16384); f32x4* dv = (f32x4*)(a.out + O_VS + (size_t)n * 16384);
        for (int i = tid; i < 127 * 32; i += 512) { dk[i] = sk[i]; dv[i] = sv[i]; } }
    LDS_WAIT();
}

__device__ __forceinline__ void pool_items(const Args& a, int gtid, int gthreads) {
    const bf16_t* Z = (const bf16_t*)(a.ws + WS_Z); bf16_t* YPRE = (bf16_t*)(a.ws + WS_YPRE); const float* sp = a.in[4];
    for (int it = gtid; it < MV * 64; it += gthreads) {
        const int row = it >> 6, cg8 = it & 63, c0 = 8 * cg8, w = 2 << (cg8 >> 4);
        const u32x4 un = *(const u32x4*)(Z + (size_t)row * INW + c0);
        float u[8], s[8];
#pragma unroll
        for (int e = 0; e < 4; ++e) { u[2 * e] = bflo(un[e]); u[2 * e + 1] = bfhi(un[e]); }
#pragma unroll
        for (int e = 0; e < 8; ++e) s[e] = u[e];
        float rc;
        if (row < MP) {
            const int b = row >> 11, t = row & 2047, cnt = min(w, t + 1); rc = 1.0f / (float)cnt;
            for (int i = 1; i < cnt; ++i) { const u32x4 x = *(const u32x4*)(Z + (size_t)(row - i) * INW + c0);
#pragma unroll
                for (int e = 0; e < 4; ++e) { s[2 * e] += bflo(x[e]); s[2 * e + 1] += bfhi(x[e]); } }
            if (t >= SEQ - 15) { float* o = a.out + O_PP + ((size_t)b * 15 + (t - (SEQ - 15))) * PW + c0;
                *(f32x4*)o = (f32x4){u[0], u[1], u[2], u[3]}; *(f32x4*)(o + 4) = (f32x4){u[4], u[5], u[6], u[7]}; }
        } else {
            const int n = row - MP; rc = 1.0f / (float)w; const float* st = sp + (size_t)n * 15 * PW + c0;
            for (int i = 1; i < w; ++i) { const f32x4 x0 = *(const f32x4*)(st + (size_t)(15 - i) * PW), x1 = *(const f32x4*)(st + (size_t)(15 - i) * PW + 4);
#pragma unroll
                for (int e = 0; e < 4; ++e) { s[e] += x0[e]; s[4 + e] += x1[e]; } }
            float* o = a.out + O_PS + (size_t)n * 15 * PW + c0;
            for (int i = 0; i < 14; ++i) { *(f32x4*)(o + (size_t)i * PW) = *(const f32x4*)(st + (size_t)(i + 1) * PW); *(f32x4*)(o + (size_t)i * PW + 4) = *(const f32x4*)(st + (size_t)(i + 1) * PW + 4); }
            *(f32x4*)(o + 14 * PW) = (f32x4){u[0], u[1], u[2], u[3]}; *(f32x4*)(o + 14 * PW + 4) = (f32x4){u[4], u[5], u[6], u[7]};
        }
        u32x4 y;
#pragma unroll
        for (int e = 0; e < 4; ++e) y[e] = cvt_pk_bf16(s[2 * e] * rc - u[2 * e], s[2 * e + 1] * rc - u[2 * e + 1]);
        *(u32x4*)(YPRE + (size_t)row * PW + c0) = y;
    }
}

__global__ void __launch_bounds__(512, 2) fwd_megakernel(Args a) {
    extern __shared__ __attribute__((aligned(16))) unsigned char lds_raw[];
    LAS unsigned char* lds = (LAS unsigned char*)lds_raw;
    cg::grid_group grid = cg::this_grid();
    const int tid = threadIdx.x, lane = tid & 63, wave = __builtin_amdgcn_readfirstlane(tid >> 6);
    const int G = gridDim.x, bx = blockIdx.x;
    const int vcu = (G % 8 == 0) ? (bx % 8) * (G / 8) + bx / 8 : bx;
    unsigned char* ws = a.ws;
    bf16_t* WIN = (bf16_t*)(ws + WS_WIN); bf16_t* WMIX = (bf16_t*)(ws + WS_MIX); bf16_t* WCAT = (bf16_t*)(ws + WS_WCAT); bf16_t* WOUT = (bf16_t*)(ws + WS_WOUT);
    bf16_t* WGU = (bf16_t*)(ws + WS_WGU); bf16_t* WDN = (bf16_t*)(ws + WS_WDN);
    bf16_t* RA = (bf16_t*)(ws + WS_RA); bf16_t* RB = (bf16_t*)(ws + WS_RB); bf16_t* YPRE = (bf16_t*)(ws + WS_YPRE); bf16_t* Z = (bf16_t*)(ws + WS_Z);
    float* SUMSQ = (float*)(ws + WS_SUMSQ);
    const int lo = a.ph_lo, hi = a.ph_hi;
#ifndef PH_MASK
#define PH_MASK 255
#endif
#define IN(k) (((PH_MASK >> (k)) & 1) && lo <= (k) && (k) < hi)
#define SEAM(k) do { if (IN(k) && IN((k) + 1)) grid.sync(); } while (0)

    if (IN(0)) {
        LAS float* scr = (LAS float*)(lds + wave * 16384);
        const int gw = vcu * 8 + wave, NGW = G * 8;
        constexpr int I_IN = 16 * 104, I_MIX = 4 * 16, I_CAT = 16 * 32, I_OUT = 16 * 32, I_GU = 16 * 176, I_DN = 44 * 32;
        constexpr int NITEMS = I_IN + I_MIX + I_CAT + I_OUT + I_GU + I_DN;
        for (int it = gw; it < NITEMS; it += NGW) {
            int r = it;
            if (r < I_IN) { transpose_item(SrcPlain{a.in[6], INW}, WIN, D, 104, r, scr, lane); continue; } r -= I_IN;
            if (r < I_MIX) { transpose_item(SrcMix{a.in[10], a.in[11]}, WMIX, 256, 16, r, scr, lane); continue; } r -= I_MIX;
            if (r < I_CAT) { transpose_item(SrcCat{a.in[12], a.in[13]}, WCAT, D, 32, r, scr, lane); continue; } r -= I_CAT;
            if (r < I_OUT) { transpose_item(SrcPlain{a.in[14], D}, WOUT, D, 32, r, scr, lane); continue; } r -= I_OUT;
            if (r < I_GU) { transpose_item(SrcGU{a.in[16], a.in[17], a.in[15]}, WGU, D, 176, r, scr, lane); continue; } r -= I_GU;
            transpose_item(SrcPlain{a.in[18], D}, WDN, FF, 32, r, scr, lane);
        }
        const float* g1 = a.in[5];
        for (int m = gw; m < MPAD; m += NGW) {
            unsigned long long* o8 = (unsigned long long*)(RA + (size_t)m * D) + lane;
            if (m < MV) {
                const f32x4* xr = (const f32x4*)(m < MP ? a.in[0] + (size_t)m * D : a.in[1] + (size_t)(m - MP) * D) + lane;
                f32x4 v[4]; float s = 0.f;
#pragma unroll
                for (int j = 0; j < 4; ++j) { v[j] = xr[64 * j]; s += (v[j].x * v[j].x + v[j].y * v[j].y) + (v[j].z * v[j].z + v[j].w * v[j].w); }
                const float rstd = __builtin_amdgcn_rsqf(wave_sum(s) * (1.f / D) + EPS);
#pragma unroll
                for (int j = 0; j < 4; ++j) { const f32x4 gg = ((const f32x4*)g1)[lane + 64 * j];
                    o8[64 * j] = (unsigned long long)cvt_pk_bf16(v[j].x * rstd * gg.x, v[j].y * rstd * gg.y) | ((unsigned long long)cvt_pk_bf16(v[j].z * rstd * gg.z, v[j].w * rstd * gg.w) << 32); }
            } else {
#pragma unroll
                for (int j = 0; j < 4; ++j) o8[64 * j] = 0ull;
                unsigned long long* y8 = (unsigned long long*)(RB + (size_t)m * D) + lane;
#pragma unroll
                for (int j = 0; j < 4; ++j) y8[64 * j] = 0ull;
                unsigned long long* p8 = (unsigned long long*)(YPRE + (size_t)m * PW) + lane;
                p8[0] = 0ull; p8[64] = 0ull;
            }
        }
        for (int i = vcu * 512 + tid; i < MPAD; i += G * 512) SUMSQ[i] = 0.f;
    }
    SEAM(0);
    if (IN(1)) {
        pg8::Gemm g{RA, WIN, D, D, D, 0, -1}; pg8::StaticOrder S; S.init(MPAD, INW, G, bx);
        pg8::gemm_phase(lds, g, S, pg8::EpiZ{Z});
    }
    SEAM(1);
    if (IN(2)) {
        for (int u = vcu; u < 256; u += G) attn_prompt_unit(a, lds, u);
        for (int n = vcu; n < NS; n += G) attn_sample_unit(a, lds, n);
        pool_items(a, vcu * 512 + tid, G * 512);
    }
    SEAM(2);
    if (IN(3)) {
        pg8::Gemm g{YPRE, WMIX, PW, 256, 256, 512, -1}; pg8::StaticOrder S; S.init(MPAD, PW, G, bx);
        pg8::gemm_phase(lds, g, S, pg8::EpiBf{RB, D});
    }
    SEAM(3);
    if (IN(4)) {
        pg8::Gemm g{RB, WCAT, D, D, D, 0, 8}; pg8::StaticOrder S; S.init(MPAD, D, G, bx);
        pg8::gemm_phase(lds, g, S, pg8::EpiMerge{Z, RA});
    }
    SEAM(4);
    if (IN(5)) {
        pg8::Gemm g{RA, WOUT, D, D, D, 0, -1}; pg8::StaticOrder S; S.init(MPAD, D, G, bx);
        pg8::gemm_phase(lds, g, S, pg8::EpiX1{a.in[0], a.in[1], a.out + O_Y, RB, SUMSQ});
    }
    SEAM(5);
    if (IN(6)) {
        pg8::Gemm g{RB, WGU, D, D, D, 0, -1}; pg8::StaticOrder S; S.init(MPAD, 2 * FF, G, bx);
        pg8::gemm_phase(lds, g, S, pg8::EpiAct{SUMSQ, Z});
    }
    SEAM(6);
    if (IN(7)) {
        pg8::Gemm g{Z, WDN, FF, FF, FF, 0, -1}; pg8::StaticOrder S; S.init(MPAD, D, G, bx);
        pg8::gemm_phase(lds, g, S, pg8::EpiY{a.out + O_Y});
    }
#undef IN
#undef SEAM
}

#ifndef MK_N_LAUNCHES
#define MK_N_LAUNCHES 1
#endif
extern "C" void kernel_launch(void* const* d_in, const int* in_sizes, int n_in, void* d_out, int out_size, void* d_ws, size_t ws_size, hipStream_t stream) {
    static int grid = 0;
    if (grid == 0) {
        int dev = 0, cus = 0, per_cu = 0;
        if (n_in != 19 || ws_size < WS_END) { fprintf(stderr, "kernel_launch: unexpected inputs (n_in %d, ws %zu)\n", n_in, ws_size); grid = -1; return; }
        hipGetDevice(&dev); hipDeviceGetAttribute(&cus, hipDeviceAttributeMultiprocessorCount, dev);
        if (hipFuncSetAttribute((const void*)fwd_megakernel, hipFuncAttributeMaxDynamicSharedMemorySize, LDS_BYTES) != hipSuccess) { fprintf(stderr, "kernel_launch: hipFuncSetAttribute failed\n"); grid = -1; return; }
        if (hipOccupancyMaxActiveBlocksPerMultiprocessor(&per_cu, (const void*)fwd_megakernel, 512, LDS_BYTES) != hipSuccess || per_cu < 1) { fprintf(stderr, "kernel_launch: occupancy query says %d\n", per_cu); per_cu = 1; }
        (void)hipGetLastError();
        grid = cus * 1;
        if (per_cu < 1) grid = -1;
    }
    if (grid < 0) return;
    Args a{};
    for (int i = 0; i < 19; ++i) a.in[i] = (const float*)d_in[i];
    a.out = (float*)d_out; a.ws = (unsigned char*)d_ws;
#if MK_N_LAUNCHES == 1
    a.ph_lo = 0; a.ph_hi = 8;
    void* args[] = {&a};
    hipError_t e = hipLaunchCooperativeKernel((const void*)fwd_megakernel, dim3(grid), dim3(512), args, LDS_BYTES, stream);
    if (e != hipSuccess) fprintf(stderr, "cooperative launch failed: %s (grid %d)\n", hipGetErrorString(e), grid);
#else
    for (int p = 0; p < 8; ++p) { a.ph_lo = p; a.ph_hi = p + 1; hipLaunchKernelGGL(fwd_megakernel, dim3(grid), dim3(512), LDS_BYTES, stream, a); }
#endif
}
```

```cpp
#include <hip/hip_runtime.h>
#include <hip/hip_cooperative_groups.h>
#include <cstdio>
#include <cstdint>
namespace cg = cooperative_groups;

#define LAS __attribute__((address_space(3)))
typedef unsigned short bf16_t;
typedef short bf16x8 __attribute__((ext_vector_type(8)));
typedef short s16x4 __attribute__((ext_vector_type(4)));
typedef float f32x4 __attribute__((ext_vector_type(4)));
typedef float f32x16 __attribute__((ext_vector_type(16)));
typedef unsigned u32x4 __attribute__((ext_vector_type(4)));
typedef unsigned u32x2 __attribute__((ext_vector_type(2)));

constexpr int D = 1024, SEQ = 2048, NB = 8, MP = NB * SEQ, NS = 128, MV = MP + NS, MPAD = 16640;
constexpr int INW = 3328, FF = 2816, PW = 512;
constexpr int ZC_Q = 512, ZC_K = 1024, ZC_V = 1152, ZC_GA = 1280, ZC_GB = 2304;
constexpr float EPS = 1e-6f;
constexpr float LOG2E = 1.4426950408889634f;
constexpr float C2 = 0.125f * LOG2E;
constexpr size_t O_Y = 0, O_KP = 16908288, O_VP = 17039360, O_PP = 17170432, O_KS = 17231872, O_VS = 19329024, O_PS = 21426176;
constexpr size_t MiB = 1u << 20;
constexpr size_t WS_SUMSQ = 0;
constexpr size_t WS_WIN = 2 * MiB, WS_MIX = 9 * MiB, WS_WCAT = 10 * MiB, WS_WOUT = 12 * MiB, WS_WGU = 14 * MiB, WS_WDN = 25 * MiB;
constexpr size_t WS_RA = 32 * MiB;
constexpr size_t WS_RB = 65 * MiB;
constexpr size_t WS_YPRE = 98 * MiB;
constexpr size_t WS_Z = 115 * MiB;
constexpr size_t WS_END = 222 * MiB;
constexpr int LDS_BYTES = 147456;

__device__ __forceinline__ unsigned cvt_pk_bf16(float lo, float hi) { unsigned r; asm("v_cvt_pk_bf16_f32 %0, %1, %2" : "=v"(r) : "v"(lo), "v"(hi)); return r; }
__device__ __forceinline__ float bflo(unsigned u) { return __uint_as_float(u << 16); }
__device__ __forceinline__ float bfhi(unsigned u) { return __uint_as_float(u & 0xffff0000u); }
__device__ __forceinline__ float bf1(bf16_t u) { return __uint_as_float(((unsigned)u) << 16); }
__device__ __forceinline__ float fsigmoid(float x) { return __builtin_amdgcn_rcpf(1.0f + __builtin_amdgcn_exp2f(-x * LOG2E)); }
__device__ __forceinline__ float wave_sum(float v) {
#pragma unroll
    for (int o = 1; o < 64; o <<= 1) v += __shfl_xor(v, o);
    return v;
}
__device__ __forceinline__ float wave_max(float v) {
#pragma unroll
    for (int o = 1; o < 64; o <<= 1) v = fmaxf(v, __shfl_xor(v, o));
    return v;
}
#define LDS_WAIT() asm volatile("s_waitcnt lgkmcnt(0)" ::: "memory")

namespace pg8 {
constexpr int BM = 256, BK = 64, HALF = 128, HTB = HALF * BK * 2, STAGE_BYTES = 8 * HTB, NXCD = 8, WGM = 8;
__host__ __device__ __forceinline__ int lds_byte(int r, int c) { const int st = (r >> 4) * 2 + (c >> 5), rr = r & 15, cc = c & 31, ob = rr * 64 + cc * 2; return st * 1024 + (ob ^ (((ob >> 9) & 1) << 5)); }
__host__ __device__ __forceinline__ void stage_rc(int b, int& R, int& C) { const int st = b / 1024, sb = b % 1024, swz = sb ^ (((sb >> 9) & 1) << 5); R = (st >> 1) * 16 + swz / 64; C = (st & 1) * 32 + (swz % 64) / 2; }
__host__ __device__ __forceinline__ int perm32(int rho) { const int n = rho >> 4, i = rho & 15; return 8 * (i >> 2) + 4 * n + (i & 3); }

struct Unit { int pm, pn; };
struct Gemm { const bf16_t* A; const bf16_t* Bt; int lda, ldb, K, a_pn_bytes, midt; };

struct StaticOrder {
    int nM, nN, nwg, G, c;
    __device__ void init(int M, int N, int G_, int c_) { nM = M / BM; nN = N / BM; nwg = nM * nN; G = G_; c = c_; }
    __device__ bool next(int i, Unit& u) const {
        const long L = (long)i * G + c; if (L >= nwg) return false;
        int wgid = (int)L; { const int q = nwg / NXCD, r = nwg % NXCD, xcd = wgid % NXCD, off = wgid / NXCD; wgid = (xcd < r ? xcd * (q + 1) : r * (q + 1) + (xcd - r) * q) + off; }
        const int nig = WGM * nN, gid = wgid / nig, fm = gid * WGM, gsz = (nM - fm) < WGM ? (nM - fm) : WGM;
        u.pm = fm + ((wgid % nig) % gsz); u.pn = (wgid % nig) / gsz; return true;
    }
};

template <class Epi>
__device__ __forceinline__ void gemm_phase(LAS unsigned char* lds, const Gemm g, const StaticOrder& S, const Epi& E) {
    const int tid = threadIdx.x, wid = __builtin_amdgcn_readfirstlane(tid >> 6), lane = tid & 63, wr = wid >> 2, wc = wid & 3, fr = lane & 15, fq = lane >> 4;
    const int K = g.K, nt = K / BK;
    unsigned voffA[2], voffB[2];
#pragma unroll
    for (int i = 0; i < 2; ++i) { int R, C; stage_rc(tid * 16 + i * 8192, R, C); const int Rb = (R & ~31) + perm32(R & 31);
        voffA[i] = (unsigned)(R * g.lda + C) * 2u; voffB[i] = (unsigned)(Rb * g.ldb + C) * 2u; }
    const size_t kstep = (size_t)(BK * 2);
    const size_t hstepA = (size_t)HALF * g.lda * 2, hstepB = (size_t)HALF * g.ldb * 2;
    const size_t tstepA = 2 * hstepA, tstepB = 2 * hstepB;
    const unsigned ldsw = (unsigned)wid * 1024u;
    const int aoff = lds_byte(wr * 64 + fr, fq * 8), boff = lds_byte(wc * 32 + fr, fq * 8);
#define PG8_SA(b, h) (((b) * 2 + (h)) * HTB)
#define PG8_SB(b, h) ((4 + (b) * 2 + (h)) * HTB)
#define PG8_STAGE(bufoff, gbase, voff) do { _Pragma("unroll") for (int _i = 0; _i < 2; ++_i) \
        __builtin_amdgcn_global_load_lds((const unsigned*)((const char*)(gbase) + (voff)[_i]), (LAS unsigned*)(lds + (bufoff) + ldsw + _i * 8192), 16, 0, 0); } while (0)
#define PG8_LDA(dst, b, h) do { _Pragma("unroll") for (int m = 0; m < 4; ++m) _Pragma("unroll") for (int k = 0; k < 2; ++k) dst[m][k] = *(const LAS bf16x8*)(lds + PG8_SA(b, h) + aoff + m * 2048 + k * 1024); } while (0)
#define PG8_LDB(dst, b, h) do { _Pragma("unroll") for (int n = 0; n < 2; ++n) _Pragma("unroll") for (int k = 0; k < 2; ++k) dst[n][k] = *(const LAS bf16x8*)(lds + PG8_SB(b, h) + boff + n * 2048 + k * 1024); } while (0)
#define PG8_MMA(ai, bj, At, Bt) do { __builtin_amdgcn_s_setprio(1); _Pragma("unroll") for (int m = 0; m < 4; ++m) _Pragma("unroll") for (int n = 0; n < 2; ++n) _Pragma("unroll") for (int k = 0; k < 2; ++k) \
        acc[ai][bj][m][n] = __builtin_amdgcn_mfma_f32_16x16x32_bf16(Bt[n][k], At[m][k], acc[ai][bj][m][n], 0, 0, 0); __builtin_amdgcn_s_setprio(0); } while (0)
#define PG8_WAIT_V(n) asm volatile("s_waitcnt vmcnt(" #n ")" ::: "memory")
#define PG8_WAIT_L(n) asm volatile("s_waitcnt lgkmcnt(" #n ")" ::: "memory")
#define PG8_BAR __builtin_amdgcn_s_barrier()
#define PG8_SCHED __builtin_amdgcn_sched_barrier(0)
    Unit cur, nxt; int ui = 0;
    if (!S.next(0, cur)) return;
    f32x4 acc[2][2][4][2];
#pragma unroll
    for (int a = 0; a < 2; ++a)
#pragma unroll
        for (int b = 0; b < 2; ++b)
#pragma unroll
            for (int m = 0; m < 4; ++m)
#pragma unroll
                for (int n = 0; n < 2; ++n) acc[a][b][m][n] = (f32x4){0.f, 0.f, 0.f, 0.f};
    bf16x8 At[4][2], B0[2][2], B1[2][2];
    const char* cA = (const char*)g.A + (size_t)cur.pm * tstepA + (size_t)cur.pn * g.a_pn_bytes; const char* cB = (const char*)g.Bt + (size_t)cur.pn * tstepB;
    PG8_STAGE(PG8_SB(0, 0), cB, voffB); PG8_STAGE(PG8_SB(0, 1), cB + hstepB, voffB); PG8_STAGE(PG8_SA(0, 0), cA, voffA); PG8_STAGE(PG8_SA(0, 1), cA + hstepA, voffA);
    if (wr == 1) PG8_BAR;
    PG8_WAIT_V(2); PG8_BAR;
    PG8_STAGE(PG8_SB(1, 0), cB + kstep, voffB); PG8_STAGE(PG8_SA(1, 0), cA + kstep, voffA); PG8_STAGE(PG8_SB(1, 1), cB + hstepB + kstep, voffB);
    PG8_WAIT_V(6); PG8_BAR;
    for (;;) {
        const bool has_next = S.next(ui + 1, nxt);
        const char* nA = has_next ? (const char*)g.A + (size_t)nxt.pm * tstepA + (size_t)nxt.pn * g.a_pn_bytes : cA; const char* nB = has_next ? (const char*)g.Bt + (size_t)nxt.pn * tstepB : cB;
#pragma unroll 1
        for (int t = 0; t < nt; t += 2) {
            const bool last = (t == nt - 2);
            if constexpr (Epi::HAS_MID) { if (t == g.midt) { E.mid(acc, cur, wr, wc, fr, fq); } PG8_SCHED; }
            const char* a1 = cA + (size_t)(t + 1) * kstep;
            const char* a2 = last ? nA : cA + (size_t)(t + 2) * kstep; const char* b2 = last ? nB : cB + (size_t)(t + 2) * kstep;
            const char* a3 = a2 + kstep; const char* b3 = b2 + kstep;
            PG8_LDB(B0, 0, 0); PG8_LDB(B1, 0, 1); PG8_SCHED; PG8_LDA(At, 0, 0); PG8_STAGE(PG8_SA(1, 1), a1 + hstepA, voffA);
            PG8_WAIT_V(8); PG8_WAIT_L(0); PG8_BAR; PG8_MMA(0, 0, At, B0); PG8_MMA(0, 1, At, B1); PG8_BAR; PG8_SCHED;
            PG8_LDA(At, 0, 1); PG8_STAGE(PG8_SB(0, 0), b2, voffB); PG8_STAGE(PG8_SB(0, 1), b2 + hstepB, voffB); PG8_STAGE(PG8_SA(0, 0), a2, voffA);
            PG8_WAIT_V(8); PG8_WAIT_L(0); PG8_BAR; PG8_MMA(1, 0, At, B0); PG8_MMA(1, 1, At, B1); PG8_BAR; PG8_SCHED;
            PG8_LDB(B0, 1, 0); PG8_LDB(B1, 1, 1); PG8_SCHED; PG8_LDA(At, 1, 0); PG8_STAGE(PG8_SA(0, 1), a2 + hstepA, voffA);
            PG8_WAIT_V(8); PG8_WAIT_L(0); PG8_BAR; PG8_MMA(0, 0, At, B0); PG8_MMA(0, 1, At, B1); PG8_BAR; PG8_SCHED;
            PG8_LDA(At, 1, 1); PG8_STAGE(PG8_SB(1, 0), b3, voffB); PG8_STAGE(PG8_SB(1, 1), b3 + hstepB, voffB); PG8_STAGE(PG8_SA(1, 0), a3, voffA);
            PG8_WAIT_V(8); PG8_WAIT_L(0); PG8_BAR; PG8_MMA(1, 0, At, B0); PG8_MMA(1, 1, At, B1); PG8_BAR; PG8_SCHED;
        }
        if (wr == 0) PG8_BAR;
        E(acc, cur, wr, wc, fr, fq);
        if (!has_next) break;
#pragma unroll
        for (int a = 0; a < 2; ++a)
#pragma unroll
            for (int b = 0; b < 2; ++b)
#pragma unroll
                for (int m = 0; m < 4; ++m)
#pragma unroll
                    for (int n = 0; n < 2; ++n) acc[a][b][m][n] = (f32x4){0.f, 0.f, 0.f, 0.f};
        cur = nxt; cA = nA; cB = nB; ++ui;
        if (wr == 1) PG8_BAR;
    }
    PG8_WAIT_V(0);
    PG8_BAR;
#undef PG8_SA
#undef PG8_SB
#undef PG8_STAGE
#undef PG8_LDA
#undef PG8_LDB
#undef PG8_MMA
#undef PG8_WAIT_V
#undef PG8_WAIT_L
#undef PG8_BAR
#undef PG8_SCHED
}

typedef f32x4 Acc[2][2][4][2];
__device__ __forceinline__ u32x4 pack8(const f32x4 v0, const f32x4 v1) { u32x4 w; w.x = cvt_pk_bf16(v0[0], v0[1]); w.y = cvt_pk_bf16(v0[2], v0[3]); w.z = cvt_pk_bf16(v1[0], v1[1]); w.w = cvt_pk_bf16(v1[2], v1[3]); return w; }

struct EpiZ {
    static constexpr bool HAS_MID = false;
    bf16_t* Z;
    __device__ __forceinline__ void operator()(Acc& acc, const Unit& u, int wr, int wc, int fr, int fq) const {
        int row0 = u.pm * BM + wr * 64 + fr; asm volatile("" : "+v"(row0)); const int col0 = u.pn * BM + wc * 32 + 8 * fq; const bool sig = u.pn >= 5;
#pragma unroll
        for (int ai = 0; ai < 2; ++ai)
#pragma unroll
            for (int m = 0; m < 4; ++m) { bf16_t* rowp = Z + (size_t)(row0 + ai * HALF + m * 16) * INW + col0;
#pragma unroll
                for (int bj = 0; bj < 2; ++bj) { f32x4 v0 = acc[ai][bj][m][0], v1 = acc[ai][bj][m][1];
                    if (sig) {
#pragma unroll
                        for (int e = 0; e < 4; ++e) { v0[e] = fsigmoid(v0[e]); v1[e] = fsigmoid(v1[e]); } }
                    *(u32x4*)(rowp + bj * HALF) = pack8(v0, v1); } }
    }
};
struct EpiBf {
    static constexpr bool HAS_MID = false;
    bf16_t* O; int ldc;
    __device__ __forceinline__ void operator()(Acc& acc, const Unit& u, int wr, int wc, int fr, int fq) const {
        int row0 = u.pm * BM + wr * 64 + fr; asm volatile("" : "+v"(row0)); const int col0 = u.pn * BM + wc * 32 + 8 * fq;
#pragma unroll
        for (int ai = 0; ai < 2; ++ai)
#pragma unroll
            for (int m = 0; m < 4; ++m) { bf16_t* rowp = O + (size_t)(row0 + ai * HALF + m * 16) * ldc + col0;
#pragma unroll
                for (int bj = 0; bj < 2; ++bj) *(u32x4*)(rowp + bj * HALF) = pack8(acc[ai][bj][m][0], acc[ai][bj][m][1]); }
    }
};
struct EpiMerge {
    static constexpr bool HAS_MID = true;
    const bf16_t* Z; bf16_t* O;
    __device__ __forceinline__ void mid(Acc& acc, const Unit& u, int wr, int wc, int fr, int fq) const {
        int row0 = u.pm * BM + wr * 64 + fr; asm volatile("" : "+v"(row0)); const int col0 = u.pn * BM + wc * 32 + 8 * fq;
#pragma unroll
        for (int ai = 0; ai < 2; ++ai)
#pragma unroll
            for (int m = 0; m < 4; ++m) { const bf16_t* zr = Z + (size_t)(row0 + ai * HALF + m * 16) * INW + col0;
#pragma unroll
                for (int bj = 0; bj < 2; ++bj) { const u32x4 a = *(const u32x4*)(zr + ZC_GA + bj * HALF), b = *(const u32x4*)(zr + ZC_GB + bj * HALF);
#pragma unroll
                    for (int e = 0; e < 4; ++e) { const float r0 = bflo(a[e]) * __builtin_amdgcn_rcpf(bflo(b[e])), r1 = bfhi(a[e]) * __builtin_amdgcn_rcpf(bfhi(b[e]));
                        acc[ai][bj][m][e >> 1][(e & 1) * 2] *= r0; acc[ai][bj][m][e >> 1][(e & 1) * 2 + 1] *= r1; } }
                asm volatile("" ::: "memory"); }
    }
    __device__ __forceinline__ void operator()(Acc& acc, const Unit& u, int wr, int wc, int fr, int fq) const {
        int row0 = u.pm * BM + wr * 64 + fr; asm volatile("" : "+v"(row0)); const int col0 = u.pn * BM + wc * 32 + 8 * fq;
#pragma unroll
        for (int ai = 0; ai < 2; ++ai)
#pragma unroll
            for (int m = 0; m < 4; ++m) { const size_t row = (size_t)(row0 + ai * HALF + m * 16); const bf16_t* zr = Z + row * INW + col0; bf16_t* rowp = O + row * D + col0;
#pragma unroll
                for (int bj = 0; bj < 2; ++bj) { const u32x4 b = *(const u32x4*)(zr + ZC_GB + bj * HALF); f32x4 v0 = acc[ai][bj][m][0], v1 = acc[ai][bj][m][1];
                    v0[0] *= bflo(b[0]); v0[1] *= bfhi(b[0]); v0[2] *= bflo(b[1]); v0[3] *= bfhi(b[1]); v1[0] *= bflo(b[2]); v1[1] *= bfhi(b[2]); v1[2] *= bflo(b[3]); v1[3] *= bfhi(b[3]);
                    *(u32x4*)(rowp + bj * HALF) = pack8(v0, v1); } }
    }
};
struct EpiX1 {
    static constexpr bool HAS_MID = false;
    const float* xp; const float* xs; float* out; bf16_t* X1B; float* sumsq;
    __device__ __forceinline__ void operator()(Acc& acc, const Unit& u, int wr, int wc, int fr, int fq) const {
        int row0 = u.pm * BM + wr * 64 + fr; asm volatile("" : "+v"(row0)); const int col0 = u.pn * BM + wc * 32 + 8 * fq;
#pragma unroll
        for (int ai = 0; ai < 2; ++ai)
#pragma unroll
            for (int m = 0; m < 4; ++m) { const int row = row0 + ai * HALF + m * 16; const bool valid = row < MV;
                const float* xr = (row < MP ? xp + (size_t)row * D : xs + (size_t)(valid ? row - MP : 0) * D) + col0;
                float ss = 0.f;
#pragma unroll
                for (int bj = 0; bj < 2; ++bj) { f32x4 v0 = acc[ai][bj][m][0], v1 = acc[ai][bj][m][1];
                    if (valid) { v0 += *(const f32x4*)(xr + bj * HALF); v1 += *(const f32x4*)(xr + bj * HALF + 4);
                        *(f32x4*)(out + (size_t)row * D + col0 + bj * HALF) = v0; *(f32x4*)(out + (size_t)row * D + col0 + bj * HALF + 4) = v1; }
                    ss += (v0[0] * v0[0] + v0[1] * v0[1]) + (v0[2] * v0[2] + v0[3] * v0[3]) + (v1[0] * v1[0] + v1[1] * v1[1]) + (v1[2] * v1[2] + v1[3] * v1[3]);
                    *(u32x4*)(X1B + (size_t)row * D + col0 + bj * HALF) = pack8(v0, v1); }
                ss += __shfl_xor(ss, 16); ss += __shfl_xor(ss, 32);
                if (fq == 0) atomicAdd(sumsq + row, ss); }
    }
};
struct EpiAct {
    static constexpr bool HAS_MID = false;
    const float* sumsq; bf16_t* ACT;
    __device__ __forceinline__ void operator()(Acc& acc, const Unit& u, int wr, int wc, int fr, int fq) const {
        int row0 = u.pm * BM + wr * 64 + fr; asm volatile("" : "+v"(row0)); const int col0 = u.pn * HALF + wc * 32 + 8 * fq;
#pragma unroll
        for (int ai = 0; ai < 2; ++ai)
#pragma unroll
            for (int m = 0; m < 4; ++m) { const int row = row0 + ai * HALF + m * 16; const float rstd = __builtin_amdgcn_rsqf(sumsq[row] * (1.0f / D) + EPS);
                f32x4 o[2];
#pragma unroll
                for (int n = 0; n < 2; ++n)
#pragma unroll
                    for (int e = 0; e < 4; ++e) { const float gt = acc[ai][0][m][n][e] * rstd, up = acc[ai][1][m][n][e] * rstd; o[n][e] = gt * up * fsigmoid(gt); }
                *(u32x4*)(ACT + (size_t)row * FF + col0) = pack8(o[0], o[1]); }
    }
};
struct EpiY {
    static constexpr bool HAS_MID = false;
    float* out;
    __device__ __forceinline__ void operator()(Acc& acc, const Unit& u, int wr, int wc, int fr, int fq) const {
        int row0 = u.pm * BM + wr * 64 + fr; asm volatile("" : "+v"(row0)); const int col0 = u.pn * BM + wc * 32 + 8 * fq;
#pragma unroll
        for (int ai = 0; ai < 2; ++ai)
#pragma unroll
            for (int m = 0; m < 4; ++m) { const int row = row0 + ai * HALF + m * 16;
                if (row < MV) { float* orow = out + (size_t)row * D + col0;
#pragma unroll
                    for (int bj = 0; bj < 2; ++bj) { const f32x4 a = *(const f32x4*)(orow + bj * HALF), b = *(const f32x4*)(orow + bj * HALF + 4);
                        *(f32x4*)(orow + bj * HALF) = a + acc[ai][bj][m][0]; *(f32x4*)(orow + bj * HALF + 4) = b + acc[ai][bj][m][1]; } } }
    }
};
}

struct SrcPlain { const float* W; int N; __device__ __forceinline__ float operator()(int k, int n) const { return W[(size_t)k * N + n]; } };
struct SrcMix { const float* mix; const float* scale;
    __device__ __forceinline__ float operator()(int kk, int n) const { const int g = n >> 7, j = n & 127; return ((kk >> 7) == (g & 1)) ? mix[((size_t)g * 128 + (kk & 127)) * 128 + j] * scale[n] : 0.f; } };
struct SrcCat { const float* wp; const float* wa;
    __device__ __forceinline__ float operator()(int k, int n) const { return k < 512 ? wp[(size_t)k * D + n] : wa[(size_t)(k - 512) * D + n]; } };
struct SrcGU { const float* wg; const float* wu; const float* nrm;
    __device__ __forceinline__ float operator()(int k, int n) const { const int t = n >> 8, j = n & 255, col = 128 * t + (j & 127); const float* w = (const float*)((uintptr_t)wg + (uintptr_t)(j >> 7) * ((uintptr_t)wu - (uintptr_t)wg)); return w[(size_t)k * FF + col] * nrm[k]; } };

template <class Src>
__device__ __forceinline__ void transpose_item(const Src src, bf16_t* WT, int ldk, int nblk, int item, LAS float* scr, int lane) {
    const int kb = item / nblk, nb = item % nblk, k0 = 64 * kb, n0 = 32 * nb;
#pragma unroll 8
    for (int i = 0; i < 32; ++i) { const int kk = 2 * i + (lane >> 5); scr[kk * 33 + (lane & 31)] = src(k0 + kk, n0 + (lane & 31)); }
    LDS_WAIT();
    const int c = lane & 7;
#pragma unroll
    for (int j = 0; j < 4; ++j) { const int n = (lane >> 3) + 8 * j; const LAS float* s = scr + (8 * c) * 33 + n;
        u32x4 o; o.x = cvt_pk_bf16(s[0 * 33], s[1 * 33]); o.y = cvt_pk_bf16(s[2 * 33], s[3 * 33]); o.z = cvt_pk_bf16(s[4 * 33], s[5 * 33]); o.w = cvt_pk_bf16(s[6 * 33], s[7 * 33]);
        *(u32x4*)(WT + (size_t)(n0 + n) * ldk + k0 + 8 * c) = o; }
    LDS_WAIT();
}

struct Args { const float* in[19]; float* out; unsigned char* ws; int ph_lo, ph_hi; };

template <class Epi>
__device__ __forceinline__ void small_gemm(LAS unsigned char* lds, const bf16_t* A, int lda, const bf16_t* Bt, int ldb, int K, int vcu, int G, const Epi& E) {
    const int tid = threadIdx.x, lane = tid & 63, wave = __builtin_amdgcn_readfirstlane(tid >> 6), fr = lane & 15, fq = lane >> 4, rh = wave & 1, ks = wave >> 1;
    const int kq = K >> 2, nsteps = kq >> 5;
    for (int u = vcu; u < 256; u += G) {
        const int r0 = 32 * (u & 3) + 16 * rh, n0 = 16 * (u >> 2);
        const bf16_t* ap = A + (size_t)(r0 + fr) * lda + ks * kq + 8 * fq; const bf16_t* bp = Bt + (size_t)(n0 + fr) * ldb + ks * kq + 8 * fq;
        f32x4 acc = (f32x4){0.f, 0.f, 0.f, 0.f};
#pragma unroll 8
        for (int s = 0; s < nsteps; ++s) { const bf16x8 af = *(const bf16x8*)(ap + 32 * s), bf = *(const bf16x8*)(bp + 32 * s);
            acc = __builtin_amdgcn_mfma_f32_16x16x32_bf16(bf, af, acc, 0, 0, 0); }
        LAS f32x4* red = (LAS f32x4*)lds;
        red[(ks * 2 + rh) * 64 + lane] = acc;
        __syncthreads();
        if (ks == 0) { const f32x4 p0 = red[(0 * 2 + rh) * 64 + lane], p1 = red[(1 * 2 + rh) * 64 + lane], p2 = red[(2 * 2 + rh) * 64 + lane], p3 = red[(3 * 2 + rh) * 64 + lane];
            E(p0, p1, p2, p3, r0 + fr, n0 + 4 * fq, fq); }
        __syncthreads();
    }
}
struct SEpiMerge { const bf16_t* Z; bf16_t* O;
    __device__ __forceinline__ void operator()(f32x4 p0, f32x4 p1, f32x4 p2, f32x4 p3, int n, int c, int fq) const {
        const bf16_t* zr = Z + (size_t)(MP + n) * INW + c; const u32x2 a = *(const u32x2*)(zr + ZC_GA), b = *(const u32x2*)(zr + ZC_GB);
        const f32x4 pool = p0 + p1, attn = p2 + p3;
        u32x2 w; w.x = cvt_pk_bf16(bflo(a.x) * pool[0] + bflo(b.x) * attn[0], bfhi(a.x) * pool[1] + bfhi(b.x) * attn[1]);
        w.y = cvt_pk_bf16(bflo(a.y) * pool[2] + bflo(b.y) * attn[2], bfhi(a.y) * pool[3] + bfhi(b.y) * attn[3]);
        *(u32x2*)(O + (size_t)(MP + n) * D + c) = w; } };
struct SEpiX1 { const float* xs; float* out; bf16_t* X1B; float* sumsq;
    __device__ __forceinline__ void operator()(f32x4 p0, f32x4 p1, f32x4 p2, f32x4 p3, int n, int c, int fq) const {
        const f32x4 v = *(const f32x4*)(xs + (size_t)n * D + c) + ((p0 + p1) + (p2 + p3));
        *(f32x4*)(out + (size_t)(MP + n) * D + c) = v;
        u32x2 w; w.x = cvt_pk_bf16(v[0], v[1]); w.y = cvt_pk_bf16(v[2], v[3]); *(u32x2*)(X1B + (size_t)(MP + n) * D + c) = w;
        float ss = (v[0] * v[0] + v[1] * v[1]) + (v[2] * v[2] + v[3] * v[3]); ss += __shfl_xor(ss, 16); ss += __shfl_xor(ss, 32);
        if (fq == 0) atomicAdd(sumsq + MP + n, ss); } };
struct SEpiY { float* out;
    __device__ __forceinline__ void operator()(f32x4 p0, f32x4 p1, f32x4 p2, f32x4 p3, int n, int c, int fq) const {
        float* o = out + (size_t)(MP + n) * D + c; *(f32x4*)o = *(const f32x4*)o + ((p0 + p1) + (p2 + p3)); } };


__device__ __forceinline__ int crow(int r, int hi) { return (r & 3) + 8 * (r >> 2) + 4 * hi; }
constexpr int KS_STRIDE = 144, VT_STRIDE = 520, LDS_VT = 256 * KS_STRIDE  , LDS_SMP = 73728;

__device__ __forceinline__ void attn_prompt_unit(const Args& a, LAS unsigned char* lds, int unit) {
    const int tid = threadIdx.x, lane = tid & 63, wave = __builtin_amdgcn_readfirstlane(tid >> 6);
    const int kh = unit & 1, qb = (unit >> 1) & 15, b = unit >> 5;
    const bf16_t* Z = (const bf16_t*)(a.ws + WS_Z); bf16_t* YY = (bf16_t*)(a.ws + WS_RB);
    const float* qnw = a.in[7]; const float* knw = a.in[8]; const float* sinks = a.in[9];
    const size_t rowbase = (size_t)b * SEQ; const int key0 = (qb - 1) * 128;
    {
        const int j = tid >> 1, half = tid & 1, pos = key0 + j; float v[32];
        if (pos >= 0) { const u32x4* src = (const u32x4*)(Z + (rowbase + pos) * INW + ZC_K + kh * 64 + 32 * half);
#pragma unroll
            for (int c = 0; c < 4; ++c) { const u32x4 w = src[c];
#pragma unroll
                for (int e = 0; e < 4; ++e) { v[c * 8 + 2 * e] = bflo(w[e]); v[c * 8 + 2 * e + 1] = bfhi(w[e]); } } }
        else {
#pragma unroll
            for (int i = 0; i < 32; ++i) v[i] = 0.f; }
        float ss = 0.f;
#pragma unroll
        for (int i = 0; i < 32; ++i) ss += v[i] * v[i];
        ss += __shfl_xor(ss, 1);
        const float rstd = __builtin_amdgcn_rsqf(ss * (1.0f / 64) + EPS);
#pragma unroll
        for (int c = 0; c < 8; ++c) { const f32x4 w = *(const f32x4*)(knw + 32 * half + 4 * c);
#pragma unroll
            for (int e = 0; e < 4; ++e) v[4 * c + e] = v[4 * c + e] * rstd * w[e]; }
        LAS u32x4* dst = (LAS u32x4*)(lds + j * KS_STRIDE + 64 * half);
#pragma unroll
        for (int c = 0; c < 4; ++c) { u32x4 w;
#pragma unroll
            for (int e = 0; e < 4; ++e) w[e] = cvt_pk_bf16(v[c * 8 + 2 * e], v[c * 8 + 2 * e + 1]);
            dst[c] = w; }
        if (qb == 15 && j >= 128) { float* o = a.out + O_KP + ((size_t)(b * 128 + (j - 128)) * 2 + kh) * 64 + 32 * half;
#pragma unroll
            for (int c = 0; c < 8; ++c) *(f32x4*)(o + 4 * c) = (f32x4){v[4 * c], v[4 * c + 1], v[4 * c + 2], v[4 * c + 3]}; }
    }
#pragma unroll
    for (int i = 0; i < 4; ++i) { const int c = tid + 512 * i, key = c & 255, dch = c >> 8, pos = key0 + key;
        u32x4 w = (u32x4){0u, 0u, 0u, 0u};
        if (pos >= 0) w = *(const u32x4*)(Z + (rowbase + pos) * INW + ZC_V + kh * 64 + 8 * dch);
        LAS bf16_t* vt = (LAS bf16_t*)(lds + LDS_VT) + key;
#pragma unroll
        for (int e = 0; e < 4; ++e) { vt[(8 * dch + 2 * e) * (VT_STRIDE / 2)] = (bf16_t)(w[e] & 0xffffu); vt[(8 * dch + 2 * e + 1) * (VT_STRIDE / 2)] = (bf16_t)(w[e] >> 16); }
        if (qb == 15 && key >= 128) { float* o = a.out + O_VP + ((size_t)(b * 128 + (key - 128)) * 2 + kh) * 64 + 8 * dch;
            *(f32x4*)o = (f32x4){bflo(w[0]), bfhi(w[0]), bflo(w[1]), bfhi(w[1])}; *(f32x4*)(o + 4) = (f32x4){bflo(w[2]), bfhi(w[2]), bflo(w[3]), bfhi(w[3])}; } }
    __syncthreads();
    const int hq = 4 * kh + (wave >> 1), ql = lane & 31, h = lane >> 5;
    const float sink2 = sinks[hq] * LOG2E;
#pragma unroll 1
    for (int gi = 0; gi < 2; ++gi) {
        const int g = 2 * (wave & 1) + gi; const size_t qrow = rowbase + (size_t)qb * 128 + 32 * g + ql;
        bf16x8 qf[4];
        { float v[32]; const bf16_t* qp = Z + qrow * INW + ZC_Q + hq * 64 + 8 * h;
#pragma unroll
            for (int ds = 0; ds < 4; ++ds) { const u32x4 w = *(const u32x4*)(qp + 16 * ds);
#pragma unroll
                for (int e = 0; e < 4; ++e) { v[ds * 8 + 2 * e] = bflo(w[e]); v[ds * 8 + 2 * e + 1] = bfhi(w[e]); } }
            float ss = 0.f;
#pragma unroll
            for (int i = 0; i < 32; ++i) ss += v[i] * v[i];
            ss += __shfl_xor(ss, 32);
            const float sc = __builtin_amdgcn_rsqf(ss * (1.0f / 64) + EPS) * C2;
#pragma unroll
            for (int ds = 0; ds < 4; ++ds) { const f32x4 w0 = *(const f32x4*)(qnw + 16 * ds + 8 * h), w1 = *(const f32x4*)(qnw + 16 * ds + 8 * h + 4); u32x4 p;
                p.x = cvt_pk_bf16(v[ds * 8 + 0] * sc * w0[0], v[ds * 8 + 1] * sc * w0[1]); p.y = cvt_pk_bf16(v[ds * 8 + 2] * sc * w0[2], v[ds * 8 + 3] * sc * w0[3]);
                p.z = cvt_pk_bf16(v[ds * 8 + 4] * sc * w1[0], v[ds * 8 + 5] * sc * w1[1]); p.w = cvt_pk_bf16(v[ds * 8 + 6] * sc * w1[2], v[ds * 8 + 7] * sc * w1[3]);
                qf[ds] = __builtin_bit_cast(bf16x8, p); } }
        f32x16 sc[5];
#pragma unroll
        for (int i = 0; i < 5; ++i) { f32x16 acc = {};
#pragma unroll
            for (int ds = 0; ds < 4; ++ds) { const bf16x8 kf = *(const LAS bf16x8*)(lds + (32 * (g + i) + ql) * KS_STRIDE + 32 * ds + 16 * h);
                acc = __builtin_amdgcn_mfma_f32_32x32x16_bf16(kf, qf[ds], acc, 0, 0, 0); }
            sc[i] = acc; }
        const int qr = 32 * g + ql; float mx = -1e30f;
#pragma unroll
        for (int i = 0; i < 5; ++i)
#pragma unroll
            for (int r = 0; r < 16; ++r) { const int j = 32 * (g + i) + crow(r, h); const bool valid = (j >= qr) && (j <= qr + 128) && (qb > 0 || j >= 128);
                const float s = valid ? sc[i][r] : -1e30f; sc[i][r] = s; mx = fmaxf(mx, s); }
        mx = fmaxf(mx, __shfl_xor(mx, 32));
        const float mref = fmaxf(mx, sink2); float lsum = 0.f;
#pragma unroll
        for (int i = 0; i < 5; ++i)
#pragma unroll
            for (int r = 0; r < 16; ++r) { const float p = __builtin_amdgcn_exp2f(sc[i][r] - mref); sc[i][r] = p; lsum += p; }
        lsum += __shfl_xor(lsum, 32);
        const float inv = 1.0f / (lsum + __builtin_amdgcn_exp2f(sink2 - mref));
        f32x16 o[2]; o[0] = (f32x16){}; o[1] = (f32x16){};
#pragma unroll
        for (int i = 0; i < 5; ++i)
#pragma unroll
            for (int s2 = 0; s2 < 2; ++s2) { u32x4 pw;
#pragma unroll
                for (int e = 0; e < 4; ++e) pw[e] = cvt_pk_bf16(sc[i][8 * s2 + 2 * e], sc[i][8 * s2 + 2 * e + 1]);
                const bf16x8 pf = __builtin_bit_cast(bf16x8, pw);
#pragma unroll
                for (int dt = 0; dt < 2; ++dt) { const LAS unsigned char* vp = lds + LDS_VT + (32 * dt + ql) * VT_STRIDE + 2 * (32 * (g + i) + 16 * s2 + 4 * h);
                    const u32x2 lo = *(const LAS u32x2*)vp, hi2 = *(const LAS u32x2*)(vp + 16);
                    const u32x4 vw = (u32x4){lo.x, lo.y, hi2.x, hi2.y};
                    o[dt] = __builtin_amdgcn_mfma_f32_32x32x16_bf16(__builtin_bit_cast(bf16x8, vw), pf, o[dt], 0, 0, 0); } }
        bf16_t* yp = YY + qrow * D + 512 + hq * 64 + 4 * h;
#pragma unroll
        for (int dt = 0; dt < 2; ++dt)
#pragma unroll
            for (int rq = 0; rq < 4; ++rq) { u32x2 w; w.x = cvt_pk_bf16(o[dt][4 * rq] * inv, o[dt][4 * rq + 1] * inv); w.y = cvt_pk_bf16(o[dt][4 * rq + 2] * inv, o[dt][4 * rq + 3] * inv);
                *(u32x2*)(yp + 32 * dt + 8 * rq) = w; }
    }
    __syncthreads();
}

__device__ __forceinline__ void attn_sample_unit(const Args& a, LAS unsigned char* lds, int n) {
    const int tid = threadIdx.x, lane = tid & 63, wave = __builtin_amdgcn_readfirstlane(tid >> 6);
    const int hq = wave, kh = wave >> 2;
    const bf16_t* zrow = (const bf16_t*)(a.ws + WS_Z) + (size_t)(MP + n) * INW; bf16_t* YY = (bf16_t*)(a.ws + WS_RB);
    const float* ck = a.in[2] + (size_t)n * 16384; const float* cv = a.in[3] + (size_t)n * 16384;
    LAS float* qs = (LAS float*)(lds + LDS_SMP + wave * 1024); LAS float* ps = qs + 64;
    const float xq = bf1(zrow[ZC_Q + hq * 64 + lane]); const float ssq = wave_sum(xq * xq);
    const float qn = xq * __builtin_amdgcn_rsqf(ssq * (1.0f / 64) + EPS) * a.in[7][lane] * C2;
    const float xk = bf1(zrow[ZC_K + kh * 64 + lane]); const float ssk = wave_sum(xk * xk);
    const float kn = xk * __builtin_amdgcn_rsqf(ssk * (1.0f / 64) + EPS) * a.in[8][lane];
    const float vn = bf1(zrow[ZC_V + kh * 64 + lane]);
    const float s_new = wave_sum(qn * kn);
    if ((wave & 3) == 0) { a.out[O_KS + (size_t)n * 16384 + (127 * 2 + kh) * 64 + lane] = kn; a.out[O_VS + (size_t)n * 16384 + (127 * 2 + kh) * 64 + lane] = vn; }
    qs[lane] = qn; LDS_WAIT();
    float s0 = 0.f, s1 = 0.f;
    { const f32x4* k0 = (const f32x4*)(ck + (size_t)(lane * 2 + kh) * 64); const f32x4* k1 = (const f32x4*)(ck + (size_t)((lane + 64) * 2 + kh) * 64);
#pragma unroll
        for (int c = 0; c < 16; ++c) { const f32x4 q4 = *(const LAS f32x4*)(qs + 4 * c), x0 = k0[c], x1 = k1[c];
            s0 += (q4[0] * x0[0] + q4[1] * x0[1]) + (q4[2] * x0[2] + q4[3] * x0[3]); s1 += (q4[0] * x1[0] + q4[1] * x1[1]) + (q4[2] * x1[2] + q4[3] * x1[3]); } }
    const float sink2 = a.in[9][hq] * LOG2E;
    const float mref = fmaxf(fmaxf(wave_max(fmaxf(s0, s1)), s_new), sink2);
    const float p0 = __builtin_amdgcn_exp2f(s0 - mref), p1 = __builtin_amdgcn_exp2f(s1 - mref), pn = __builtin_amdgcn_exp2f(s_new - mref);
    const float l = wave_sum(p0 + p1) + pn + __builtin_amdgcn_exp2f(sink2 - mref);
    ps[lane] = p0; ps[lane + 64] = p1; LDS_WAIT();
    float o = pn * vn;
#pragma unroll 8
    for (int j = 0; j < 128; ++j) o += ps[j] * cv[(size_t)(j * 2 + kh) * 64 + lane];
    YY[(size_t)(MP + n) * D + 512 + hq * 64 + lane] = (bf16_t)(cvt_pk_bf16(o / l, 0.f) & 0xffffu);
    { const f32x4* sk = (const f32x4*)(ck + 128); const f32x4* sv = (const f32x4*)(cv + 128); f32x4* dk = (f32x4*)(a.out + O_KS + (size_t)n * 16384); f32x4* dv = (f32x4*)(a.out + O_VS + (size_t)n * 16384);
        for (int i = tid; i < 127 * 32; i += 512) { dk[i] = sk[i]; dv[i] = sv[i]; } }
    LDS_WAIT();
}

__device__ __forceinline__ void pool_items(const Args& a, int gtid, int gthreads) {
    const bf16_t* Z = (const bf16_t*)(a.ws + WS_Z); bf16_t* YPRE = (bf16_t*)(a.ws + WS_YPRE); const float* sp = a.in[4];
    for (int it = gtid; it < MV * 64; it += gthreads) {
        const int row = it >> 6, cg8 = it & 63, c0 = 8 * cg8, w = 2 << (cg8 >> 4);
        const u32x4 un = *(const u32x4*)(Z + (size_t)row * INW + c0);
        float u[8], s[8];
#pragma unroll
        for (int e = 0; e < 4; ++e) { u[2 * e] = bflo(un[e]); u[2 * e + 1] = bfhi(un[e]); }
#pragma unroll
        for (int e = 0; e < 8; ++e) s[e] = u[e];
        float rc;
        if (row < MP) {
            const int b = row >> 11, t = row & 2047, cnt = min(w, t + 1); rc = 1.0f / (float)cnt;
            for (int i = 1; i < cnt; ++i) { const u32x4 x = *(const u32x4*)(Z + (size_t)(row - i) * INW + c0);
#pragma unroll
                for (int e = 0; e < 4; ++e) { s[2 * e] += bflo(x[e]); s[2 * e + 1] += bfhi(x[e]); } }
            if (t >= SEQ - 15) { float* o = a.out + O_PP + ((size_t)b * 15 + (t - (SEQ - 15))) * PW + c0;
                *(f32x4*)o = (f32x4){u[0], u[1], u[2], u[3]}; *(f32x4*)(o + 4) = (f32x4){u[4], u[5], u[6], u[7]}; }
        } else {
            const int n = row - MP; rc = 1.0f / (float)w; const float* st = sp + (size_t)n * 15 * PW + c0;
            for (int i = 1; i < w; ++i) { const f32x4 x0 = *(const f32x4*)(st + (size_t)(15 - i) * PW), x1 = *(const f32x4*)(st + (size_t)(15 - i) * PW + 4);
#pragma unroll
                for (int e = 0; e < 4; ++e) { s[e] += x0[e]; s[4 + e] += x1[e]; } }
            float* o = a.out + O_PS + (size_t)n * 15 * PW + c0;
            for (int i = 0; i < 14; ++i) { *(f32x4*)(o + (size_t)i * PW) = *(const f32x4*)(st + (size_t)(i + 1) * PW); *(f32x4*)(o + (size_t)i * PW + 4) = *(const f32x4*)(st + (size_t)(i + 1) * PW + 4); }
            *(f32x4*)(o + 14 * PW) = (f32x4){u[0], u[1], u[2], u[3]}; *(f32x4*)(o + 14 * PW + 4) = (f32x4){u[4], u[5], u[6], u[7]};
        }
        u32x4 y;
#pragma unroll
        for (int e = 0; e < 4; ++e) y[e] = cvt_pk_bf16(s[2 * e] * rc - u[2 * e], s[2 * e + 1] * rc - u[2 * e + 1]);
        *(u32x4*)(YPRE + (size_t)row * PW + c0) = y;
    }
}

__global__ void __launch_bounds__(512, 2) fwd_megakernel(Args a) {
    extern __shared__ __attribute__((aligned(16))) unsigned char lds_raw[];
    LAS unsigned char* lds = (LAS unsigned char*)lds_raw;
    cg::grid_group grid = cg::this_grid();
    const int tid = threadIdx.x, lane = tid & 63, wave = __builtin_amdgcn_readfirstlane(tid >> 6);
    const int G = gridDim.x, bx = blockIdx.x;
    const int vcu = (G % 8 == 0) ? (bx % 8) * (G / 8) + bx / 8 : bx;
    unsigned char* ws = a.ws;
    bf16_t* WIN = (bf16_t*)(ws + WS_WIN); bf16_t* WMIX = (bf16_t*)(ws + WS_MIX); bf16_t* WCAT = (bf16_t*)(ws + WS_WCAT); bf16_t* WOUT = (bf16_t*)(ws + WS_WOUT);
    bf16_t* WGU = (bf16_t*)(ws + WS_WGU); bf16_t* WDN = (bf16_t*)(ws + WS_WDN);
    bf16_t* RA = (bf16_t*)(ws + WS_RA); bf16_t* RB = (bf16_t*)(ws + WS_RB); bf16_t* YPRE = (bf16_t*)(ws + WS_YPRE); bf16_t* Z = (bf16_t*)(ws + WS_Z);
    float* SUMSQ = (float*)(ws + WS_SUMSQ);
    const int lo = a.ph_lo, hi = a.ph_hi;
#ifndef PH_MASK
#define PH_MASK 255
#endif
#define IN(k) (((PH_MASK >> (k)) & 1) && lo <= (k) && (k) < hi)
#define SEAM(k) do { if (IN(k) && IN((k) + 1)) grid.sync(); } while (0)

    if (IN(0)) {
        LAS float* scr = (LAS float*)(lds + wave * 16384);
        const int gw = vcu * 8 + wave, NGW = G * 8;
        constexpr int I_IN = 16 * 104, I_MIX = 4 * 16, I_CAT = 16 * 32, I_OUT = 16 * 32, I_GU = 16 * 176, I_DN = 44 * 32;
        constexpr int NITEMS = I_IN + I_MIX + I_CAT + I_OUT + I_GU + I_DN;
        for (int it = gw; it < NITEMS; it += NGW) {
            int r = it;
            if (r < I_IN) { transpose_item(SrcPlain{a.in[6], INW}, WIN, D, 104, r, scr, lane); continue; } r -= I_IN;
            if (r < I_MIX) { transpose_item(SrcMix{a.in[10], a.in[11]}, WMIX, 256, 16, r, scr, lane); continue; } r -= I_MIX;
            if (r < I_CAT) { transpose_item(SrcCat{a.in[12], a.in[13]}, WCAT, D, 32, r, scr, lane); continue; } r -= I_CAT;
            if (r < I_OUT) { transpose_item(SrcPlain{a.in[14], D}, WOUT, D, 32, r, scr, lane); continue; } r -= I_OUT;
            if (r < I_GU) { transpose_item(SrcGU{a.in[16], a.in[17], a.in[15]}, WGU, D, 176, r, scr, lane); continue; } r -= I_GU;
            transpose_item(SrcPlain{a.in[18], D}, WDN, FF, 32, r, scr, lane);
        }
        const float* g1 = a.in[5];
        for (int m = gw; m < MPAD; m += NGW) {
            unsigned long long* o8 = (unsigned long long*)(RA + (size_t)m * D) + lane;
            if (m < MV) {
                const f32x4* xr = (const f32x4*)(m < MP ? a.in[0] + (size_t)m * D : a.in[1] + (size_t)(m - MP) * D) + lane;
                f32x4 v[4]; float s = 0.f;
#pragma unroll
                for (int j = 0; j < 4; ++j) { v[j] = xr[64 * j]; s += (v[j].x * v[j].x + v[j].y * v[j].y) + (v[j].z * v[j].z + v[j].w * v[j].w); }
                const float rstd = __builtin_amdgcn_rsqf(wave_sum(s) * (1.f / D) + EPS);
#pragma unroll
                for (int j = 0; j < 4; ++j) { const f32x4 gg = ((const f32x4*)g1)[lane + 64 * j];
                    o8[64 * j] = (unsigned long long)cvt_pk_bf16(v[j].x * rstd * gg.x, v[j].y * rstd * gg.y) | ((unsigned long long)cvt_pk_bf16(v[j].z * rstd * gg.z, v[j].w * rstd * gg.w) << 32); }
            } else {
#pragma unroll
                for (int j = 0; j < 4; ++j) o8[64 * j] = 0ull;
                unsigned long long* y8 = (unsigned long long*)(RB + (size_t)m * D) + lane;
#pragma unroll
                for (int j = 0; j < 4; ++j) y8[64 * j] = 0ull;
                unsigned long long* p8 = (unsigned long long*)(YPRE + (size_t)m * PW) + lane;
                p8[0] = 0ull; p8[64] = 0ull;
            }
        }
        for (int i = vcu * 512 + tid; i < MPAD; i += G * 512) SUMSQ[i] = 0.f;
    }
    SEAM(0);
    if (IN(1)) {
        pg8::Gemm g{RA, WIN, D, D, D, 0, -1}; pg8::StaticOrder S; S.init(MPAD, INW, G, bx);
        pg8::gemm_phase(lds, g, S, pg8::EpiZ{Z});
    }
    SEAM(1);
    if (IN(2)) {
        for (int u = vcu; u < 256; u += G) attn_prompt_unit(a, lds, u);
        for (int n = vcu; n < NS; n += G) attn_sample_unit(a, lds, n);
        pool_items(a, vcu * 512 + tid, G * 512);
    }
    SEAM(2);
    if (IN(3)) {
        pg8::Gemm g{YPRE, WMIX, PW, 256, 256, 512, -1}; pg8::StaticOrder S; S.init(MPAD, PW, G, bx);
        pg8::gemm_phase(lds, g, S, pg8::EpiBf{RB, D});
    }
    SEAM(3);
    if (IN(4)) {
        small_gemm(lds, RB + (size_t)MP * D, D, WCAT, D, D, vcu, G, SEpiMerge{Z, RA});
        pg8::Gemm g{RB, WCAT, D, D, D, 0, 8}; pg8::StaticOrder S; S.init(MP, D, G, bx);
        pg8::gemm_phase(lds, g, S, pg8::EpiMerge{Z, RA});
    }
    SEAM(4);
    if (IN(5)) {
        small_gemm(lds, RA + (size_t)MP * D, D, WOUT, D, D, vcu, G, SEpiX1{a.in[1], a.out + O_Y, RB, SUMSQ});
        pg8::Gemm g{RA, WOUT, D, D, D, 0, -1}; pg8::StaticOrder S; S.init(MP, D, G, bx);
        pg8::gemm_phase(lds, g, S, pg8::EpiX1{a.in[0], a.in[1], a.out + O_Y, RB, SUMSQ});
    }
    SEAM(5);
    if (IN(6)) {
        pg8::Gemm g{RB, WGU, D, D, D, 0, -1}; pg8::StaticOrder S; S.init(MPAD, 2 * FF, G, bx);
        pg8::gemm_phase(lds, g, S, pg8::EpiAct{SUMSQ, Z});
    }
    SEAM(6);
    if (IN(7)) {
        small_gemm(lds, Z + (size_t)MP * FF, FF, WDN, FF, FF, vcu, G, SEpiY{a.out + O_Y});
        pg8::Gemm g{Z, WDN, FF, FF, FF, 0, -1}; pg8::StaticOrder S; S.init(MP, D, G, bx);
        pg8::gemm_phase(lds, g, S, pg8::EpiY{a.out + O_Y});
    }
#undef IN
#undef SEAM
}

#ifndef MK_N_LAUNCHES
#define MK_N_LAUNCHES 1
#endif
extern "C" void kernel_launch(void* const* d_in, const int* in_sizes, int n_in, void* d_out, int out_size, void* d_ws, size_t ws_size, hipStream_t stream) {
    static int grid = 0;
    if (grid == 0) {
        int dev = 0, cus = 0, per_cu = 0;
        if (n_in != 19 || ws_size < WS_END) { fprintf(stderr, "kernel_launch: unexpected inputs (n_in %d, ws %zu)\n", n_in, ws_size); grid = -1; return; }
        hipGetDevice(&dev); hipDeviceGetAttribute(&cus, hipDeviceAttributeMultiprocessorCount, dev);
        if (hipFuncSetAttribute((const void*)fwd_megakernel, hipFuncAttributeMaxDynamicSharedMemorySize, LDS_BYTES) != hipSuccess) { fprintf(stderr, "kernel_launch: hipFuncSetAttribute failed\n"); grid = -1; return; }
        if (hipOccupancyMaxActiveBlocksPerMultiprocessor(&per_cu, (const void*)fwd_megakernel, 512, LDS_BYTES) != hipSuccess || per_cu < 1) { fprintf(stderr, "kernel_launch: occupancy query says %d\n", per_cu); per_cu = 1; }
        (void)hipGetLastError();
        grid = cus * 1;
        if (per_cu < 1) grid = -1;
    }
    if (grid < 0) return;
    Args a{};
    for (int i = 0; i < 19; ++i) a.in[i] = (const float*)d_in[i];
    a.out = (float*)d_out; a.ws = (unsigned char*)d_ws;
#if MK_N_LAUNCHES == 1
    a.ph_lo = 0; a.ph_hi = 8;
    void* args[] = {&a};
    hipError_t e = hipLaunchCooperativeKernel((const void*)fwd_megakernel, dim3(grid), dim3(512), args, LDS_BYTES, stream);
    if (e != hipSuccess) fprintf(stderr, "cooperative launch failed: %s (grid %d)\n", hipGetErrorString(e), grid);
#else
    for (int p = 0; p < 8; ++p) { a.ph_lo = p; a.ph_hi = p + 1; hipLaunchKernelGGL(fwd_megakernel, dim3(grid), dim3(512), LDS_BYTES, stream, a); }
#endif
}
```

```cpp
#include <hip/hip_runtime.h>
#include <hip/hip_cooperative_groups.h>
#include <cstdio>
#include <cstdint>
namespace cg = cooperative_groups;

#define LAS __attribute__((address_space(3)))
typedef unsigned short bf16_t;
typedef short bf16x8 __attribute__((ext_vector_type(8)));
typedef short s16x4 __attribute__((ext_vector_type(4)));
typedef float f32x4 __attribute__((ext_vector_type(4)));
typedef float f32x16 __attribute__((ext_vector_type(16)));
typedef unsigned u32x4 __attribute__((ext_vector_type(4)));
typedef unsigned u32x2 __attribute__((ext_vector_type(2)));

constexpr int D = 1024, SEQ = 2048, NB = 8, MP = NB * SEQ, NS = 128, MV = MP + NS, MPAD = 16640;
constexpr int INW = 3328, FF = 2816, PW = 512;
constexpr int ZC_Q = 512, ZC_K = 1024, ZC_V = 1152, ZC_GA = 1280, ZC_GB = 2304;
constexpr float EPS = 1e-6f;
constexpr float LOG2E = 1.4426950408889634f;
constexpr float C2 = 0.125f * LOG2E;
constexpr size_t O_Y = 0, O_KP = 16908288, O_VP = 17039360, O_PP = 17170432, O_KS = 17231872, O_VS = 19329024, O_PS = 21426176;
constexpr size_t MiB = 1u << 20;
constexpr size_t WS_SUMSQ = 0;
constexpr size_t WS_BAR = 1 * MiB, WS_BAR_BYTES = 16384;
constexpr size_t WS_WIN = 2 * MiB, WS_MIX = 9 * MiB, WS_WCAT = 10 * MiB, WS_WOUT = 12 * MiB, WS_WGU = 14 * MiB, WS_WDN = 25 * MiB;
constexpr size_t WS_RA = 32 * MiB;
constexpr size_t WS_RB = 65 * MiB;
constexpr size_t WS_YPRE = 98 * MiB;
constexpr size_t WS_Z = 115 * MiB;
constexpr size_t WS_END = 222 * MiB;
constexpr int LDS_BYTES = 147456;
constexpr int LDS_MISC = 135168;

__device__ __forceinline__ unsigned cvt_pk_bf16(float lo, float hi) { unsigned r; asm("v_cvt_pk_bf16_f32 %0, %1, %2" : "=v"(r) : "v"(lo), "v"(hi)); return r; }
__device__ __forceinline__ float bflo(unsigned u) { return __uint_as_float(u << 16); }
__device__ __forceinline__ float bfhi(unsigned u) { return __uint_as_float(u & 0xffff0000u); }
__device__ __forceinline__ float bf1(bf16_t u) { return __uint_as_float(((unsigned)u) << 16); }
__device__ __forceinline__ float fsigmoid(float x) { return __builtin_amdgcn_rcpf(1.0f + __builtin_amdgcn_exp2f(-x * LOG2E)); }
__device__ __forceinline__ float wave_sum(float v) {
#pragma unroll
    for (int o = 1; o < 64; o <<= 1) v += __shfl_xor(v, o);
    return v;
}
__device__ __forceinline__ float wave_max(float v) {
#pragma unroll
    for (int o = 1; o < 64; o <<= 1) v = fmaxf(v, __shfl_xor(v, o));
    return v;
}
#define LDS_WAIT() asm volatile("s_waitcnt lgkmcnt(0)" ::: "memory")

namespace pg8 {
constexpr int BM = 256, BK = 64, HALF = 128, HTB = HALF * BK * 2, STAGE_BYTES = 8 * HTB, NXCD = 8, WGM = 8;
__host__ __device__ __forceinline__ int lds_byte(int r, int c) { const int st = (r >> 4) * 2 + (c >> 5), rr = r & 15, cc = c & 31, ob = rr * 64 + cc * 2; return st * 1024 + (ob ^ (((ob >> 9) & 1) << 5)); }
__host__ __device__ __forceinline__ void stage_rc(int b, int& R, int& C) { const int st = b / 1024, sb = b % 1024, swz = sb ^ (((sb >> 9) & 1) << 5); R = (st >> 1) * 16 + swz / 64; C = (st & 1) * 32 + (swz % 64) / 2; }
__host__ __device__ __forceinline__ int perm32(int rho) { const int n = rho >> 4, i = rho & 15; return 8 * (i >> 2) + 4 * n + (i & 3); }

struct Unit { int pm, pn; };
struct Gemm { const bf16_t* A; const bf16_t* Bt; int lda, ldb, K, a_pn_bytes, midt; };

struct StaticOrder {
    int nM, nN, nwg, G, c;
    __device__ void init(int M, int N, int G_, int c_) { nM = M / BM; nN = N / BM; nwg = nM * nN; G = G_; c = c_; }
    __device__ bool next(int i, Unit& u) const {
        const long L = (long)i * G + c; if (L >= nwg) return false;
        int wgid = (int)L; { const int q = nwg / NXCD, r = nwg % NXCD, xcd = wgid % NXCD, off = wgid / NXCD; wgid = (xcd < r ? xcd * (q + 1) : r * (q + 1) + (xcd - r) * q) + off; }
        const int nig = WGM * nN, gid = wgid / nig, fm = gid * WGM, gsz = (nM - fm) < WGM ? (nM - fm) : WGM;
        u.pm = fm + ((wgid % nig) % gsz); u.pn = (wgid % nig) / gsz; return true;
    }
};

template <class Epi>
__device__ __forceinline__ void gemm_phase(LAS unsigned char* lds, const Gemm g, const StaticOrder& S, const Epi& E) {
    const int tid = threadIdx.x, wid = __builtin_amdgcn_readfirstlane(tid >> 6), lane = tid & 63, wr = wid >> 2, wc = wid & 3, fr = lane & 15, fq = lane >> 4;
    const int K = g.K, nt = K / BK;
    unsigned voffA[2], voffB[2];
#pragma unroll
    for (int i = 0; i < 2; ++i) { int R, C; stage_rc(tid * 16 + i * 8192, R, C); const int Rb = (R & ~31) + perm32(R & 31);
        voffA[i] = (unsigned)(R * g.lda + C) * 2u; voffB[i] = (unsigned)(Rb * g.ldb + C) * 2u; }
    const size_t kstep = (size_t)(BK * 2);
    const size_t hstepA = (size_t)HALF * g.lda * 2, hstepB = (size_t)HALF * g.ldb * 2;
    const size_t tstepA = 2 * hstepA, tstepB = 2 * hstepB;
    const unsigned ldsw = (unsigned)wid * 1024u;
    const int aoff = lds_byte(wr * 64 + fr, fq * 8), boff = lds_byte(wc * 32 + fr, fq * 8);
#define PG8_SA(b, h) (((b) * 2 + (h)) * HTB)
#define PG8_SB(b, h) ((4 + (b) * 2 + (h)) * HTB)
#define PG8_STAGE(bufoff, gbase, voff) do { _Pragma("unroll") for (int _i = 0; _i < 2; ++_i) \
        __builtin_amdgcn_global_load_lds((const unsigned*)((const char*)(gbase) + (voff)[_i]), (LAS unsigned*)(lds + (bufoff) + ldsw + _i * 8192), 16, 0, 0); } while (0)
#define PG8_LDA(dst, b, h) do { _Pragma("unroll") for (int m = 0; m < 4; ++m) _Pragma("unroll") for (int k = 0; k < 2; ++k) dst[m][k] = *(const LAS bf16x8*)(lds + PG8_SA(b, h) + aoff + m * 2048 + k * 1024); } while (0)
#define PG8_LDB(dst, b, h) do { _Pragma("unroll") for (int n = 0; n < 2; ++n) _Pragma("unroll") for (int k = 0; k < 2; ++k) dst[n][k] = *(const LAS bf16x8*)(lds + PG8_SB(b, h) + boff + n * 2048 + k * 1024); } while (0)
#define PG8_MMA(ai, bj, At, Bt) do { __builtin_amdgcn_s_setprio(1); _Pragma("unroll") for (int m = 0; m < 4; ++m) _Pragma("unroll") for (int n = 0; n < 2; ++n) _Pragma("unroll") for (int k = 0; k < 2; ++k) \
        acc[ai][bj][m][n] = __builtin_amdgcn_mfma_f32_16x16x32_bf16(Bt[n][k], At[m][k], acc[ai][bj][m][n], 0, 0, 0); __builtin_amdgcn_s_setprio(0); } while (0)
#define PG8_WAIT_V(n) asm volatile("s_waitcnt vmcnt(" #n ")" ::: "memory")
#define PG8_WAIT_L(n) asm volatile("s_waitcnt lgkmcnt(" #n ")" ::: "memory")
#define PG8_BAR __builtin_amdgcn_s_barrier()
#define PG8_SCHED __builtin_amdgcn_sched_barrier(0)
    Unit cur, nxt; int ui = 0;
    if (!S.next(0, cur)) return;
    f32x4 acc[2][2][4][2];
#pragma unroll
    for (int a = 0; a < 2; ++a)
#pragma unroll
        for (int b = 0; b < 2; ++b)
#pragma unroll
            for (int m = 0; m < 4; ++m)
#pragma unroll
                for (int n = 0; n < 2; ++n) acc[a][b][m][n] = (f32x4){0.f, 0.f, 0.f, 0.f};
    bf16x8 At[4][2], B0[2][2], B1[2][2];
    const char* cA = (const char*)g.A + (size_t)cur.pm * tstepA + (size_t)cur.pn * g.a_pn_bytes; const char* cB = (const char*)g.Bt + (size_t)cur.pn * tstepB;
    PG8_STAGE(PG8_SB(0, 0), cB, voffB); PG8_STAGE(PG8_SB(0, 1), cB + hstepB, voffB); PG8_STAGE(PG8_SA(0, 0), cA, voffA); PG8_STAGE(PG8_SA(0, 1), cA + hstepA, voffA);
    if (wr == 1) PG8_BAR;
    PG8_WAIT_V(2); PG8_BAR;
    PG8_STAGE(PG8_SB(1, 0), cB + kstep, voffB); PG8_STAGE(PG8_SA(1, 0), cA + kstep, voffA); PG8_STAGE(PG8_SB(1, 1), cB + hstepB + kstep, voffB);
    PG8_WAIT_V(6); PG8_BAR;
    for (;;) {
        const bool has_next = S.next(ui + 1, nxt);
        const char* nA = has_next ? (const char*)g.A + (size_t)nxt.pm * tstepA + (size_t)nxt.pn * g.a_pn_bytes : cA; const char* nB = has_next ? (const char*)g.Bt + (size_t)nxt.pn * tstepB : cB;
#pragma unroll 1
        for (int t = 0; t < nt; t += 2) {
            const bool last = (t == nt - 2);
            if constexpr (Epi::HAS_MID) { if (t == g.midt) { E.mid(acc, cur, wr, wc, fr, fq); } PG8_SCHED; }
            const char* a1 = cA + (size_t)(t + 1) * kstep;
            const char* a2 = last ? nA : cA + (size_t)(t + 2) * kstep; const char* b2 = last ? nB : cB + (size_t)(t + 2) * kstep;
            const char* a3 = a2 + kstep; const char* b3 = b2 + kstep;
            PG8_LDB(B0, 0, 0); PG8_LDB(B1, 0, 1); PG8_SCHED; PG8_LDA(At, 0, 0); PG8_STAGE(PG8_SA(1, 1), a1 + hstepA, voffA);
            PG8_WAIT_V(8); PG8_WAIT_L(0); PG8_BAR; PG8_MMA(0, 0, At, B0); PG8_MMA(0, 1, At, B1); PG8_BAR; PG8_SCHED;
            PG8_LDA(At, 0, 1); PG8_STAGE(PG8_SB(0, 0), b2, voffB); PG8_STAGE(PG8_SB(0, 1), b2 + hstepB, voffB); PG8_STAGE(PG8_SA(0, 0), a2, voffA);
            PG8_WAIT_V(8); PG8_WAIT_L(0); PG8_BAR; PG8_MMA(1, 0, At, B0); PG8_MMA(1, 1, At, B1); PG8_BAR; PG8_SCHED;
            PG8_LDB(B0, 1, 0); PG8_LDB(B1, 1, 1); PG8_SCHED; PG8_LDA(At, 1, 0); PG8_STAGE(PG8_SA(0, 1), a2 + hstepA, voffA);
            PG8_WAIT_V(8); PG8_WAIT_L(0); PG8_BAR; PG8_MMA(0, 0, At, B0); PG8_MMA(0, 1, At, B1); PG8_BAR; PG8_SCHED;
            PG8_LDA(At, 1, 1); PG8_STAGE(PG8_SB(1, 0), b3, voffB); PG8_STAGE(PG8_SB(1, 1), b3 + hstepB, voffB); PG8_STAGE(PG8_SA(1, 0), a3, voffA);
            PG8_WAIT_V(8); PG8_WAIT_L(0); PG8_BAR; PG8_MMA(1, 0, At, B0); PG8_MMA(1, 1, At, B1); PG8_BAR; PG8_SCHED;
        }
        if (wr == 0) PG8_BAR;
        E(acc, cur, wr, wc, fr, fq);
        if (!has_next) break;
#pragma unroll
        for (int a = 0; a < 2; ++a)
#pragma unroll
            for (int b = 0; b < 2; ++b)
#pragma unroll
                for (int m = 0; m < 4; ++m)
#pragma unroll
                    for (int n = 0; n < 2; ++n) acc[a][b][m][n] = (f32x4){0.f, 0.f, 0.f, 0.f};
        cur = nxt; cA = nA; cB = nB; ++ui;
        if (wr == 1) PG8_BAR;
    }
    PG8_WAIT_V(0);
    PG8_BAR;
#undef PG8_SA
#undef PG8_SB
#undef PG8_STAGE
#undef PG8_LDA
#undef PG8_LDB
#undef PG8_MMA
#undef PG8_WAIT_V
#undef PG8_WAIT_L
#undef PG8_BAR
#undef PG8_SCHED
}

typedef f32x4 Acc[2][2][4][2];
__device__ __forceinline__ u32x4 pack8(const f32x4 v0, const f32x4 v1) { u32x4 w; w.x = cvt_pk_bf16(v0[0], v0[1]); w.y = cvt_pk_bf16(v0[2], v0[3]); w.z = cvt_pk_bf16(v1[0], v1[1]); w.w = cvt_pk_bf16(v1[2], v1[3]); return w; }

struct EpiZ {
    static constexpr bool HAS_MID = false;
    bf16_t* Z;
    __device__ __forceinline__ void operator()(Acc& acc, const Unit& u, int wr, int wc, int fr, int fq) const {
        int row0 = u.pm * BM + wr * 64 + fr; asm volatile("" : "+v"(row0)); const int col0 = u.pn * BM + wc * 32 + 8 * fq; const bool sig = u.pn >= 5;
#pragma unroll
        for (int ai = 0; ai < 2; ++ai)
#pragma unroll
            for (int m = 0; m < 4; ++m) { bf16_t* rowp = Z + (size_t)(row0 + ai * HALF + m * 16) * INW + col0;
#pragma unroll
                for (int bj = 0; bj < 2; ++bj) { f32x4 v0 = acc[ai][bj][m][0], v1 = acc[ai][bj][m][1];
                    if (sig) {
#pragma unroll
                        for (int e = 0; e < 4; ++e) { v0[e] = fsigmoid(v0[e]); v1[e] = fsigmoid(v1[e]); } }
                    *(u32x4*)(rowp + bj * HALF) = pack8(v0, v1); } }
    }
};
struct EpiBf {
    static constexpr bool HAS_MID = false;
    bf16_t* O; int ldc;
    __device__ __forceinline__ void operator()(Acc& acc, const Unit& u, int wr, int wc, int fr, int fq) const {
        int row0 = u.pm * BM + wr * 64 + fr; asm volatile("" : "+v"(row0)); const int col0 = u.pn * BM + wc * 32 + 8 * fq;
#pragma unroll
        for (int ai = 0; ai < 2; ++ai)
#pragma unroll
            for (int m = 0; m < 4; ++m) { bf16_t* rowp = O + (size_t)(row0 + ai * HALF + m * 16) * ldc + col0;
#pragma unroll
                for (int bj = 0; bj < 2; ++bj) *(u32x4*)(rowp + bj * HALF) = pack8(acc[ai][bj][m][0], acc[ai][bj][m][1]); }
    }
};
struct EpiMerge {
    static constexpr bool HAS_MID = true;
    const bf16_t* Z; bf16_t* O;
    __device__ __forceinline__ void mid(Acc& acc, const Unit& u, int wr, int wc, int fr, int fq) const {
        int row0 = u.pm * BM + wr * 64 + fr; asm volatile("" : "+v"(row0)); const int col0 = u.pn * BM + wc * 32 + 8 * fq;
#pragma unroll
        for (int ai = 0; ai < 2; ++ai)
#pragma unroll
            for (int m = 0; m < 4; ++m) { const bf16_t* zr = Z + (size_t)(row0 + ai * HALF + m * 16) * INW + col0;
#pragma unroll
                for (int bj = 0; bj < 2; ++bj) { const u32x4 a = *(const u32x4*)(zr + ZC_GA + bj * HALF), b = *(const u32x4*)(zr + ZC_GB + bj * HALF);
#pragma unroll
                    for (int e = 0; e < 4; ++e) { const float r0 = bflo(a[e]) * __builtin_amdgcn_rcpf(bflo(b[e])), r1 = bfhi(a[e]) * __builtin_amdgcn_rcpf(bfhi(b[e]));
                        acc[ai][bj][m][e >> 1][(e & 1) * 2] *= r0; acc[ai][bj][m][e >> 1][(e & 1) * 2 + 1] *= r1; } }
                asm volatile("" ::: "memory"); }
    }
    __device__ __forceinline__ void operator()(Acc& acc, const Unit& u, int wr, int wc, int fr, int fq) const {
        int row0 = u.pm * BM + wr * 64 + fr; asm volatile("" : "+v"(row0)); const int col0 = u.pn * BM + wc * 32 + 8 * fq;
#pragma unroll
        for (int ai = 0; ai < 2; ++ai)
#pragma unroll
            for (int m = 0; m < 4; ++m) { const size_t row = (size_t)(row0 + ai * HALF + m * 16); const bf16_t* zr = Z + row * INW + col0; bf16_t* rowp = O + row * D + col0;
#pragma unroll
                for (int bj = 0; bj < 2; ++bj) { const u32x4 b = *(const u32x4*)(zr + ZC_GB + bj * HALF); f32x4 v0 = acc[ai][bj][m][0], v1 = acc[ai][bj][m][1];
                    v0[0] *= bflo(b[0]); v0[1] *= bfhi(b[0]); v0[2] *= bflo(b[1]); v0[3] *= bfhi(b[1]); v1[0] *= bflo(b[2]); v1[1] *= bfhi(b[2]); v1[2] *= bflo(b[3]); v1[3] *= bfhi(b[3]);
                    *(u32x4*)(rowp + bj * HALF) = pack8(v0, v1); } }
    }
};
struct EpiX1 {
    static constexpr bool HAS_MID = false;
    const float* xp; const float* xs; float* out; bf16_t* X1B; float* sumsq;
    __device__ __forceinline__ void operator()(Acc& acc, const Unit& u, int wr, int wc, int fr, int fq) const {
        int row0 = u.pm * BM + wr * 64 + fr; asm volatile("" : "+v"(row0)); const int col0 = u.pn * BM + wc * 32 + 8 * fq;
#pragma unroll
        for (int ai = 0; ai < 2; ++ai)
#pragma unroll
            for (int m = 0; m < 4; ++m) { const int row = row0 + ai * HALF + m * 16; const bool valid = row < MV;
                const float* xr = (row < MP ? xp + (size_t)row * D : xs + (size_t)(valid ? row - MP : 0) * D) + col0;
                float ss = 0.f;
#pragma unroll
                for (int bj = 0; bj < 2; ++bj) { f32x4 v0 = acc[ai][bj][m][0], v1 = acc[ai][bj][m][1];
                    if (valid) { v0 += *(const f32x4*)(xr + bj * HALF); v1 += *(const f32x4*)(xr + bj * HALF + 4);
                        *(f32x4*)(out + (size_t)row * D + col0 + bj * HALF) = v0; *(f32x4*)(out + (size_t)row * D + col0 + bj * HALF + 4) = v1; }
                    ss += (v0[0] * v0[0] + v0[1] * v0[1]) + (v0[2] * v0[2] + v0[3] * v0[3]) + (v1[0] * v1[0] + v1[1] * v1[1]) + (v1[2] * v1[2] + v1[3] * v1[3]);
                    *(u32x4*)(X1B + (size_t)row * D + col0 + bj * HALF) = pack8(v0, v1); }
                ss += __shfl_xor(ss, 16); ss += __shfl_xor(ss, 32);
                if (fq == 0) atomicAdd(sumsq + row, ss); }
    }
};
struct EpiAct {
    static constexpr bool HAS_MID = false;
    const float* sumsq; bf16_t* ACT;
    __device__ __forceinline__ void operator()(Acc& acc, const Unit& u, int wr, int wc, int fr, int fq) const {
        int row0 = u.pm * BM + wr * 64 + fr; asm volatile("" : "+v"(row0)); const int col0 = u.pn * HALF + wc * 32 + 8 * fq;
#pragma unroll
        for (int ai = 0; ai < 2; ++ai)
#pragma unroll
            for (int m = 0; m < 4; ++m) { const int row = row0 + ai * HALF + m * 16; const float rstd = __builtin_amdgcn_rsqf(sumsq[row] * (1.0f / D) + EPS);
                f32x4 o[2];
#pragma unroll
                for (int n = 0; n < 2; ++n)
#pragma unroll
                    for (int e = 0; e < 4; ++e) { const float gt = acc[ai][0][m][n][e] * rstd, up = acc[ai][1][m][n][e] * rstd; o[n][e] = gt * up * fsigmoid(gt); }
                *(u32x4*)(ACT + (size_t)row * FF + col0) = pack8(o[0], o[1]); }
    }
};
struct EpiY {
    static constexpr bool HAS_MID = false;
    float* out;
    __device__ __forceinline__ void operator()(Acc& acc, const Unit& u, int wr, int wc, int fr, int fq) const {
        int row0 = u.pm * BM + wr * 64 + fr; asm volatile("" : "+v"(row0)); const int col0 = u.pn * BM + wc * 32 + 8 * fq;
#pragma unroll
        for (int ai = 0; ai < 2; ++ai)
#pragma unroll
            for (int m = 0; m < 4; ++m) { const int row = row0 + ai * HALF + m * 16;
                if (row < MV) { float* orow = out + (size_t)row * D + col0;
#pragma unroll
                    for (int bj = 0; bj < 2; ++bj) { const f32x4 a = *(const f32x4*)(orow + bj * HALF), b = *(const f32x4*)(orow + bj * HALF + 4);
                        *(f32x4*)(orow + bj * HALF) = a + acc[ai][bj][m][0]; *(f32x4*)(orow + bj * HALF + 4) = b + acc[ai][bj][m][1]; } } }
    }
};
}

struct SrcPlain { const float* W; int N; __device__ __forceinline__ float operator()(int k, int n) const { return W[(size_t)k * N + n]; } };
struct SrcMix { const float* mix; const float* scale;
    __device__ __forceinline__ float operator()(int kk, int n) const { const int g = n >> 7, j = n & 127; return ((kk >> 7) == (g & 1)) ? mix[((size_t)g * 128 + (kk & 127)) * 128 + j] * scale[n] : 0.f; } };
struct SrcCat { const float* wp; const float* wa;
    __device__ __forceinline__ float operator()(int k, int n) const { return k < 512 ? wp[(size_t)k * D + n] : wa[(size_t)(k - 512) * D + n]; } };
struct SrcGU { const float* wg; const float* wu; const float* nrm;
    __device__ __forceinline__ float operator()(int k, int n) const { const int t = n >> 8, j = n & 255, col = 128 * t + (j & 127); const float* w = (const float*)((uintptr_t)wg + (uintptr_t)(j >> 7) * ((uintptr_t)wu - (uintptr_t)wg)); return w[(size_t)k * FF + col] * nrm[k]; } };

template <class Src>
__device__ __forceinline__ void transpose_item(const Src src, bf16_t* WT, int ldk, int nblk, int item, LAS float* scr, int lane) {
    const int kb = item / nblk, nb = item % nblk, k0 = 64 * kb, n0 = 32 * nb;
#pragma unroll 8
    for (int i = 0; i < 32; ++i) { const int kk = 2 * i + (lane >> 5); scr[kk * 33 + (lane & 31)] = src(k0 + kk, n0 + (lane & 31)); }
    LDS_WAIT();
    const int c = lane & 7;
#pragma unroll
    for (int j = 0; j < 4; ++j) { const int n = (lane >> 3) + 8 * j; const LAS float* s = scr + (8 * c) * 33 + n;
        u32x4 o; o.x = cvt_pk_bf16(s[0 * 33], s[1 * 33]); o.y = cvt_pk_bf16(s[2 * 33], s[3 * 33]); o.z = cvt_pk_bf16(s[4 * 33], s[5 * 33]); o.w = cvt_pk_bf16(s[6 * 33], s[7 * 33]);
        *(u32x4*)(WT + (size_t)(n0 + n) * ldk + k0 + 8 * c) = o; }
    LDS_WAIT();
}

struct Args { const float* in[19]; float* out; unsigned char* ws; int ph_lo, ph_hi; };

template <class Epi>
__device__ __forceinline__ void small_gemm(LAS unsigned char* lds, const bf16_t* A, int lda, const bf16_t* Bt, int ldb, int K, int vcu, int G, const Epi& E) {
    const int tid = threadIdx.x, lane = tid & 63, wave = __builtin_amdgcn_readfirstlane(tid >> 6), fr = lane & 15, fq = lane >> 4, rh = wave & 1, ks = wave >> 1;
    const int kq = K >> 2, nsteps = kq >> 5;
    for (int u = vcu; u < 256; u += G) {
        const int r0 = 32 * (u & 3) + 16 * rh, n0 = 16 * (u >> 2);
        const bf16_t* ap = A + (size_t)(r0 + fr) * lda + ks * kq + 8 * fq; const bf16_t* bp = Bt + (size_t)(n0 + fr) * ldb + ks * kq + 8 * fq;
        f32x4 acc = (f32x4){0.f, 0.f, 0.f, 0.f};
#pragma unroll 8
        for (int s = 0; s < nsteps; ++s) { const bf16x8 af = *(const bf16x8*)(ap + 32 * s), bf = *(const bf16x8*)(bp + 32 * s);
            acc = __builtin_amdgcn_mfma_f32_16x16x32_bf16(bf, af, acc, 0, 0, 0); }
        LAS f32x4* red = (LAS f32x4*)lds;
        red[(ks * 2 + rh) * 64 + lane] = acc;
        __syncthreads();
        if (ks == 0) { const f32x4 p0 = red[(0 * 2 + rh) * 64 + lane], p1 = red[(1 * 2 + rh) * 64 + lane], p2 = red[(2 * 2 + rh) * 64 + lane], p3 = red[(3 * 2 + rh) * 64 + lane];
            E(p0, p1, p2, p3, r0 + fr, n0 + 4 * fq, fq); }
        __syncthreads();
    }
}
struct SEpiMerge { const bf16_t* Z; bf16_t* O;
    __device__ __forceinline__ void operator()(f32x4 p0, f32x4 p1, f32x4 p2, f32x4 p3, int n, int c, int fq) const {
        const bf16_t* zr = Z + (size_t)(MP + n) * INW + c; const u32x2 a = *(const u32x2*)(zr + ZC_GA), b = *(const u32x2*)(zr + ZC_GB);
        const f32x4 pool = p0 + p1, attn = p2 + p3;
        u32x2 w; w.x = cvt_pk_bf16(bflo(a.x) * pool[0] + bflo(b.x) * attn[0], bfhi(a.x) * pool[1] + bfhi(b.x) * attn[1]);
        w.y = cvt_pk_bf16(bflo(a.y) * pool[2] + bflo(b.y) * attn[2], bfhi(a.y) * pool[3] + bfhi(b.y) * attn[3]);
        *(u32x2*)(O + (size_t)(MP + n) * D + c) = w; } };
struct SEpiX1 { const float* xs; float* out; bf16_t* X1B; float* sumsq;
    __device__ __forceinline__ void operator()(f32x4 p0, f32x4 p1, f32x4 p2, f32x4 p3, int n, int c, int fq) const {
        const f32x4 v = *(const f32x4*)(xs + (size_t)n * D + c) + ((p0 + p1) + (p2 + p3));
        *(f32x4*)(out + (size_t)(MP + n) * D + c) = v;
        u32x2 w; w.x = cvt_pk_bf16(v[0], v[1]); w.y = cvt_pk_bf16(v[2], v[3]); *(u32x2*)(X1B + (size_t)(MP + n) * D + c) = w;
        float ss = (v[0] * v[0] + v[1] * v[1]) + (v[2] * v[2] + v[3] * v[3]); ss += __shfl_xor(ss, 16); ss += __shfl_xor(ss, 32);
        if (fq == 0) atomicAdd(sumsq + MP + n, ss); } };
struct SEpiY { float* out;
    __device__ __forceinline__ void operator()(f32x4 p0, f32x4 p1, f32x4 p2, f32x4 p3, int n, int c, int fq) const {
        float* o = out + (size_t)(MP + n) * D + c; *(f32x4*)o = *(const f32x4*)o + ((p0 + p1) + (p2 + p3)); } };


__device__ __forceinline__ int crow(int r, int hi) { return (r & 3) + 8 * (r >> 2) + 4 * hi; }
constexpr int KS_STRIDE = 144, VT_STRIDE = 520, LDS_VT = 256 * KS_STRIDE  , LDS_SMP = 73728;

__device__ __forceinline__ void attn_prompt_unit(const Args& a, LAS unsigned char* lds, int unit) {
    const int tid = threadIdx.x, lane = tid & 63, wave = __builtin_amdgcn_readfirstlane(tid >> 6);
    const int kh = unit & 1, qb = (unit >> 1) & 15, b = unit >> 5;
    const bf16_t* Z = (const bf16_t*)(a.ws + WS_Z); bf16_t* YY = (bf16_t*)(a.ws + WS_RB);
    const float* qnw = a.in[7]; const float* knw = a.in[8]; const float* sinks = a.in[9];
    const size_t rowbase = (size_t)b * SEQ; const int key0 = (qb - 1) * 128;
    {
        const int j = tid >> 1, half = tid & 1, pos = key0 + j; float v[32];
        if (pos >= 0) { const u32x4* src = (const u32x4*)(Z + (rowbase + pos) * INW + ZC_K + kh * 64 + 32 * half);
#pragma unroll
            for (int c = 0; c < 4; ++c) { const u32x4 w = src[c];
#pragma unroll
                for (int e = 0; e < 4; ++e) { v[c * 8 + 2 * e] = bflo(w[e]); v[c * 8 + 2 * e + 1] = bfhi(w[e]); } } }
        else {
#pragma unroll
            for (int i = 0; i < 32; ++i) v[i] = 0.f; }
        float ss = 0.f;
#pragma unroll
        for (int i = 0; i < 32; ++i) ss += v[i] * v[i];
        ss += __shfl_xor(ss, 1);
        const float rstd = __builtin_amdgcn_rsqf(ss * (1.0f / 64) + EPS);
#pragma unroll
        for (int c = 0; c < 8; ++c) { const f32x4 w = *(const f32x4*)(knw + 32 * half + 4 * c);
#pragma unroll
            for (int e = 0; e < 4; ++e) v[4 * c + e] = v[4 * c + e] * rstd * w[e]; }
        LAS u32x4* dst = (LAS u32x4*)(lds + j * KS_STRIDE + 64 * half);
#pragma unroll
        for (int c = 0; c < 4; ++c) { u32x4 w;
#pragma unroll
            for (int e = 0; e < 4; ++e) w[e] = cvt_pk_bf16(v[c * 8 + 2 * e], v[c * 8 + 2 * e + 1]);
            dst[c] = w; }
        if (qb == 15 && j >= 128) { float* o = a.out + O_KP + ((size_t)(b * 128 + (j - 128)) * 2 + kh) * 64 + 32 * half;
#pragma unroll
            for (int c = 0; c < 8; ++c) *(f32x4*)(o + 4 * c) = (f32x4){v[4 * c], v[4 * c + 1], v[4 * c + 2], v[4 * c + 3]}; }
    }
#pragma unroll
    for (int i = 0; i < 4; ++i) { const int c = tid + 512 * i, key = c & 255, dch = c >> 8, pos = key0 + key;
        u32x4 w = (u32x4){0u, 0u, 0u, 0u};
        if (pos >= 0) w = *(const u32x4*)(Z + (rowbase + pos) * INW + ZC_V + kh * 64 + 8 * dch);
        LAS bf16_t* vt = (LAS bf16_t*)(lds + LDS_VT) + key;
#pragma unroll
        for (int e = 0; e < 4; ++e) { vt[(8 * dch + 2 * e) * (VT_STRIDE / 2)] = (bf16_t)(w[e] & 0xffffu); vt[(8 * dch + 2 * e + 1) * (VT_STRIDE / 2)] = (bf16_t)(w[e] >> 16); }
        if (qb == 15 && key >= 128) { float* o = a.out + O_VP + ((size_t)(b * 128 + (key - 128)) * 2 + kh) * 64 + 8 * dch;
            *(f32x4*)o = (f32x4){bflo(w[0]), bfhi(w[0]), bflo(w[1]), bfhi(w[1])}; *(f32x4*)(o + 4) = (f32x4){bflo(w[2]), bfhi(w[2]), bflo(w[3]), bfhi(w[3])}; } }
    __syncthreads();
    const int hq = 4 * kh + (wave >> 1), ql = lane & 31, h = lane >> 5;
    const float sink2 = sinks[hq] * LOG2E;
#pragma unroll 1
    for (int gi = 0; gi < 2; ++gi) {
        const int g = 2 * (wave & 1) + gi; const size_t qrow = rowbase + (size_t)qb * 128 + 32 * g + ql;
        bf16x8 qf[4];
        { float v[32]; const bf16_t* qp = Z + qrow * INW + ZC_Q + hq * 64 + 8 * h;
#pragma unroll
            for (int ds = 0; ds < 4; ++ds) { const u32x4 w = *(const u32x4*)(qp + 16 * ds);
#pragma unroll
                for (int e = 0; e < 4; ++e) { v[ds * 8 + 2 * e] = bflo(w[e]); v[ds * 8 + 2 * e + 1] = bfhi(w[e]); } }
            float ss = 0.f;
#pragma unroll
            for (int i = 0; i < 32; ++i) ss += v[i] * v[i];
            ss += __shfl_xor(ss, 32);
            const float sc = __builtin_amdgcn_rsqf(ss * (1.0f / 64) + EPS) * C2;
#pragma unroll
            for (int ds = 0; ds < 4; ++ds) { const f32x4 w0 = *(const f32x4*)(qnw + 16 * ds + 8 * h), w1 = *(const f32x4*)(qnw + 16 * ds + 8 * h + 4); u32x4 p;
                p.x = cvt_pk_bf16(v[ds * 8 + 0] * sc * w0[0], v[ds * 8 + 1] * sc * w0[1]); p.y = cvt_pk_bf16(v[ds * 8 + 2] * sc * w0[2], v[ds * 8 + 3] * sc * w0[3]);
                p.z = cvt_pk_bf16(v[ds * 8 + 4] * sc * w1[0], v[ds * 8 + 5] * sc * w1[1]); p.w = cvt_pk_bf16(v[ds * 8 + 6] * sc * w1[2], v[ds * 8 + 7] * sc * w1[3]);
                qf[ds] = __builtin_bit_cast(bf16x8, p); } }
        f32x16 sc[5];
#pragma unroll
        for (int i = 0; i < 5; ++i) { f32x16 acc = {};
#pragma unroll
            for (int ds = 0; ds < 4; ++ds) { const bf16x8 kf = *(const LAS bf16x8*)(lds + (32 * (g + i) + ql) * KS_STRIDE + 32 * ds + 16 * h);
                acc = __builtin_amdgcn_mfma_f32_32x32x16_bf16(kf, qf[ds], acc, 0, 0, 0); }
            sc[i] = acc; }
        const int qr = 32 * g + ql; float mx = -1e30f;
#pragma unroll
        for (int i = 0; i < 5; ++i)
#pragma unroll
            for (int r = 0; r < 16; ++r) { const int j = 32 * (g + i) + crow(r, h); const bool valid = (j >= qr) && (j <= qr + 128) && (qb > 0 || j >= 128);
                const float s = valid ? sc[i][r] : -1e30f; sc[i][r] = s; mx = fmaxf(mx, s); }
        mx = fmaxf(mx, __shfl_xor(mx, 32));
        const float mref = fmaxf(mx, sink2); float lsum = 0.f;
#pragma unroll
        for (int i = 0; i < 5; ++i)
#pragma unroll
            for (int r = 0; r < 16; ++r) { const float p = __builtin_amdgcn_exp2f(sc[i][r] - mref); sc[i][r] = p; lsum += p; }
        lsum += __shfl_xor(lsum, 32);
        const float inv = 1.0f / (lsum + __builtin_amdgcn_exp2f(sink2 - mref));
        f32x16 o[2]; o[0] = (f32x16){}; o[1] = (f32x16){};
#pragma unroll
        for (int i = 0; i < 5; ++i)
#pragma unroll
            for (int s2 = 0; s2 < 2; ++s2) { u32x4 pw;
#pragma unroll
                for (int e = 0; e < 4; ++e) pw[e] = cvt_pk_bf16(sc[i][8 * s2 + 2 * e], sc[i][8 * s2 + 2 * e + 1]);
                const bf16x8 pf = __builtin_bit_cast(bf16x8, pw);
#pragma unroll
                for (int dt = 0; dt < 2; ++dt) { const LAS unsigned char* vp = lds + LDS_VT + (32 * dt + ql) * VT_STRIDE + 2 * (32 * (g + i) + 16 * s2 + 4 * h);
                    const u32x2 lo = *(const LAS u32x2*)vp, hi2 = *(const LAS u32x2*)(vp + 16);
                    const u32x4 vw = (u32x4){lo.x, lo.y, hi2.x, hi2.y};
                    o[dt] = __builtin_amdgcn_mfma_f32_32x32x16_bf16(__builtin_bit_cast(bf16x8, vw), pf, o[dt], 0, 0, 0); } }
        bf16_t* yp = YY + qrow * D + 512 + hq * 64 + 4 * h;
#pragma unroll
        for (int dt = 0; dt < 2; ++dt)
#pragma unroll
            for (int rq = 0; rq < 4; ++rq) { u32x2 w; w.x = cvt_pk_bf16(o[dt][4 * rq] * inv, o[dt][4 * rq + 1] * inv); w.y = cvt_pk_bf16(o[dt][4 * rq + 2] * inv, o[dt][4 * rq + 3] * inv);
                *(u32x2*)(yp + 32 * dt + 8 * rq) = w; }
    }
    __syncthreads();
}

__device__ __forceinline__ void attn_sample_unit(const Args& a, LAS unsigned char* lds, int n) {
    const int tid = threadIdx.x, lane = tid & 63, wave = __builtin_amdgcn_readfirstlane(tid >> 6);
    const int hq = wave, kh = wave >> 2;
    const bf16_t* zrow = (const bf16_t*)(a.ws + WS_Z) + (size_t)(MP + n) * INW; bf16_t* YY = (bf16_t*)(a.ws + WS_RB);
    const float* ck = a.in[2] + (size_t)n * 16384; const float* cv = a.in[3] + (size_t)n * 16384;
    LAS float* qs = (LAS float*)(lds + LDS_SMP + wave * 1024); LAS float* ps = qs + 64;
    const float xq = bf1(zrow[ZC_Q + hq * 64 + lane]); const float ssq = wave_sum(xq * xq);
    const float qn = xq * __builtin_amdgcn_rsqf(ssq * (1.0f / 64) + EPS) * a.in[7][lane] * C2;
    const float xk = bf1(zrow[ZC_K + kh * 64 + lane]); const float ssk = wave_sum(xk * xk);
    const float kn = xk * __builtin_amdgcn_rsqf(ssk * (1.0f / 64) + EPS) * a.in[8][lane];
    const float vn = bf1(zrow[ZC_V + kh * 64 + lane]);
    const float s_new = wave_sum(qn * kn);
    if ((wave & 3) == 0) { a.out[O_KS + (size_t)n * 16384 + (127 * 2 + kh) * 64 + lane] = kn; a.out[O_VS + (size_t)n * 16384 + (127 * 2 + kh) * 64 + lane] = vn; }
    qs[lane] = qn; LDS_WAIT();
    float s0 = 0.f, s1 = 0.f;
    { const f32x4* k0 = (const f32x4*)(ck + (size_t)(lane * 2 + kh) * 64); const f32x4* k1 = (const f32x4*)(ck + (size_t)((lane + 64) * 2 + kh) * 64);
#pragma unroll
        for (int c = 0; c < 16; ++c) { const f32x4 q4 = *(const LAS f32x4*)(qs + 4 * c), x0 = k0[c], x1 = k1[c];
            s0 += (q4[0] * x0[0] + q4[1] * x0[1]) + (q4[2] * x0[2] + q4[3] * x0[3]); s1 += (q4[0] * x1[0] + q4[1] * x1[1]) + (q4[2] * x1[2] + q4[3] * x1[3]); } }
    const float sink2 = a.in[9][hq] * LOG2E;
    const float mref = fmaxf(fmaxf(wave_max(fmaxf(s0, s1)), s_new), sink2);
    const float p0 = __builtin_amdgcn_exp2f(s0 - mref), p1 = __builtin_amdgcn_exp2f(s1 - mref), pn = __builtin_amdgcn_exp2f(s_new - mref);
    const float l = wave_sum(p0 + p1) + pn + __builtin_amdgcn_exp2f(sink2 - mref);
    ps[lane] = p0; ps[lane + 64] = p1; LDS_WAIT();
    float o = pn * vn;
#pragma unroll 8
    for (int j = 0; j < 128; ++j) o += ps[j] * cv[(size_t)(j * 2 + kh) * 64 + lane];
    YY[(size_t)(MP + n) * D + 512 + hq * 64 + lane] = (bf16_t)(cvt_pk_bf16(o / l, 0.f) & 0xffffu);
    { const f32x4* sk = (const f32x4*)(ck + 128); const f32x4* sv = (const f32x4*)(cv + 128); f32x4* dk = (f32x4*)(a.out + O_KS + (size_t)n * 16384); f32x4* dv = (f32x4*)(a.out + O_VS + (size_t)n * 16384);
        for (int i = tid; i < 127 * 32; i += 512) { dk[i] = sk[i]; dv[i] = sv[i]; } }
    LDS_WAIT();
}

__device__ __forceinline__ void pool_items(const Args& a, int gtid, int gthreads) {
    const bf16_t* Z = (const bf16_t*)(a.ws + WS_Z); bf16_t* YPRE = (bf16_t*)(a.ws + WS_YPRE); const float* sp = a.in[4];
    for (int it = gtid; it < MV * 64; it += gthreads) {
        const int row = it >> 6, cg8 = it & 63, c0 = 8 * cg8, w = 2 << (cg8 >> 4);
        const u32x4 un = *(const u32x4*)(Z + (size_t)row * INW + c0);
        float u[8], s[8];
#pragma unroll
        for (int e = 0; e < 4; ++e) { u[2 * e] = bflo(un[e]); u[2 * e + 1] = bfhi(un[e]); }
#pragma unroll
        for (int e = 0; e < 8; ++e) s[e] = u[e];
        float rc;
        if (row < MP) {
            const int b = row >> 11, t = row & 2047, cnt = min(w, t + 1); rc = 1.0f / (float)cnt;
            for (int i = 1; i < cnt; ++i) { const u32x4 x = *(const u32x4*)(Z + (size_t)(row - i) * INW + c0);
#pragma unroll
                for (int e = 0; e < 4; ++e) { s[2 * e] += bflo(x[e]); s[2 * e + 1] += bfhi(x[e]); } }
            if (t >= SEQ - 15) { float* o = a.out + O_PP + ((size_t)b * 15 + (t - (SEQ - 15))) * PW + c0;
                *(f32x4*)o = (f32x4){u[0], u[1], u[2], u[3]}; *(f32x4*)(o + 4) = (f32x4){u[4], u[5], u[6], u[7]}; }
        } else {
            const int n = row - MP; rc = 1.0f / (float)w; const float* st = sp + (size_t)n * 15 * PW + c0;
            for (int i = 1; i < w; ++i) { const f32x4 x0 = *(const f32x4*)(st + (size_t)(15 - i) * PW), x1 = *(const f32x4*)(st + (size_t)(15 - i) * PW + 4);
#pragma unroll
                for (int e = 0; e < 4; ++e) { s[e] += x0[e]; s[4 + e] += x1[e]; } }
            float* o = a.out + O_PS + (size_t)n * 15 * PW + c0;
            for (int i = 0; i < 14; ++i) { *(f32x4*)(o + (size_t)i * PW) = *(const f32x4*)(st + (size_t)(i + 1) * PW); *(f32x4*)(o + (size_t)i * PW + 4) = *(const f32x4*)(st + (size_t)(i + 1) * PW + 4); }
            *(f32x4*)(o + 14 * PW) = (f32x4){u[0], u[1], u[2], u[3]}; *(f32x4*)(o + 14 * PW + 4) = (f32x4){u[4], u[5], u[6], u[7]};
        }
        u32x4 y;
#pragma unroll
        for (int e = 0; e < 4; ++e) y[e] = cvt_pk_bf16(s[2 * e] * rc - u[2 * e], s[2 * e + 1] * rc - u[2 * e + 1]);
        *(u32x4*)(YPRE + (size_t)row * PW + c0) = y;
    }
}


#define XB_TMO      128
#define XB_XCNT(j)  (256  + 64 * (j))
#define XB_XSUB(j)  (1280 + 64 * (j))
#define XB_XGEN(j)  (2304 + 64 * (j))
#define XB_TOP      3328
#define XB_TOPGEN   3392
#define XCD_BAR_WORDS 3456
#define XB_SPIN_CAP (1u << 18)
__device__ __forceinline__ unsigned xb_ld(unsigned* p)              { return __hip_atomic_load(p, __ATOMIC_RELAXED, __HIP_MEMORY_SCOPE_AGENT); }
__device__ __forceinline__ unsigned xb_add(unsigned* p, unsigned v) { return __hip_atomic_fetch_add(p, v, __ATOMIC_RELAXED, __HIP_MEMORY_SCOPE_AGENT); }
__device__ __forceinline__ unsigned xb_xcc_id() { return (unsigned)__builtin_amdgcn_s_getreg((3 << 11) | 20) & 0xFu; }
#define XB_SPIN(cond, bar) do { unsigned _sp = 0; while (cond) { __builtin_amdgcn_s_sleep(1); \
    if ((++_sp & 255u) == 0u) { if (xb_ld(&(bar)[XB_TMO])) break; if (_sp > XB_SPIN_CAP) { atomicAdd(&(bar)[XB_TMO], 1u); break; } } } } while (0)
struct XcdBarrier { unsigned* bar; unsigned x; volatile LAS unsigned* st; };
__device__ __forceinline__ XcdBarrier xcd_barrier_post(unsigned* bar, volatile LAS unsigned* st) {
    XcdBarrier b; b.bar = bar; b.x = xb_xcc_id(); b.st = st;
    if (threadIdx.x == 0) (void)xb_add(&bar[XB_XCNT(b.x)], 1u);
    return b;
}
__device__ __forceinline__ void xcd_barrier_complete(unsigned* bar, unsigned x, unsigned& nloc, unsigned& nx) {
    const unsigned G = gridDim.x * gridDim.y * gridDim.z;
    unsigned sum, cnt, mine, sp = 0u;
    for (;;) {
        sum = 0u; cnt = 0u; mine = 0u;
#pragma unroll
        for (unsigned j = 0; j < 16; ++j) { const unsigned c = xb_ld(&bar[XB_XCNT(j)]); sum += c; cnt += (c > 0u) ? 1u : 0u; mine = (j == x) ? c : mine; }
        if (sum == G) break;
        __builtin_amdgcn_s_sleep(1);
        if ((++sp & 255u) == 0u) { if (xb_ld(&bar[XB_TMO])) break; if (sp > XB_SPIN_CAP) { atomicAdd(&bar[XB_TMO], 1u); break; } }
    }
    nloc = mine > 0u ? mine : 1u; nx = cnt > 0u ? cnt : 1u;
}
__device__ __forceinline__ void xcd_barrier(const XcdBarrier& b) {
    asm volatile("s_waitcnt vmcnt(0)" ::: "memory");
    __syncthreads();
    if (threadIdx.x == 0) {
        unsigned* bar = b.bar;
        __builtin_amdgcn_s_waitcnt(0);
        unsigned nloc = b.st[0], nx = b.st[1];
        if (nloc == 0u) { xcd_barrier_complete(bar, b.x, nloc, nx); b.st[0] = nloc; b.st[1] = nx; }
        const unsigned old = xb_add(&bar[XB_XSUB(b.x)], 1u);
        const unsigned gen = old / nloc;
        if (old + 1u == (gen + 1u) * nloc) {
            __builtin_amdgcn_fence(__ATOMIC_RELEASE, "agent");
            asm volatile("s_waitcnt vmcnt(0)" ::: "memory");
            const unsigned og = xb_add(&bar[XB_TOP], 1u);
            const unsigned tg = og / nx;
            if (og + 1u == (tg + 1u) * nx) xb_add(&bar[XB_TOPGEN], 1u);
            else XB_SPIN(xb_ld(&bar[XB_TOPGEN]) == tg, bar);
            __builtin_amdgcn_fence(__ATOMIC_ACQUIRE, "agent");
            xb_add(&bar[XB_XGEN(b.x)], 1u);
            asm volatile("s_waitcnt vmcnt(0)" ::: "memory");
        } else {
            XB_SPIN(xb_ld(&bar[XB_XGEN(b.x)]) == gen, bar);
            __builtin_amdgcn_fence(__ATOMIC_ACQUIRE, "agent");
            asm volatile("s_waitcnt vmcnt(0)" ::: "memory");
        }
    }
    __syncthreads();
}

__global__ void __launch_bounds__(512, 2) fwd_megakernel(Args a) {
    extern __shared__ __attribute__((aligned(16))) unsigned char lds_raw[];
    LAS unsigned char* lds = (LAS unsigned char*)lds_raw;
    cg::grid_group grid = cg::this_grid();
    const int tid = threadIdx.x, lane = tid & 63, wave = __builtin_amdgcn_readfirstlane(tid >> 6);
    const int G = gridDim.x, bx = blockIdx.x;
    const int vcu = (G % 8 == 0) ? (bx % 8) * (G / 8) + bx / 8 : bx;
    unsigned char* ws = a.ws;
    bf16_t* WIN = (bf16_t*)(ws + WS_WIN); bf16_t* WMIX = (bf16_t*)(ws + WS_MIX); bf16_t* WCAT = (bf16_t*)(ws + WS_WCAT); bf16_t* WOUT = (bf16_t*)(ws + WS_WOUT);
    bf16_t* WGU = (bf16_t*)(ws + WS_WGU); bf16_t* WDN = (bf16_t*)(ws + WS_WDN);
    bf16_t* RA = (bf16_t*)(ws + WS_RA); bf16_t* RB = (bf16_t*)(ws + WS_RB); bf16_t* YPRE = (bf16_t*)(ws + WS_YPRE); bf16_t* Z = (bf16_t*)(ws + WS_Z);
    float* SUMSQ = (float*)(ws + WS_SUMSQ);
    const int lo = a.ph_lo, hi = a.ph_hi;
    if (tid < 2) ((volatile LAS unsigned*)(lds + LDS_MISC))[tid] = 0u;
    __syncthreads();
    XcdBarrier xbar = xcd_barrier_post((unsigned*)(ws + WS_BAR), (volatile LAS unsigned*)(lds + LDS_MISC));
    if (hi < 0) grid.sync();
#ifndef PH_MASK
#define PH_MASK 255
#endif
#define IN(k) (((PH_MASK >> (k)) & 1) && lo <= (k) && (k) < hi)
#ifndef DUP_MASK
#define DUP_MASK 0
#endif
#ifndef EXTRA_SYNCS
#define EXTRA_SYNCS 0
#endif
#define REP(k) for (int rep_ = 0; rep_ < 1 + ((DUP_MASK >> (k)) & 1); ++rep_)
#define SEAM(k) do { if (IN(k) && IN((k) + 1)) { xcd_barrier(xbar); for (int xs_ = 0; xs_ < EXTRA_SYNCS; ++xs_) xcd_barrier(xbar); } } while (0)

    if (IN(0)) REP(0) {
        LAS float* scr = (LAS float*)(lds + wave * 16384);
        const int gw = vcu * 8 + wave, NGW = G * 8;
        constexpr int I_IN = 16 * 104, I_MIX = 4 * 16, I_CAT = 16 * 32, I_OUT = 16 * 32, I_GU = 16 * 176, I_DN = 44 * 32;
        constexpr int NITEMS = I_IN + I_MIX + I_CAT + I_OUT + I_GU + I_DN;
        for (int it = gw; it < NITEMS; it += NGW) {
            int r = it;
            if (r < I_IN) { transpose_item(SrcPlain{a.in[6], INW}, WIN, D, 104, r, scr, lane); continue; } r -= I_IN;
            if (r < I_MIX) { transpose_item(SrcMix{a.in[10], a.in[11]}, WMIX, 256, 16, r, scr, lane); continue; } r -= I_MIX;
            if (r < I_CAT) { transpose_item(SrcCat{a.in[12], a.in[13]}, WCAT, D, 32, r, scr, lane); continue; } r -= I_CAT;
            if (r < I_OUT) { transpose_item(SrcPlain{a.in[14], D}, WOUT, D, 32, r, scr, lane); continue; } r -= I_OUT;
            if (r < I_GU) { transpose_item(SrcGU{a.in[16], a.in[17], a.in[15]}, WGU, D, 176, r, scr, lane); continue; } r -= I_GU;
            transpose_item(SrcPlain{a.in[18], D}, WDN, FF, 32, r, scr, lane);
        }
        const float* g1 = a.in[5];
        for (int m = gw; m < MPAD; m += NGW) {
            unsigned long long* o8 = (unsigned long long*)(RA + (size_t)m * D) + lane;
            if (m < MV) {
                const f32x4* xr = (const f32x4*)(m < MP ? a.in[0] + (size_t)m * D : a.in[1] + (size_t)(m - MP) * D) + lane;
                f32x4 v[4]; float s = 0.f;
#pragma unroll
                for (int j = 0; j < 4; ++j) { v[j] = xr[64 * j]; s += (v[j].x * v[j].x + v[j].y * v[j].y) + (v[j].z * v[j].z + v[j].w * v[j].w); }
                const float rstd = __builtin_amdgcn_rsqf(wave_sum(s) * (1.f / D) + EPS);
#pragma unroll
                for (int j = 0; j < 4; ++j) { const f32x4 gg = ((const f32x4*)g1)[lane + 64 * j];
                    o8[64 * j] = (unsigned long long)cvt_pk_bf16(v[j].x * rstd * gg.x, v[j].y * rstd * gg.y) | ((unsigned long long)cvt_pk_bf16(v[j].z * rstd * gg.z, v[j].w * rstd * gg.w) << 32); }
            } else {
#pragma unroll
                for (int j = 0; j < 4; ++j) o8[64 * j] = 0ull;
                unsigned long long* y8 = (unsigned long long*)(RB + (size_t)m * D) + lane;
#pragma unroll
                for (int j = 0; j < 4; ++j) y8[64 * j] = 0ull;
                unsigned long long* p8 = (unsigned long long*)(YPRE + (size_t)m * PW) + lane;
                p8[0] = 0ull; p8[64] = 0ull;
            }
        }
        for (int i = vcu * 512 + tid; i < MPAD; i += G * 512) SUMSQ[i] = 0.f;
    }
    SEAM(0);
    if (IN(1)) REP(1) {
        pg8::Gemm g{RA, WIN, D, D, D, 0, -1}; pg8::StaticOrder S; S.init(MPAD, INW, G, bx);
        pg8::gemm_phase(lds, g, S, pg8::EpiZ{Z});
    }
    SEAM(1);
    if (IN(2)) REP(2) {
        for (int u = vcu; u < 256; u += G) attn_prompt_unit(a, lds, u);
        for (int n = vcu; n < NS; n += G) attn_sample_unit(a, lds, n);
        pool_items(a, vcu * 512 + tid, G * 512);
    }
    SEAM(2);
    if (IN(3)) REP(3) {
        pg8::Gemm g{YPRE, WMIX, PW, 256, 256, 512, -1}; pg8::StaticOrder S; S.init(MPAD, PW, G, bx);
        pg8::gemm_phase(lds, g, S, pg8::EpiBf{RB, D});
    }
    SEAM(3);
    if (IN(4)) REP(4) {
        small_gemm(lds, RB + (size_t)MP * D, D, WCAT, D, D, vcu, G, SEpiMerge{Z, RA});
        pg8::Gemm g{RB, WCAT, D, D, D, 0, 8}; pg8::StaticOrder S; S.init(MP, D, G, bx);
        pg8::gemm_phase(lds, g, S, pg8::EpiMerge{Z, RA});
    }
    SEAM(4);
    if (IN(5)) REP(5) {
        small_gemm(lds, RA + (size_t)MP * D, D, WOUT, D, D, vcu, G, SEpiX1{a.in[1], a.out + O_Y, RB, SUMSQ});
        pg8::Gemm g{RA, WOUT, D, D, D, 0, -1}; pg8::StaticOrder S; S.init(MP, D, G, bx);
        pg8::gemm_phase(lds, g, S, pg8::EpiX1{a.in[0], a.in[1], a.out + O_Y, RB, SUMSQ});
    }
    SEAM(5);
    if (IN(6)) REP(6) {
        pg8::Gemm g{RB, WGU, D, D, D, 0, -1}; pg8::StaticOrder S; S.init(MPAD, 2 * FF, G, bx);
        pg8::gemm_phase(lds, g, S, pg8::EpiAct{SUMSQ, Z});
    }
    SEAM(6);
    if (IN(7)) REP(7) {
        small_gemm(lds, Z + (size_t)MP * FF, FF, WDN, FF, FF, vcu, G, SEpiY{a.out + O_Y});
        pg8::Gemm g{Z, WDN, FF, FF, FF, 0, -1}; pg8::StaticOrder S; S.init(MP, D, G, bx);
        pg8::gemm_phase(lds, g, S, pg8::EpiY{a.out + O_Y});
    }
#undef IN
#undef SEAM
}

#ifndef MK_N_LAUNCHES
#define MK_N_LAUNCHES 1
#endif
extern "C" void kernel_launch(void* const* d_in, const int* in_sizes, int n_in, void* d_out, int out_size, void* d_ws, size_t ws_size, hipStream_t stream) {
    static int grid = 0;
    if (grid == 0) {
        int dev = 0, cus = 0, per_cu = 0;
        if (n_in != 19 || ws_size < WS_END) { fprintf(stderr, "kernel_launch: unexpected inputs (n_in %d, ws %zu)\n", n_in, ws_size); grid = -1; return; }
        hipGetDevice(&dev); hipDeviceGetAttribute(&cus, hipDeviceAttributeMultiprocessorCount, dev);
        if (hipFuncSetAttribute((const void*)fwd_megakernel, hipFuncAttributeMaxDynamicSharedMemorySize, LDS_BYTES) != hipSuccess) { fprintf(stderr, "kernel_launch: hipFuncSetAttribute failed\n"); grid = -1; return; }
        if (hipOccupancyMaxActiveBlocksPerMultiprocessor(&per_cu, (const void*)fwd_megakernel, 512, LDS_BYTES) != hipSuccess || per_cu < 1) { fprintf(stderr, "kernel_launch: occupancy query says %d\n", per_cu); per_cu = 1; }
        (void)hipGetLastError();
        grid = cus * 1;
        if (per_cu < 1) grid = -1;
    }
    if (grid < 0) return;
    if (hipMemsetAsync((char*)d_ws + WS_BAR, 0, WS_BAR_BYTES, stream) != hipSuccess) { fprintf(stderr, "kernel_launch: memset failed\n"); return; }
    Args a{};
    for (int i = 0; i < 19; ++i) a.in[i] = (const float*)d_in[i];
    a.out = (float*)d_out; a.ws = (unsigned char*)d_ws;
#if MK_N_LAUNCHES == 1
    a.ph_lo = 0; a.ph_hi = 8;
    void* args[] = {&a};
    hipError_t e = hipLaunchCooperativeKernel((const void*)fwd_megakernel, dim3(grid), dim3(512), args, LDS_BYTES, stream);
    if (e != hipSuccess) fprintf(stderr, "cooperative launch failed: %s (grid %d)\n", hipGetErrorString(e), grid);
#else
    for (int p = 0; p < 8; ++p) { a.ph_lo = p; a.ph_hi = p + 1; hipLaunchKernelGGL(fwd_megakernel, dim3(grid), dim3(512), LDS_BYTES, stream, a); }
#endif
}
```

```cpp
#include <hip/hip_runtime.h>
#include <hip/hip_cooperative_groups.h>
#include <cstdio>
#include <cstdint>
namespace cg = cooperative_groups;

#define LAS __attribute__((address_space(3)))
typedef unsigned short bf16_t;
typedef short bf16x8 __attribute__((ext_vector_type(8)));
typedef short s16x4 __attribute__((ext_vector_type(4)));
typedef float f32x4 __attribute__((ext_vector_type(4)));
typedef float f32x16 __attribute__((ext_vector_type(16)));
typedef unsigned u32x4 __attribute__((ext_vector_type(4)));
typedef unsigned u32x2 __attribute__((ext_vector_type(2)));

constexpr int D = 1024, SEQ = 2048, NB = 8, MP = NB * SEQ, NS = 128, MV = MP + NS, MPAD = 16640;
constexpr int INW = 3328, FF = 2816, PW = 512;
constexpr int ZC_Q = 512, ZC_K = 1024, ZC_V = 1152, ZC_GA = 1280, ZC_GB = 2304;
constexpr float EPS = 1e-6f;
constexpr float LOG2E = 1.4426950408889634f;
constexpr float C2 = 0.125f * LOG2E;
constexpr size_t O_Y = 0, O_KP = 16908288, O_VP = 17039360, O_PP = 17170432, O_KS = 17231872, O_VS = 19329024, O_PS = 21426176;
constexpr size_t MiB = 1u << 20;
constexpr size_t WS_SUMSQ = 0;
constexpr size_t WS_BAR = 1 * MiB, WS_BAR_BYTES = 16384;
constexpr size_t WS_WIN = 2 * MiB, WS_MIX = 9 * MiB, WS_WCAT = 10 * MiB, WS_WOUT = 12 * MiB, WS_WGU = 14 * MiB, WS_WDN = 25 * MiB;
constexpr size_t WS_RA = 32 * MiB;
constexpr size_t WS_RB = 65 * MiB;
constexpr size_t WS_YPRE = 98 * MiB;
constexpr size_t WS_Z = 115 * MiB;
constexpr size_t WS_END = 222 * MiB;
constexpr int LDS_BYTES = 147456;
constexpr int LDS_MISC = 135168;

__device__ __forceinline__ unsigned cvt_pk_bf16(float lo, float hi) { unsigned r; asm("v_cvt_pk_bf16_f32 %0, %1, %2" : "=v"(r) : "v"(lo), "v"(hi)); return r; }
__device__ __forceinline__ float bflo(unsigned u) { return __uint_as_float(u << 16); }
__device__ __forceinline__ float bfhi(unsigned u) { return __uint_as_float(u & 0xffff0000u); }
__device__ __forceinline__ float bf1(bf16_t u) { return __uint_as_float(((unsigned)u) << 16); }
__device__ __forceinline__ float fsigmoid(float x) { return __builtin_amdgcn_rcpf(1.0f + __builtin_amdgcn_exp2f(-x * LOG2E)); }
__device__ __forceinline__ float wave_sum(float v) {
#pragma unroll
    for (int o = 1; o < 64; o <<= 1) v += __shfl_xor(v, o);
    return v;
}
__device__ __forceinline__ float wave_max(float v) {
#pragma unroll
    for (int o = 1; o < 64; o <<= 1) v = fmaxf(v, __shfl_xor(v, o));
    return v;
}
#define LDS_WAIT() asm volatile("s_waitcnt lgkmcnt(0)" ::: "memory")

namespace pg8 {
constexpr int BM = 256, BK = 64, HALF = 128, HTB = HALF * BK * 2, STAGE_BYTES = 8 * HTB, NXCD = 8, WGM = 8;
__host__ __device__ __forceinline__ int lds_byte(int r, int c) { const int st = (r >> 4) * 2 + (c >> 5), rr = r & 15, cc = c & 31, ob = rr * 64 + cc * 2; return st * 1024 + (ob ^ (((ob >> 9) & 1) << 5)); }
__host__ __device__ __forceinline__ void stage_rc(int b, int& R, int& C) { const int st = b / 1024, sb = b % 1024, swz = sb ^ (((sb >> 9) & 1) << 5); R = (st >> 1) * 16 + swz / 64; C = (st & 1) * 32 + (swz % 64) / 2; }
__host__ __device__ __forceinline__ int perm32(int rho) { const int n = rho >> 4, i = rho & 15; return 8 * (i >> 2) + 4 * n + (i & 3); }

struct Unit { int pm, pn, last; };
struct Gemm { const bf16_t* A; const bf16_t* Bt; int lda, ldb, K, a_pn_bytes, midt; };

struct StaticOrder {
    int nM, nN, nwg, G, c, per, reps;
    __device__ void init(int M, int N, int G_, int c_, int reps_ = 1) { nM = M / BM; nN = N / BM; nwg = nM * nN; G = G_; c = c_; per = c < nwg ? (nwg - c + G - 1) / G : 0; reps = reps_; }
    __device__ bool next(int i, Unit& u) const {
        if (i >= per * reps) return false;
        const int pass = i / per; u.last = (pass == reps - 1);
        const long L = (long)(i - pass * per) * G + c;
        int wgid = (int)L; { const int q = nwg / NXCD, r = nwg % NXCD, xcd = wgid % NXCD, off = wgid / NXCD; wgid = (xcd < r ? xcd * (q + 1) : r * (q + 1) + (xcd - r) * q) + off; }
        const int nig = WGM * nN, gid = wgid / nig, fm = gid * WGM, gsz = (nM - fm) < WGM ? (nM - fm) : WGM;
        u.pm = fm + ((wgid % nig) % gsz); u.pn = (wgid % nig) / gsz; return true;
    }
};

template <class Epi>
__device__ __forceinline__ void gemm_phase(LAS unsigned char* lds, const Gemm g, const StaticOrder& S, const Epi& E) {
    const int tid = threadIdx.x, wid = __builtin_amdgcn_readfirstlane(tid >> 6), lane = tid & 63, wr = wid >> 2, wc = wid & 3, fr = lane & 15, fq = lane >> 4;
    const int K = g.K, nt = K / BK;
    unsigned voffA[2], voffB[2];
#pragma unroll
    for (int i = 0; i < 2; ++i) { int R, C; stage_rc(tid * 16 + i * 8192, R, C); const int Rb = (R & ~31) + perm32(R & 31);
        voffA[i] = (unsigned)(R * g.lda + C) * 2u; voffB[i] = (unsigned)(Rb * g.ldb + C) * 2u; }
    const size_t kstep = (size_t)(BK * 2);
    const size_t hstepA = (size_t)HALF * g.lda * 2, hstepB = (size_t)HALF * g.ldb * 2;
    const size_t tstepA = 2 * hstepA, tstepB = 2 * hstepB;
    const unsigned ldsw = (unsigned)wid * 1024u;
    const int aoff = lds_byte(wr * 64 + fr, fq * 8), boff = lds_byte(wc * 32 + fr, fq * 8);
#define PG8_SA(b, h) (((b) * 2 + (h)) * HTB)
#define PG8_SB(b, h) ((4 + (b) * 2 + (h)) * HTB)
#define PG8_STAGE(bufoff, gbase, voff) do { _Pragma("unroll") for (int _i = 0; _i < 2; ++_i) \
        __builtin_amdgcn_global_load_lds((const unsigned*)((const char*)(gbase) + (voff)[_i]), (LAS unsigned*)(lds + (bufoff) + ldsw + _i * 8192), 16, 0, 0); } while (0)
#define PG8_LDA(dst, b, h) do { _Pragma("unroll") for (int m = 0; m < 4; ++m) _Pragma("unroll") for (int k = 0; k < 2; ++k) dst[m][k] = *(const LAS bf16x8*)(lds + PG8_SA(b, h) + aoff + m * 2048 + k * 1024); } while (0)
#define PG8_LDB(dst, b, h) do { _Pragma("unroll") for (int n = 0; n < 2; ++n) _Pragma("unroll") for (int k = 0; k < 2; ++k) dst[n][k] = *(const LAS bf16x8*)(lds + PG8_SB(b, h) + boff + n * 2048 + k * 1024); } while (0)
#define PG8_MMA(ai, bj, At, Bt) do { __builtin_amdgcn_s_setprio(1); _Pragma("unroll") for (int m = 0; m < 4; ++m) _Pragma("unroll") for (int n = 0; n < 2; ++n) _Pragma("unroll") for (int k = 0; k < 2; ++k) \
        acc[ai][bj][m][n] = __builtin_amdgcn_mfma_f32_16x16x32_bf16(Bt[n][k], At[m][k], acc[ai][bj][m][n], 0, 0, 0); __builtin_amdgcn_s_setprio(0); } while (0)
#define PG8_WAIT_V(n) asm volatile("s_waitcnt vmcnt(" #n ")" ::: "memory")
#define PG8_WAIT_L(n) asm volatile("s_waitcnt lgkmcnt(" #n ")" ::: "memory")
#define PG8_BAR __builtin_amdgcn_s_barrier()
#define PG8_SCHED __builtin_amdgcn_sched_barrier(0)
    Unit cur, nxt; int ui = 0;
    if (!S.next(0, cur)) return;
    f32x4 acc[2][2][4][2];
#pragma unroll
    for (int a = 0; a < 2; ++a)
#pragma unroll
        for (int b = 0; b < 2; ++b)
#pragma unroll
            for (int m = 0; m < 4; ++m)
#pragma unroll
                for (int n = 0; n < 2; ++n) acc[a][b][m][n] = (f32x4){0.f, 0.f, 0.f, 0.f};
    bf16x8 At[4][2], B0[2][2], B1[2][2];
    const char* cA = (const char*)g.A + (size_t)cur.pm * tstepA + (size_t)cur.pn * g.a_pn_bytes; const char* cB = (const char*)g.Bt + (size_t)cur.pn * tstepB;
    PG8_STAGE(PG8_SB(0, 0), cB, voffB); PG8_STAGE(PG8_SB(0, 1), cB + hstepB, voffB); PG8_STAGE(PG8_SA(0, 0), cA, voffA); PG8_STAGE(PG8_SA(0, 1), cA + hstepA, voffA);
    if (wr == 1) PG8_BAR;
    PG8_WAIT_V(2); PG8_BAR;
    PG8_STAGE(PG8_SB(1, 0), cB + kstep, voffB); PG8_STAGE(PG8_SA(1, 0), cA + kstep, voffA); PG8_STAGE(PG8_SB(1, 1), cB + hstepB + kstep, voffB);
    PG8_WAIT_V(6); PG8_BAR;
    for (;;) {
        const bool has_next = S.next(ui + 1, nxt);
        const char* nA = has_next ? (const char*)g.A + (size_t)nxt.pm * tstepA + (size_t)nxt.pn * g.a_pn_bytes : cA; const char* nB = has_next ? (const char*)g.Bt + (size_t)nxt.pn * tstepB : cB;
#pragma unroll 1
        for (int t = 0; t < nt; t += 2) {
            const bool last = (t == nt - 2);
            if constexpr (Epi::HAS_MID) { if (t == g.midt) { E.mid(acc, cur, wr, wc, fr, fq); } PG8_SCHED; }
            const char* a1 = cA + (size_t)(t + 1) * kstep;
            const char* a2 = last ? nA : cA + (size_t)(t + 2) * kstep; const char* b2 = last ? nB : cB + (size_t)(t + 2) * kstep;
            const char* a3 = a2 + kstep; const char* b3 = b2 + kstep;
            PG8_LDB(B0, 0, 0); PG8_LDB(B1, 0, 1); PG8_SCHED; PG8_LDA(At, 0, 0); PG8_STAGE(PG8_SA(1, 1), a1 + hstepA, voffA);
            PG8_WAIT_V(8); PG8_WAIT_L(0); PG8_BAR; PG8_MMA(0, 0, At, B0); PG8_MMA(0, 1, At, B1); PG8_BAR; PG8_SCHED;
            PG8_LDA(At, 0, 1); PG8_STAGE(PG8_SB(0, 0), b2, voffB); PG8_STAGE(PG8_SB(0, 1), b2 + hstepB, voffB); PG8_STAGE(PG8_SA(0, 0), a2, voffA);
            PG8_WAIT_V(8); PG8_WAIT_L(0); PG8_BAR; PG8_MMA(1, 0, At, B0); PG8_MMA(1, 1, At, B1); PG8_BAR; PG8_SCHED;
            PG8_LDB(B0, 1, 0); PG8_LDB(B1, 1, 1); PG8_SCHED; PG8_LDA(At, 1, 0); PG8_STAGE(PG8_SA(0, 1), a2 + hstepA, voffA);
            PG8_WAIT_V(8); PG8_WAIT_L(0); PG8_BAR; PG8_MMA(0, 0, At, B0); PG8_MMA(0, 1, At, B1); PG8_BAR; PG8_SCHED;
            PG8_LDA(At, 1, 1); PG8_STAGE(PG8_SB(1, 0), b3, voffB); PG8_STAGE(PG8_SB(1, 1), b3 + hstepB, voffB); PG8_STAGE(PG8_SA(1, 0), a3, voffA);
            PG8_WAIT_V(8); PG8_WAIT_L(0); PG8_BAR; PG8_MMA(1, 0, At, B0); PG8_MMA(1, 1, At, B1); PG8_BAR; PG8_SCHED;
        }
        if (wr == 0) PG8_BAR;
        E(acc, cur, wr, wc, fr, fq);
        if (!has_next) break;
#pragma unroll
        for (int a = 0; a < 2; ++a)
#pragma unroll
            for (int b = 0; b < 2; ++b)
#pragma unroll
                for (int m = 0; m < 4; ++m)
#pragma unroll
                    for (int n = 0; n < 2; ++n) acc[a][b][m][n] = (f32x4){0.f, 0.f, 0.f, 0.f};
        cur = nxt; cA = nA; cB = nB; ++ui;
        if (wr == 1) PG8_BAR;
    }
    PG8_WAIT_V(0);
    PG8_BAR;
#undef PG8_SA
#undef PG8_SB
#undef PG8_STAGE
#undef PG8_LDA
#undef PG8_LDB
#undef PG8_MMA
#undef PG8_WAIT_V
#undef PG8_WAIT_L
#undef PG8_BAR
#undef PG8_SCHED
}

typedef f32x4 Acc[2][2][4][2];
__device__ __forceinline__ u32x4 pack8(const f32x4 v0, const f32x4 v1) { u32x4 w; w.x = cvt_pk_bf16(v0[0], v0[1]); w.y = cvt_pk_bf16(v0[2], v0[3]); w.z = cvt_pk_bf16(v1[0], v1[1]); w.w = cvt_pk_bf16(v1[2], v1[3]); return w; }

struct EpiZ {
    static constexpr bool HAS_MID = false;
    bf16_t* Z;
    __device__ __forceinline__ void operator()(Acc& acc, const Unit& u, int wr, int wc, int fr, int fq) const {
        int row0 = u.pm * BM + wr * 64 + fr; asm volatile("" : "+v"(row0)); const int col0 = u.pn * BM + wc * 32 + 8 * fq; const bool sig = u.pn >= 5;
#pragma unroll
        for (int ai = 0; ai < 2; ++ai)
#pragma unroll
            for (int m = 0; m < 4; ++m) { bf16_t* rowp = Z + (size_t)(row0 + ai * HALF + m * 16) * INW + col0;
#pragma unroll
                for (int bj = 0; bj < 2; ++bj) { f32x4 v0 = acc[ai][bj][m][0], v1 = acc[ai][bj][m][1];
                    if (sig) {
#pragma unroll
                        for (int e = 0; e < 4; ++e) { v0[e] = fsigmoid(v0[e]); v1[e] = fsigmoid(v1[e]); } }
                    *(u32x4*)(rowp + bj * HALF) = pack8(v0, v1); } }
    }
};
struct EpiBf {
    static constexpr bool HAS_MID = false;
    bf16_t* O; int ldc;
    __device__ __forceinline__ void operator()(Acc& acc, const Unit& u, int wr, int wc, int fr, int fq) const {
        int row0 = u.pm * BM + wr * 64 + fr; asm volatile("" : "+v"(row0)); const int col0 = u.pn * BM + wc * 32 + 8 * fq;
#pragma unroll
        for (int ai = 0; ai < 2; ++ai)
#pragma unroll
            for (int m = 0; m < 4; ++m) { bf16_t* rowp = O + (size_t)(row0 + ai * HALF + m * 16) * ldc + col0;
#pragma unroll
                for (int bj = 0; bj < 2; ++bj) *(u32x4*)(rowp + bj * HALF) = pack8(acc[ai][bj][m][0], acc[ai][bj][m][1]); }
    }
};
struct EpiMerge {
    static constexpr bool HAS_MID = true;
    const bf16_t* Z; bf16_t* O;
    __device__ __forceinline__ void mid(Acc& acc, const Unit& u, int wr, int wc, int fr, int fq) const {
        int row0 = u.pm * BM + wr * 64 + fr; asm volatile("" : "+v"(row0)); const int col0 = u.pn * BM + wc * 32 + 8 * fq;
#pragma unroll
        for (int ai = 0; ai < 2; ++ai)
#pragma unroll
            for (int m = 0; m < 4; ++m) { const bf16_t* zr = Z + (size_t)(row0 + ai * HALF + m * 16) * INW + col0;
#pragma unroll
                for (int bj = 0; bj < 2; ++bj) { const u32x4 a = *(const u32x4*)(zr + ZC_GA + bj * HALF), b = *(const u32x4*)(zr + ZC_GB + bj * HALF);
#pragma unroll
                    for (int e = 0; e < 4; ++e) { const float r0 = bflo(a[e]) * __builtin_amdgcn_rcpf(bflo(b[e])), r1 = bfhi(a[e]) * __builtin_amdgcn_rcpf(bfhi(b[e]));
                        acc[ai][bj][m][e >> 1][(e & 1) * 2] *= r0; acc[ai][bj][m][e >> 1][(e & 1) * 2 + 1] *= r1; } }
                asm volatile("" ::: "memory"); }
    }
    __device__ __forceinline__ void operator()(Acc& acc, const Unit& u, int wr, int wc, int fr, int fq) const {
        int row0 = u.pm * BM + wr * 64 + fr; asm volatile("" : "+v"(row0)); const int col0 = u.pn * BM + wc * 32 + 8 * fq;
#pragma unroll
        for (int ai = 0; ai < 2; ++ai)
#pragma unroll
            for (int m = 0; m < 4; ++m) { const size_t row = (size_t)(row0 + ai * HALF + m * 16); const bf16_t* zr = Z + row * INW + col0; bf16_t* rowp = O + row * D + col0;
#pragma unroll
                for (int bj = 0; bj < 2; ++bj) { const u32x4 b = *(const u32x4*)(zr + ZC_GB + bj * HALF); f32x4 v0 = acc[ai][bj][m][0], v1 = acc[ai][bj][m][1];
                    v0[0] *= bflo(b[0]); v0[1] *= bfhi(b[0]); v0[2] *= bflo(b[1]); v0[3] *= bfhi(b[1]); v1[0] *= bflo(b[2]); v1[1] *= bfhi(b[2]); v1[2] *= bflo(b[3]); v1[3] *= bfhi(b[3]);
                    *(u32x4*)(rowp + bj * HALF) = pack8(v0, v1); } }
    }
};
struct EpiX1 {
    static constexpr bool HAS_MID = false;
    const float* xp; const float* xs; float* out; bf16_t* X1B; float* sumsq;
    __device__ __forceinline__ void operator()(Acc& acc, const Unit& u, int wr, int wc, int fr, int fq) const {
        if (!u.last) return;
        int row0 = u.pm * BM + wr * 64 + fr; asm volatile("" : "+v"(row0)); const int col0 = u.pn * BM + wc * 32 + 8 * fq;
#pragma unroll
        for (int ai = 0; ai < 2; ++ai)
#pragma unroll
            for (int m = 0; m < 4; ++m) { const int row = row0 + ai * HALF + m * 16; const bool valid = row < MV;
                const float* xr = (row < MP ? xp + (size_t)row * D : xs + (size_t)(valid ? row - MP : 0) * D) + col0;
                float ss = 0.f;
#pragma unroll
                for (int bj = 0; bj < 2; ++bj) { f32x4 v0 = acc[ai][bj][m][0], v1 = acc[ai][bj][m][1];
                    if (valid) { v0 += *(const f32x4*)(xr + bj * HALF); v1 += *(const f32x4*)(xr + bj * HALF + 4);
                        *(f32x4*)(out + (size_t)row * D + col0 + bj * HALF) = v0; *(f32x4*)(out + (size_t)row * D + col0 + bj * HALF + 4) = v1; }
                    ss += (v0[0] * v0[0] + v0[1] * v0[1]) + (v0[2] * v0[2] + v0[3] * v0[3]) + (v1[0] * v1[0] + v1[1] * v1[1]) + (v1[2] * v1[2] + v1[3] * v1[3]);
                    *(u32x4*)(X1B + (size_t)row * D + col0 + bj * HALF) = pack8(v0, v1); }
                ss += __shfl_xor(ss, 16); ss += __shfl_xor(ss, 32);
                if (fq == 0) atomicAdd(sumsq + row, ss); }
    }
};
struct EpiAct {
    static constexpr bool HAS_MID = false;
    const float* sumsq; bf16_t* ACT;
    __device__ __forceinline__ void operator()(Acc& acc, const Unit& u, int wr, int wc, int fr, int fq) const {
        int row0 = u.pm * BM + wr * 64 + fr; asm volatile("" : "+v"(row0)); const int col0 = u.pn * HALF + wc * 32 + 8 * fq;
#pragma unroll
        for (int ai = 0; ai < 2; ++ai)
#pragma unroll
            for (int m = 0; m < 4; ++m) { const int row = row0 + ai * HALF + m * 16; const float rstd = __builtin_amdgcn_rsqf(sumsq[row] * (1.0f / D) + EPS);
                f32x4 o[2];
#pragma unroll
                for (int n = 0; n < 2; ++n)
#pragma unroll
                    for (int e = 0; e < 4; ++e) { const float gt = acc[ai][0][m][n][e] * rstd, up = acc[ai][1][m][n][e] * rstd; o[n][e] = gt * up * fsigmoid(gt); }
                *(u32x4*)(ACT + (size_t)row * FF + col0) = pack8(o[0], o[1]); }
    }
};
struct EpiY {
    static constexpr bool HAS_MID = false;
    float* out;
    __device__ __forceinline__ void operator()(Acc& acc, const Unit& u, int wr, int wc, int fr, int fq) const {
        if (!u.last) return;
        int row0 = u.pm * BM + wr * 64 + fr; asm volatile("" : "+v"(row0)); const int col0 = u.pn * BM + wc * 32 + 8 * fq;
#pragma unroll
        for (int ai = 0; ai < 2; ++ai)
#pragma unroll
            for (int m = 0; m < 4; ++m) { const int row = row0 + ai * HALF + m * 16;
                if (row < MV) { float* orow = out + (size_t)row * D + col0;
#pragma unroll
                    for (int bj = 0; bj < 2; ++bj) { const f32x4 a = *(const f32x4*)(orow + bj * HALF), b = *(const f32x4*)(orow + bj * HALF + 4);
                        *(f32x4*)(orow + bj * HALF) = a + acc[ai][bj][m][0]; *(f32x4*)(orow + bj * HALF + 4) = b + acc[ai][bj][m][1]; } } }
    }
};
}

struct SrcPlain { const float* W; int N; __device__ __forceinline__ float operator()(int k, int n) const { return W[(size_t)k * N + n]; } };
struct SrcMix { const float* mix; const float* scale;
    __device__ __forceinline__ float operator()(int k, int n) const { return mix[((size_t)(n >> 7) * 128 + k) * 128 + (n & 127)] * scale[n]; } };
struct SrcCat { const float* wp; const float* wa;
    __device__ __forceinline__ float operator()(int k, int n) const { return k < 512 ? wp[(size_t)k * D + n] : wa[(size_t)(k - 512) * D + n]; } };
struct SrcGU { const float* wg; const float* wu; const float* nrm;
    __device__ __forceinline__ float operator()(int k, int n) const { const int t = n >> 8, j = n & 255, col = 128 * t + (j & 127); const float* w = (const float*)((uintptr_t)wg + (uintptr_t)(j >> 7) * ((uintptr_t)wu - (uintptr_t)wg)); return w[(size_t)k * FF + col] * nrm[k]; } };

template <class Src>
__device__ __forceinline__ void transpose_item(const Src src, bf16_t* WT, int ldk, int nblk, int item, LAS float* scr, int lane) {
    const int kb = item / nblk, nb = item % nblk, k0 = 64 * kb, n0 = 32 * nb;
#pragma unroll 8
    for (int i = 0; i < 32; ++i) { const int kk = 2 * i + (lane >> 5); scr[kk * 33 + (lane & 31)] = src(k0 + kk, n0 + (lane & 31)); }
    LDS_WAIT();
    const int c = lane & 7;
#pragma unroll
    for (int j = 0; j < 4; ++j) { const int n = (lane >> 3) + 8 * j; const LAS float* s = scr + (8 * c) * 33 + n;
        u32x4 o; o.x = cvt_pk_bf16(s[0 * 33], s[1 * 33]); o.y = cvt_pk_bf16(s[2 * 33], s[3 * 33]); o.z = cvt_pk_bf16(s[4 * 33], s[5 * 33]); o.w = cvt_pk_bf16(s[6 * 33], s[7 * 33]);
        *(u32x4*)(WT + (size_t)(n0 + n) * ldk + k0 + 8 * c) = o; }
    LDS_WAIT();
}

struct Args { const float* in[19]; float* out; unsigned char* ws; int ph_lo, ph_hi; };

template <class Epi>
__device__ __forceinline__ void small_gemm(LAS unsigned char* lds, const bf16_t* A, int lda, const bf16_t* Bt, int ldb, int K, int vcu, int G, const Epi& E) {
    const int tid = threadIdx.x, lane = tid & 63, wave = __builtin_amdgcn_readfirstlane(tid >> 6), fr = lane & 15, fq = lane >> 4, rh = wave & 1, ks = wave >> 1;
    const int kq = K >> 2, nsteps = kq >> 5;
    for (int u = vcu; u < 256; u += G) {
        const int r0 = 32 * (u & 3) + 16 * rh, n0 = 16 * (u >> 2);
        const bf16_t* ap = A + (size_t)(r0 + fr) * lda + ks * kq + 8 * fq; const bf16_t* bp = Bt + (size_t)(n0 + fr) * ldb + ks * kq + 8 * fq;
        f32x4 acc = (f32x4){0.f, 0.f, 0.f, 0.f};
#pragma unroll 8
        for (int s = 0; s < nsteps; ++s) { const bf16x8 af = *(const bf16x8*)(ap + 32 * s), bf = *(const bf16x8*)(bp + 32 * s);
            acc = __builtin_amdgcn_mfma_f32_16x16x32_bf16(bf, af, acc, 0, 0, 0); }
        LAS f32x4* red = (LAS f32x4*)lds;
        red[(ks * 2 + rh) * 64 + lane] = acc;
        __syncthreads();
        if (ks == 0) { const f32x4 p0 = red[(0 * 2 + rh) * 64 + lane], p1 = red[(1 * 2 + rh) * 64 + lane], p2 = red[(2 * 2 + rh) * 64 + lane], p3 = red[(3 * 2 + rh) * 64 + lane];
            E(p0, p1, p2, p3, r0 + fr, n0 + 4 * fq, fq); }
        __syncthreads();
    }
}
struct SEpiMerge { const bf16_t* Z; bf16_t* O;
    __device__ __forceinline__ void operator()(f32x4 p0, f32x4 p1, f32x4 p2, f32x4 p3, int n, int c, int fq) const {
        const bf16_t* zr = Z + (size_t)(MP + n) * INW + c; const u32x2 a = *(const u32x2*)(zr + ZC_GA), b = *(const u32x2*)(zr + ZC_GB);
        const f32x4 pool = p0 + p1, attn = p2 + p3;
        u32x2 w; w.x = cvt_pk_bf16(bflo(a.x) * pool[0] + bflo(b.x) * attn[0], bfhi(a.x) * pool[1] + bfhi(b.x) * attn[1]);
        w.y = cvt_pk_bf16(bflo(a.y) * pool[2] + bflo(b.y) * attn[2], bfhi(a.y) * pool[3] + bfhi(b.y) * attn[3]);
        *(u32x2*)(O + (size_t)(MP + n) * D + c) = w; } };
struct SEpiX1 { const float* xs; float* out; bf16_t* X1B; float* sumsq;
    __device__ __forceinline__ void operator()(f32x4 p0, f32x4 p1, f32x4 p2, f32x4 p3, int n, int c, int fq) const {
        const f32x4 v = *(const f32x4*)(xs + (size_t)n * D + c) + ((p0 + p1) + (p2 + p3));
        *(f32x4*)(out + (size_t)(MP + n) * D + c) = v;
        u32x2 w; w.x = cvt_pk_bf16(v[0], v[1]); w.y = cvt_pk_bf16(v[2], v[3]); *(u32x2*)(X1B + (size_t)(MP + n) * D + c) = w;
        float ss = (v[0] * v[0] + v[1] * v[1]) + (v[2] * v[2] + v[3] * v[3]); ss += __shfl_xor(ss, 16); ss += __shfl_xor(ss, 32);
        if (fq == 0) atomicAdd(sumsq + MP + n, ss); } };
struct SEpiY { float* out;
    __device__ __forceinline__ void operator()(f32x4 p0, f32x4 p1, f32x4 p2, f32x4 p3, int n, int c, int fq) const {
        float* o = out + (size_t)(MP + n) * D + c; *(f32x4*)o = *(const f32x4*)o + ((p0 + p1) + (p2 + p3)); } };


__device__ __forceinline__ int crow(int r, int hi) { return (r & 3) + 8 * (r >> 2) + 4 * hi; }
constexpr int KS_STRIDE = 144, VT_STRIDE = 520, LDS_VT = 256 * KS_STRIDE  , LDS_SMP = 73728;

__device__ __forceinline__ void attn_prompt_unit(const Args& a, LAS unsigned char* lds, int unit) {
    const int tid = threadIdx.x, lane = tid & 63, wave = __builtin_amdgcn_readfirstlane(tid >> 6);
    const int kh = unit & 1, qb = (unit >> 1) & 15, b = unit >> 5;
    const bf16_t* Z = (const bf16_t*)(a.ws + WS_Z); bf16_t* YY = (bf16_t*)(a.ws + WS_RB);
    const float* qnw = a.in[7]; const float* knw = a.in[8]; const float* sinks = a.in[9];
    const size_t rowbase = (size_t)b * SEQ; const int key0 = (qb - 1) * 128;
    {
        const int j = tid >> 1, half = tid & 1, pos = key0 + j; float v[32];
        if (pos >= 0) { const u32x4* src = (const u32x4*)(Z + (rowbase + pos) * INW + ZC_K + kh * 64 + 32 * half);
#pragma unroll
            for (int c = 0; c < 4; ++c) { const u32x4 w = src[c];
#pragma unroll
                for (int e = 0; e < 4; ++e) { v[c * 8 + 2 * e] = bflo(w[e]); v[c * 8 + 2 * e + 1] = bfhi(w[e]); } } }
        else {
#pragma unroll
            for (int i = 0; i < 32; ++i) v[i] = 0.f; }
        float ss = 0.f;
#pragma unroll
        for (int i = 0; i < 32; ++i) ss += v[i] * v[i];
        ss += __shfl_xor(ss, 1);
        const float rstd = __builtin_amdgcn_rsqf(ss * (1.0f / 64) + EPS);
#pragma unroll
        for (int c = 0; c < 8; ++c) { const f32x4 w = *(const f32x4*)(knw + 32 * half + 4 * c);
#pragma unroll
            for (int e = 0; e < 4; ++e) v[4 * c + e] = v[4 * c + e] * rstd * w[e]; }
        LAS u32x4* dst = (LAS u32x4*)(lds + j * KS_STRIDE + 64 * half);
#pragma unroll
        for (int c = 0; c < 4; ++c) { u32x4 w;
#pragma unroll
            for (int e = 0; e < 4; ++e) w[e] = cvt_pk_bf16(v[c * 8 + 2 * e], v[c * 8 + 2 * e + 1]);
            dst[c] = w; }
        if (qb == 15 && j >= 128) { float* o = a.out + O_KP + ((size_t)(b * 128 + (j - 128)) * 2 + kh) * 64 + 32 * half;
#pragma unroll
            for (int c = 0; c < 8; ++c) *(f32x4*)(o + 4 * c) = (f32x4){v[4 * c], v[4 * c + 1], v[4 * c + 2], v[4 * c + 3]}; }
    }
#pragma unroll
    for (int i = 0; i < 4; ++i) { const int c = tid + 512 * i, key = c & 255, dch = c >> 8, pos = key0 + key;
        u32x4 w = (u32x4){0u, 0u, 0u, 0u};
        if (pos >= 0) w = *(const u32x4*)(Z + (rowbase + pos) * INW + ZC_V + kh * 64 + 8 * dch);
        LAS bf16_t* vt = (LAS bf16_t*)(lds + LDS_VT) + key;
#pragma unroll
        for (int e = 0; e < 4; ++e) { vt[(8 * dch + 2 * e) * (VT_STRIDE / 2)] = (bf16_t)(w[e] & 0xffffu); vt[(8 * dch + 2 * e + 1) * (VT_STRIDE / 2)] = (bf16_t)(w[e] >> 16); }
        if (qb == 15 && key >= 128) { float* o = a.out + O_VP + ((size_t)(b * 128 + (key - 128)) * 2 + kh) * 64 + 8 * dch;
            *(f32x4*)o = (f32x4){bflo(w[0]), bfhi(w[0]), bflo(w[1]), bfhi(w[1])}; *(f32x4*)(o + 4) = (f32x4){bflo(w[2]), bfhi(w[2]), bflo(w[3]), bfhi(w[3])}; } }
    __syncthreads();
    const int hq = 4 * kh + (wave >> 1), ql = lane & 31, h = lane >> 5;
    const float sink2 = sinks[hq] * LOG2E;
#pragma unroll 1
    for (int gi = 0; gi < 2; ++gi) {
        const int g = 2 * (wave & 1) + gi; const size_t qrow = rowbase + (size_t)qb * 128 + 32 * g + ql;
        bf16x8 qf[4];
        { float v[32]; const bf16_t* qp = Z + qrow * INW + ZC_Q + hq * 64 + 8 * h;
#pragma unroll
            for (int ds = 0; ds < 4; ++ds) { const u32x4 w = *(const u32x4*)(qp + 16 * ds);
#pragma unroll
                for (int e = 0; e < 4; ++e) { v[ds * 8 + 2 * e] = bflo(w[e]); v[ds * 8 + 2 * e + 1] = bfhi(w[e]); } }
            float ss = 0.f;
#pragma unroll
            for (int i = 0; i < 32; ++i) ss += v[i] * v[i];
            ss += __shfl_xor(ss, 32);
            const float sc = __builtin_amdgcn_rsqf(ss * (1.0f / 64) + EPS) * C2;
#pragma unroll
            for (int ds = 0; ds < 4; ++ds) { const f32x4 w0 = *(const f32x4*)(qnw + 16 * ds + 8 * h), w1 = *(const f32x4*)(qnw + 16 * ds + 8 * h + 4); u32x4 p;
                p.x = cvt_pk_bf16(v[ds * 8 + 0] * sc * w0[0], v[ds * 8 + 1] * sc * w0[1]); p.y = cvt_pk_bf16(v[ds * 8 + 2] * sc * w0[2], v[ds * 8 + 3] * sc * w0[3]);
                p.z = cvt_pk_bf16(v[ds * 8 + 4] * sc * w1[0], v[ds * 8 + 5] * sc * w1[1]); p.w = cvt_pk_bf16(v[ds * 8 + 6] * sc * w1[2], v[ds * 8 + 7] * sc * w1[3]);
                qf[ds] = __builtin_bit_cast(bf16x8, p); } }
        f32x16 sc[5];
#pragma unroll
        for (int i = 0; i < 5; ++i) { f32x16 acc = {};
#pragma unroll
            for (int ds = 0; ds < 4; ++ds) { const bf16x8 kf = *(const LAS bf16x8*)(lds + (32 * (g + i) + ql) * KS_STRIDE + 32 * ds + 16 * h);
                acc = __builtin_amdgcn_mfma_f32_32x32x16_bf16(kf, qf[ds], acc, 0, 0, 0); }
            sc[i] = acc; }
        const int qr = 32 * g + ql; float mx = -1e30f;
#pragma unroll
        for (int i = 0; i < 5; ++i)
#pragma unroll
            for (int r = 0; r < 16; ++r) { const int j = 32 * (g + i) + crow(r, h); const bool valid = (j >= qr) && (j <= qr + 128) && (qb > 0 || j >= 128);
                const float s = valid ? sc[i][r] : -1e30f; sc[i][r] = s; mx = fmaxf(mx, s); }
        mx = fmaxf(mx, __shfl_xor(mx, 32));
        const float mref = fmaxf(mx, sink2); float lsum = 0.f;
#pragma unroll
        for (int i = 0; i < 5; ++i)
#pragma unroll
            for (int r = 0; r < 16; ++r) { const float p = __builtin_amdgcn_exp2f(sc[i][r] - mref); sc[i][r] = p; lsum += p; }
        lsum += __shfl_xor(lsum, 32);
        const float inv = 1.0f / (lsum + __builtin_amdgcn_exp2f(sink2 - mref));
        f32x16 o[2]; o[0] = (f32x16){}; o[1] = (f32x16){};
#pragma unroll
        for (int i = 0; i < 5; ++i)
#pragma unroll
            for (int s2 = 0; s2 < 2; ++s2) { u32x4 pw;
#pragma unroll
                for (int e = 0; e < 4; ++e) pw[e] = cvt_pk_bf16(sc[i][8 * s2 + 2 * e], sc[i][8 * s2 + 2 * e + 1]);
                const bf16x8 pf = __builtin_bit_cast(bf16x8, pw);
#pragma unroll
                for (int dt = 0; dt < 2; ++dt) { const LAS unsigned char* vp = lds + LDS_VT + (32 * dt + ql) * VT_STRIDE + 2 * (32 * (g + i) + 16 * s2 + 4 * h);
                    const u32x2 lo = *(const LAS u32x2*)vp, hi2 = *(const LAS u32x2*)(vp + 16);
                    const u32x4 vw = (u32x4){lo.x, lo.y, hi2.x, hi2.y};
                    o[dt] = __builtin_amdgcn_mfma_f32_32x32x16_bf16(__builtin_bit_cast(bf16x8, vw), pf, o[dt], 0, 0, 0); } }
        bf16_t* yp = YY + qrow * D + 512 + hq * 64 + 4 * h;
#pragma unroll
        for (int dt = 0; dt < 2; ++dt)
#pragma unroll
            for (int rq = 0; rq < 4; ++rq) { u32x2 w; w.x = cvt_pk_bf16(o[dt][4 * rq] * inv, o[dt][4 * rq + 1] * inv); w.y = cvt_pk_bf16(o[dt][4 * rq + 2] * inv, o[dt][4 * rq + 3] * inv);
                *(u32x2*)(yp + 32 * dt + 8 * rq) = w; }
    }
    __syncthreads();
}

__device__ __forceinline__ void attn_sample_unit(const Args& a, LAS unsigned char* lds, int su) {
    const int tid = threadIdx.x, lane = tid & 63, wave = __builtin_amdgcn_readfirstlane(tid >> 6);
    const int n = su >> 1, kh = su & 1;
    const float* ck = a.in[2] + (size_t)n * 16384; const float* cv = a.in[3] + (size_t)n * 16384;
    if (wave < 4) {
        const int hq = 4 * kh + wave;
        const bf16_t* zrow = (const bf16_t*)(a.ws + WS_Z) + (size_t)(MP + n) * INW; bf16_t* YY = (bf16_t*)(a.ws + WS_RB);
        LAS float* qs = (LAS float*)(lds + LDS_SMP + wave * 1024); LAS float* ps = qs + 64;
        const float xq = bf1(zrow[ZC_Q + hq * 64 + lane]); const float ssq = wave_sum(xq * xq);
        const float qn = xq * __builtin_amdgcn_rsqf(ssq * (1.0f / 64) + EPS) * a.in[7][lane] * C2;
        const float xk = bf1(zrow[ZC_K + kh * 64 + lane]); const float ssk = wave_sum(xk * xk);
        const float kn = xk * __builtin_amdgcn_rsqf(ssk * (1.0f / 64) + EPS) * a.in[8][lane];
        const float vn = bf1(zrow[ZC_V + kh * 64 + lane]);
        const float s_new = wave_sum(qn * kn);
        if (wave == 0) { a.out[O_KS + (size_t)n * 16384 + (127 * 2 + kh) * 64 + lane] = kn; a.out[O_VS + (size_t)n * 16384 + (127 * 2 + kh) * 64 + lane] = vn; }
        qs[lane] = qn; LDS_WAIT();
        float s0 = 0.f, s1 = 0.f;
        { const f32x4* k0 = (const f32x4*)(ck + (size_t)(lane * 2 + kh) * 64); const f32x4* k1 = (const f32x4*)(ck + (size_t)((lane + 64) * 2 + kh) * 64);
#pragma unroll
            for (int c = 0; c < 16; ++c) { const f32x4 q4 = *(const LAS f32x4*)(qs + 4 * c), x0 = k0[c], x1 = k1[c];
                s0 += (q4[0] * x0[0] + q4[1] * x0[1]) + (q4[2] * x0[2] + q4[3] * x0[3]); s1 += (q4[0] * x1[0] + q4[1] * x1[1]) + (q4[2] * x1[2] + q4[3] * x1[3]); } }
        const float sink2 = a.in[9][hq] * LOG2E;
        const float mref = fmaxf(fmaxf(wave_max(fmaxf(s0, s1)), s_new), sink2);
        const float p0 = __builtin_amdgcn_exp2f(s0 - mref), p1 = __builtin_amdgcn_exp2f(s1 - mref), pn = __builtin_amdgcn_exp2f(s_new - mref);
        const float l = wave_sum(p0 + p1) + pn + __builtin_amdgcn_exp2f(sink2 - mref);
        ps[lane] = p0; ps[lane + 64] = p1; LDS_WAIT();
        const int kg = lane >> 4, dc = lane & 15;
        f32x4 o = (f32x4){0.f, 0.f, 0.f, 0.f};
#pragma unroll 16
        for (int j = 0; j < 32; ++j) { const int key = 4 * j + kg; const f32x4 v = *(const f32x4*)(cv + (size_t)(key * 2 + kh) * 64 + 4 * dc); o += v * ps[key]; }
#pragma unroll
        for (int e = 0; e < 4; ++e) { o[e] += __shfl_xor(o[e], 16); o[e] += __shfl_xor(o[e], 32); }
        if (kg == 0) { const f32x4 vn4 = (f32x4){bf1(zrow[ZC_V + kh * 64 + 4 * dc]), bf1(zrow[ZC_V + kh * 64 + 4 * dc + 1]), bf1(zrow[ZC_V + kh * 64 + 4 * dc + 2]), bf1(zrow[ZC_V + kh * 64 + 4 * dc + 3])};
            const float il = 1.0f / l; const f32x4 r = (o + vn4 * pn) * il;
            u32x2 w; w.x = cvt_pk_bf16(r[0], r[1]); w.y = cvt_pk_bf16(r[2], r[3]);
            *(u32x2*)(YY + (size_t)(MP + n) * D + 512 + hq * 64 + 4 * dc) = w; }
    } else {
        const int t4 = tid - 256; f32x4 tk[8], tv[8];
#pragma unroll
        for (int q = 0; q < 8; ++q) { const int i = t4 + 256 * q, row = i >> 4, c = i & 15; const size_t so = (size_t)((row + 1) * 2 + kh) * 64 + 4 * c;
            if (i < 127 * 16) { tk[q] = *(const f32x4*)(ck + so); tv[q] = *(const f32x4*)(cv + so); } }
#pragma unroll
        for (int q = 0; q < 8; ++q) { const int i = t4 + 256 * q, row = i >> 4, c = i & 15; const size_t dd = (size_t)(row * 2 + kh) * 64 + 4 * c;
            if (i < 127 * 16) { *(f32x4*)(a.out + O_KS + (size_t)n * 16384 + dd) = tk[q]; *(f32x4*)(a.out + O_VS + (size_t)n * 16384 + dd) = tv[q]; } }
    }
    __syncthreads();
}

constexpr int PL_STRIDE = 272;
template <int W>
__device__ __forceinline__ void pool_task(const Args& a, LAS unsigned char* wl, int blk, int g, int lane) {
    const bf16_t* Z = (const bf16_t*)(a.ws + WS_Z); bf16_t* YY = (bf16_t*)(a.ws + WS_RB); const bf16_t* WM = (const bf16_t*)(a.ws + WS_MIX);
    const int r0 = 32 * blk, row = lane & 31, h = lane >> 5;
    f32x16 acc[4];
#pragma unroll
    for (int nt = 0; nt < 4; ++nt) acc[nt] = (f32x16){};
    if (r0 < MP) {
        const int t0 = r0 & (SEQ - 1), b = r0 >> 11;
#pragma unroll
        for (int it = 0; it < 12; ++it) { const int rr = 4 * it + (lane >> 4);
            if (rr < 47) { u32x4 v = (u32x4){0u, 0u, 0u, 0u};
                if (t0 > 0 || rr >= 15) v = *(const u32x4*)(Z + (size_t)(r0 - 15 + rr) * INW + 128 * g + 8 * (lane & 15));
                *(LAS u32x4*)(wl + rr * PL_STRIDE + 16 * (lane & 15)) = v; } }
        LDS_WAIT();
        const int t = t0 + row; const float rc = 1.0f / (float)min(W, t + 1);
#pragma unroll 1
        for (int ks = 0; ks < 8; ++ks) {
            const LAS unsigned char* base = wl + (15 + row) * PL_STRIDE + (16 * ks + 8 * h) * 2;
            float s[8], u[8];
            { const u32x4 x = *(const LAS u32x4*)base;
#pragma unroll
                for (int e = 0; e < 4; ++e) { u[2 * e] = bflo(x[e]); u[2 * e + 1] = bfhi(x[e]); s[2 * e] = u[2 * e]; s[2 * e + 1] = u[2 * e + 1]; } }
#pragma unroll
            for (int i = 1; i < W; ++i) { const u32x4 x = *(const LAS u32x4*)(base - i * PL_STRIDE);
#pragma unroll
                for (int e = 0; e < 4; ++e) { s[2 * e] += bflo(x[e]); s[2 * e + 1] += bfhi(x[e]); } }
            u32x4 y;
#pragma unroll
            for (int e = 0; e < 4; ++e) y[e] = cvt_pk_bf16(s[2 * e] * rc - u[2 * e], s[2 * e + 1] * rc - u[2 * e + 1]);
            const bf16x8 af = __builtin_bit_cast(bf16x8, y);
            if (t >= SEQ - 15) { float* o = a.out + O_PP + ((size_t)b * 15 + (t - (SEQ - 15))) * PW + 128 * g + 16 * ks + 8 * h;
                *(f32x4*)o = (f32x4){u[0], u[1], u[2], u[3]}; *(f32x4*)(o + 4) = (f32x4){u[4], u[5], u[6], u[7]}; }
#pragma unroll
            for (int nt = 0; nt < 4; ++nt) { const bf16x8 bfr = *(const bf16x8*)(WM + (size_t)(128 * g + 32 * nt + row) * 128 + 16 * ks + 8 * h);
                acc[nt] = __builtin_amdgcn_mfma_f32_32x32x16_bf16(af, bfr, acc[nt], 0, 0, 0); }
        }
    } else {
        const int n = r0 - MP + row; const float* st = a.in[4] + (size_t)n * 15 * PW; float* po = a.out + O_PS + (size_t)n * 15 * PW; const float rc = 1.0f / (float)W;
#pragma unroll 1
        for (int ks = 0; ks < 8; ++ks) {
            const int c0 = 128 * g + 16 * ks + 8 * h;
            float s[8], u[8];
            { const u32x4 x = *(const u32x4*)(Z + (size_t)(MP + n) * INW + c0);
#pragma unroll
                for (int e = 0; e < 4; ++e) { u[2 * e] = bflo(x[e]); u[2 * e + 1] = bfhi(x[e]); s[2 * e] = u[2 * e]; s[2 * e + 1] = u[2 * e + 1]; } }
#pragma unroll
            for (int i = 1; i < W; ++i) { const f32x4 x0 = *(const f32x4*)(st + (size_t)(15 - i) * PW + c0), x1 = *(const f32x4*)(st + (size_t)(15 - i) * PW + c0 + 4);
#pragma unroll
                for (int e = 0; e < 4; ++e) { s[e] += x0[e]; s[4 + e] += x1[e]; } }
            *(f32x4*)(po + 14 * PW + c0) = (f32x4){u[0], u[1], u[2], u[3]}; *(f32x4*)(po + 14 * PW + c0 + 4) = (f32x4){u[4], u[5], u[6], u[7]};
            u32x4 y;
#pragma unroll
            for (int e = 0; e < 4; ++e) y[e] = cvt_pk_bf16(s[2 * e] * rc - u[2 * e], s[2 * e + 1] * rc - u[2 * e + 1]);
            const bf16x8 af = __builtin_bit_cast(bf16x8, y);
#pragma unroll
            for (int nt = 0; nt < 4; ++nt) { const bf16x8 bfr = *(const bf16x8*)(WM + (size_t)(128 * g + 32 * nt + row) * 128 + 16 * ks + 8 * h);
                acc[nt] = __builtin_amdgcn_mfma_f32_32x32x16_bf16(af, bfr, acc[nt], 0, 0, 0); }
        }
    }
#pragma unroll
    for (int nt = 0; nt < 4; ++nt)
#pragma unroll
        for (int r = 0; r < 16; ++r) YY[(size_t)(r0 + crow(r, h)) * D + 128 * g + 32 * nt + row] = (bf16_t)(cvt_pk_bf16(acc[nt][r], 0.f) & 0xffffu);
    LDS_WAIT();
}
__device__ __forceinline__ void pool_tasks(const Args& a, LAS unsigned char* lds, int gw, int ngw) {
    const int lane = threadIdx.x & 63, wave = __builtin_amdgcn_readfirstlane(threadIdx.x >> 6);
    LAS unsigned char* wl = lds + wave * 16384;
    constexpr int NT = (MV / 32) * 4, NSB = (NS / 32) * 4;
    for (int p = 0; p * ngw < NT; ++p) {
        const int wt = ((gw + p * (ngw >> 1)) % ngw) + p * ngw;
        if (wt >= NT) continue;
        const int w2 = wt < NSB ? (MP / 32) * 4 + wt : wt - NSB;
        const int blk = w2 >> 2, g = w2 & 3;
        if (g == 0) pool_task<2>(a, wl, blk, 0, lane); else if (g == 1) pool_task<4>(a, wl, blk, 1, lane); else if (g == 2) pool_task<8>(a, wl, blk, 2, lane); else pool_task<16>(a, wl, blk, 3, lane);
    }
}
__device__ __forceinline__ void state_roll(const Args& a, int gtid, int gthreads) {
    const f32x4* src = (const f32x4*)a.in[4]; f32x4* dst = (f32x4*)(a.out + O_PS);
    for (int i0 = gtid; i0 < NS * 1792; i0 += 2 * gthreads) { const int i1 = i0 + gthreads; const bool two = i1 < NS * 1792;
        const int n0 = i0 / 1792, j0 = i0 - n0 * 1792, n1 = two ? i1 / 1792 : 0, j1 = two ? i1 - n1 * 1792 : 0;
        const f32x4 v0 = src[(size_t)n0 * 1920 + 128 + j0], v1 = src[(size_t)n1 * 1920 + 128 + j1];
        dst[(size_t)n0 * 1920 + j0] = v0; if (two) dst[(size_t)n1 * 1920 + j1] = v1; }
}

#define XB_TMO      128
#define XB_XCNT(j)  (256  + 64 * (j))
#define XB_XSUB(j)  (1280 + 64 * (j))
#define XB_XGEN(j)  (2304 + 64 * (j))
#define XB_TOP      3328
#define XB_TOPGEN   3392
#define XCD_BAR_WORDS 3456
#define XB_SPIN_CAP (1u << 18)
__device__ __forceinline__ unsigned xb_ld(unsigned* p)              { return __hip_atomic_load(p, __ATOMIC_RELAXED, __HIP_MEMORY_SCOPE_AGENT); }
__device__ __forceinline__ unsigned xb_add(unsigned* p, unsigned v) { return __hip_atomic_fetch_add(p, v, __ATOMIC_RELAXED, __HIP_MEMORY_SCOPE_AGENT); }
__device__ __forceinline__ unsigned xb_xcc_id() { return (unsigned)__builtin_amdgcn_s_getreg((3 << 11) | 20) & 0xFu; }
#define XB_SPIN(cond, bar) do { unsigned _sp = 0; while (cond) { __builtin_amdgcn_s_sleep(1); \
    if ((++_sp & 255u) == 0u) { if (xb_ld(&(bar)[XB_TMO])) break; if (_sp > XB_SPIN_CAP) { atomicAdd(&(bar)[XB_TMO], 1u); break; } } } } while (0)
struct XcdBarrier { unsigned* bar; unsigned x; volatile LAS unsigned* st; };
__device__ __forceinline__ XcdBarrier xcd_barrier_post(unsigned* bar, volatile LAS unsigned* st) {
    XcdBarrier b; b.bar = bar; b.x = xb_xcc_id(); b.st = st;
    if (threadIdx.x == 0) (void)xb_add(&bar[XB_XCNT(b.x)], 1u);
    return b;
}
__device__ __forceinline__ void xcd_barrier_complete(unsigned* bar, unsigned x, unsigned& nloc, unsigned& nx) {
    const unsigned G = gridDim.x * gridDim.y * gridDim.z;
    unsigned sum, cnt, mine, sp = 0u;
    for (;;) {
        sum = 0u; cnt = 0u; mine = 0u;
#pragma unroll
        for (unsigned j = 0; j < 16; ++j) { const unsigned c = xb_ld(&bar[XB_XCNT(j)]); sum += c; cnt += (c > 0u) ? 1u : 0u; mine = (j == x) ? c : mine; }
        if (sum == G) break;
        __builtin_amdgcn_s_sleep(1);
        if ((++sp & 255u) == 0u) { if (xb_ld(&bar[XB_TMO])) break; if (sp > XB_SPIN_CAP) { atomicAdd(&bar[XB_TMO], 1u); break; } }
    }
    nloc = mine > 0u ? mine : 1u; nx = cnt > 0u ? cnt : 1u;
}
__device__ __forceinline__ void xcd_barrier(const XcdBarrier& b) {
    asm volatile("s_waitcnt vmcnt(0)" ::: "memory");
    __syncthreads();
    if (threadIdx.x == 0) {
        unsigned* bar = b.bar;
        __builtin_amdgcn_s_waitcnt(0);
        unsigned nloc = b.st[0], nx = b.st[1];
        if (nloc == 0u) { xcd_barrier_complete(bar, b.x, nloc, nx); b.st[0] = nloc; b.st[1] = nx; }
        const unsigned old = xb_add(&bar[XB_XSUB(b.x)], 1u);
        const unsigned gen = old / nloc;
        if (old + 1u == (gen + 1u) * nloc) {
            __builtin_amdgcn_fence(__ATOMIC_RELEASE, "agent");
            asm volatile("s_waitcnt vmcnt(0)" ::: "memory");
            const unsigned og = xb_add(&bar[XB_TOP], 1u);
            const unsigned tg = og / nx;
            if (og + 1u == (tg + 1u) * nx) xb_add(&bar[XB_TOPGEN], 1u);
            else XB_SPIN(xb_ld(&bar[XB_TOPGEN]) == tg, bar);
            __builtin_amdgcn_fence(__ATOMIC_ACQUIRE, "agent");
            xb_add(&bar[XB_XGEN(b.x)], 1u);
            asm volatile("s_waitcnt vmcnt(0)" ::: "memory");
        } else {
            XB_SPIN(xb_ld(&bar[XB_XGEN(b.x)]) == gen, bar);
            __builtin_amdgcn_fence(__ATOMIC_ACQUIRE, "agent");
            asm volatile("s_waitcnt vmcnt(0)" ::: "memory");
        }
    }
    __syncthreads();
}

__global__ void __launch_bounds__(512, 2) fwd_megakernel(Args a) {
    extern __shared__ __attribute__((aligned(16))) unsigned char lds_raw[];
    LAS unsigned char* lds = (LAS unsigned char*)lds_raw;
    cg::grid_group grid = cg::this_grid();
    const int tid = threadIdx.x, lane = tid & 63, wave = __builtin_amdgcn_readfirstlane(tid >> 6);
    const int G = gridDim.x, bx = blockIdx.x;
    const int vcu = (G % 8 == 0) ? (bx % 8) * (G / 8) + bx / 8 : bx;
    unsigned char* ws = a.ws;
    bf16_t* WIN = (bf16_t*)(ws + WS_WIN); bf16_t* WMIX = (bf16_t*)(ws + WS_MIX); bf16_t* WCAT = (bf16_t*)(ws + WS_WCAT); bf16_t* WOUT = (bf16_t*)(ws + WS_WOUT);
    bf16_t* WGU = (bf16_t*)(ws + WS_WGU); bf16_t* WDN = (bf16_t*)(ws + WS_WDN);
    bf16_t* RA = (bf16_t*)(ws + WS_RA); bf16_t* RB = (bf16_t*)(ws + WS_RB); bf16_t* Z = (bf16_t*)(ws + WS_Z);
    float* SUMSQ = (float*)(ws + WS_SUMSQ);
    const int lo = a.ph_lo, hi = a.ph_hi;
    if (tid < 2) ((volatile LAS unsigned*)(lds + LDS_MISC))[tid] = 0u;
    __syncthreads();
    XcdBarrier xbar = xcd_barrier_post((unsigned*)(ws + WS_BAR), (volatile LAS unsigned*)(lds + LDS_MISC));
    if (hi < 0) grid.sync();
#ifndef PH_MASK
#define PH_MASK 255
#endif
#define IN(k) (((PH_MASK >> (k)) & 1) && lo <= (k) && (k) < hi)
#ifndef DUP_MASK
#define DUP_MASK 0
#endif
#ifndef SMALL_REP
#define SMALL_REP 0
#endif
#ifndef EXTRA_SYNCS
#define EXTRA_SYNCS 0
#endif
#define REP(k) for (int rep_ = 0; rep_ < 1 + ((DUP_MASK >> (k)) & 1); ++rep_)
#define LASTREP(k) (rep_ == ((DUP_MASK >> (k)) & 1))
#define SEAM(k) do { if (IN(k) && IN((k) + 1)) { xcd_barrier(xbar); for (int xs_ = 0; xs_ < EXTRA_SYNCS; ++xs_) xcd_barrier(xbar); } } while (0)

    if (IN(0)) REP(0) {
        LAS float* scr = (LAS float*)(lds + wave * 16384);
        const int gw = vcu * 8 + wave, NGW = G * 8;
        constexpr int I_IN = 16 * 104, I_MIX = 2 * 16, I_CAT = 16 * 32, I_OUT = 16 * 32, I_GU = 16 * 176, I_DN = 44 * 32;
        constexpr int NITEMS = I_IN + I_MIX + I_CAT + I_OUT + I_GU + I_DN;
        for (int it = gw; it < NITEMS; it += NGW) {
            int r = it;
            if (r < I_IN) { transpose_item(SrcPlain{a.in[6], INW}, WIN, D, 104, r, scr, lane); continue; } r -= I_IN;
            if (r < I_MIX) { transpose_item(SrcMix{a.in[10], a.in[11]}, WMIX, 128, 16, r, scr, lane); continue; } r -= I_MIX;
            if (r < I_CAT) { transpose_item(SrcCat{a.in[12], a.in[13]}, WCAT, D, 32, r, scr, lane); continue; } r -= I_CAT;
            if (r < I_OUT) { transpose_item(SrcPlain{a.in[14], D}, WOUT, D, 32, r, scr, lane); continue; } r -= I_OUT;
            if (r < I_GU) { transpose_item(SrcGU{a.in[16], a.in[17], a.in[15]}, WGU, D, 176, r, scr, lane); continue; } r -= I_GU;
            transpose_item(SrcPlain{a.in[18], D}, WDN, FF, 32, r, scr, lane);
        }
        const float* g1 = a.in[5];
        for (int m = gw; m < MPAD; m += NGW) {
            unsigned long long* o8 = (unsigned long long*)(RA + (size_t)m * D) + lane;
            if (m < MV) {
                const f32x4* xr = (const f32x4*)(m < MP ? a.in[0] + (size_t)m * D : a.in[1] + (size_t)(m - MP) * D) + lane;
                f32x4 v[4]; float s = 0.f;
#pragma unroll
                for (int j = 0; j < 4; ++j) { v[j] = xr[64 * j]; s += (v[j].x * v[j].x + v[j].y * v[j].y) + (v[j].z * v[j].z + v[j].w * v[j].w); }
                const float rstd = __builtin_amdgcn_rsqf(wave_sum(s) * (1.f / D) + EPS);
#pragma unroll
                for (int j = 0; j < 4; ++j) { const f32x4 gg = ((const f32x4*)g1)[lane + 64 * j];
                    o8[64 * j] = (unsigned long long)cvt_pk_bf16(v[j].x * rstd * gg.x, v[j].y * rstd * gg.y) | ((unsigned long long)cvt_pk_bf16(v[j].z * rstd * gg.z, v[j].w * rstd * gg.w) << 32); }
            } else {
#pragma unroll
                for (int j = 0; j < 4; ++j) o8[64 * j] = 0ull;
                unsigned long long* y8 = (unsigned long long*)(RB + (size_t)m * D) + lane;
#pragma unroll
                for (int j = 0; j < 4; ++j) y8[64 * j] = 0ull;
            }
        }
        for (int i = vcu * 512 + tid; i < MPAD; i += G * 512) SUMSQ[i] = 0.f;
    }
    SEAM(0);
    if (IN(1)) {
        pg8::Gemm g{RA, WIN, D, D, D, 0, -1}; pg8::StaticOrder S; S.init(MPAD, INW, G, bx, 1 + ((DUP_MASK >> 1) & 1));
        pg8::gemm_phase(lds, g, S, pg8::EpiZ{Z});
    }
    SEAM(1);
    if (IN(2)) REP(2) {
        state_roll(a, vcu * 512 + tid, G * 512);
        for (int u = vcu; u < 256; u += G) attn_prompt_unit(a, lds, u);
        for (int su = vcu; su < 2 * NS; su += G) attn_sample_unit(a, lds, su);
        pool_tasks(a, lds, vcu * 8 + wave, G * 8);
    }
    SEAM(2);
    if (IN(4)) {
        for (int sr_ = 0; sr_ < 1 + SMALL_REP; ++sr_) small_gemm(lds, RB + (size_t)MP * D, D, WCAT, D, D, vcu, G, SEpiMerge{Z, RA});
        pg8::Gemm g{RB, WCAT, D, D, D, 0, 8}; pg8::StaticOrder S; S.init(MP, D, G, bx, 1 + ((DUP_MASK >> 4) & 1));
        pg8::gemm_phase(lds, g, S, pg8::EpiMerge{Z, RA});
    }
    SEAM(4);
    if (IN(5)) {
        small_gemm(lds, RA + (size_t)MP * D, D, WOUT, D, D, vcu, G, SEpiX1{a.in[1], a.out + O_Y, RB, SUMSQ});
        pg8::Gemm g{RA, WOUT, D, D, D, 0, -1}; pg8::StaticOrder S; S.init(MP, D, G, bx, 1 + ((DUP_MASK >> 5) & 1));
        pg8::gemm_phase(lds, g, S, pg8::EpiX1{a.in[0], a.in[1], a.out + O_Y, RB, SUMSQ});
    }
    SEAM(5);
    if (IN(6)) {
        pg8::Gemm g{RB, WGU, D, D, D, 0, -1}; pg8::StaticOrder S; S.init(MPAD, 2 * FF, G, bx, 1 + ((DUP_MASK >> 6) & 1));
        pg8::gemm_phase(lds, g, S, pg8::EpiAct{SUMSQ, Z});
    }
    SEAM(6);
    if (IN(7)) {
        small_gemm(lds, Z + (size_t)MP * FF, FF, WDN, FF, FF, vcu, G, SEpiY{a.out + O_Y});
        pg8::Gemm g{Z, WDN, FF, FF, FF, 0, -1}; pg8::StaticOrder S; S.init(MP, D, G, bx, 1 + ((DUP_MASK >> 7) & 1));
        pg8::gemm_phase(lds, g, S, pg8::EpiY{a.out + O_Y});
    }
#undef IN
#undef SEAM
}

#ifndef MK_N_LAUNCHES
#define MK_N_LAUNCHES 1
#endif
extern "C" void kernel_launch(void* const* d_in, const int* in_sizes, int n_in, void* d_out, int out_size, void* d_ws, size_t ws_size, hipStream_t stream) {
    static int grid = 0;
    if (grid == 0) {
        int dev = 0, cus = 0, per_cu = 0;
        if (n_in != 19 || ws_size < WS_END) { fprintf(stderr, "kernel_launch: unexpected inputs (n_in %d, ws %zu)\n", n_in, ws_size); grid = -1; return; }
        hipGetDevice(&dev); hipDeviceGetAttribute(&cus, hipDeviceAttributeMultiprocessorCount, dev);
        if (hipFuncSetAttribute((const void*)fwd_megakernel, hipFuncAttributeMaxDynamicSharedMemorySize, LDS_BYTES) != hipSuccess) { fprintf(stderr, "kernel_launch: hipFuncSetAttribute failed\n"); grid = -1; return; }
        if (hipOccupancyMaxActiveBlocksPerMultiprocessor(&per_cu, (const void*)fwd_megakernel, 512, LDS_BYTES) != hipSuccess || per_cu < 1) { fprintf(stderr, "kernel_launch: occupancy query says %d\n", per_cu); per_cu = 1; }
        (void)hipGetLastError();
        grid = cus * 1;
        if (per_cu < 1) grid = -1;
    }
    if (grid < 0) return;
    if (hipMemsetAsync((char*)d_ws + WS_BAR, 0, WS_BAR_BYTES, stream) != hipSuccess) { fprintf(stderr, "kernel_launch: memset failed\n"); return; }
    Args a{};
    for (int i = 0; i < 19; ++i) a.in[i] = (const float*)d_in[i];
    a.out = (float*)d_out; a.ws = (unsigned char*)d_ws;
#if MK_N_LAUNCHES == 1
    a.ph_lo = 0; a.ph_hi = 8;
    void* args[] = {&a};
    hipError_t e = hipLaunchCooperativeKernel((const void*)fwd_megakernel, dim3(grid), dim3(512), args, LDS_BYTES, stream);
    if (e != hipSuccess) fprintf(stderr, "cooperative launch failed: %s (grid %d)\n", hipGetErrorString(e), grid);
#else
    for (int p = 0; p < 8; ++p) { a.ph_lo = p; a.ph_hi = p + 1; hipLaunchKernelGGL(fwd_megakernel, dim3(grid), dim3(512), LDS_BYTES, stream, a); }
#endif
}
```

```cpp
#include <hip/hip_runtime.h>
#include <hip/hip_cooperative_groups.h>
#include <cstdio>
#include <cstdint>
namespace cg = cooperative_groups;

#define LAS __attribute__((address_space(3)))
typedef unsigned short bf16_t;
typedef short bf16x8 __attribute__((ext_vector_type(8)));
typedef short s16x4 __attribute__((ext_vector_type(4)));
typedef float f32x4 __attribute__((ext_vector_type(4)));
typedef float f32x16 __attribute__((ext_vector_type(16)));
typedef unsigned u32x4 __attribute__((ext_vector_type(4)));
typedef unsigned u32x2 __attribute__((ext_vector_type(2)));

constexpr int D = 1024, SEQ = 2048, NB = 8, MP = NB * SEQ, NS = 128, MV = MP + NS, MPAD = 16640;
constexpr int INW = 3328, FF = 2816, PW = 512;
constexpr int ZC_Q = 512, ZC_K = 1024, ZC_V = 1152, ZC_GA = 1280, ZC_GB = 2304;
constexpr float EPS = 1e-6f;
constexpr float LOG2E = 1.4426950408889634f;
constexpr float C2 = 0.125f * LOG2E;
constexpr size_t O_Y = 0, O_KP = 16908288, O_VP = 17039360, O_PP = 17170432, O_KS = 17231872, O_VS = 19329024, O_PS = 21426176;
constexpr size_t MiB = 1u << 20;
constexpr size_t WS_SUMSQ = 0;
constexpr size_t WS_BAR = 1 * MiB, WS_BAR_BYTES = 16384;
constexpr size_t WS_WIN = 2 * MiB, WS_MIX = 9 * MiB, WS_WCAT = 10 * MiB, WS_WOUT = 12 * MiB, WS_WGU = 14 * MiB, WS_WDN = 25 * MiB;
constexpr size_t WS_RA = 32 * MiB;
constexpr size_t WS_RB = 65 * MiB;
constexpr size_t WS_YPRE = 98 * MiB;
constexpr size_t WS_Z = 115 * MiB;
constexpr size_t WS_END = 222 * MiB;
constexpr int LDS_BYTES = 147456;
constexpr int LDS_MISC = 135168;

__device__ __forceinline__ unsigned cvt_pk_bf16(float lo, float hi) { unsigned r; asm("v_cvt_pk_bf16_f32 %0, %1, %2" : "=v"(r) : "v"(lo), "v"(hi)); return r; }
__device__ __forceinline__ float bflo(unsigned u) { return __uint_as_float(u << 16); }
__device__ __forceinline__ float bfhi(unsigned u) { return __uint_as_float(u & 0xffff0000u); }
__device__ __forceinline__ float bf1(bf16_t u) { return __uint_as_float(((unsigned)u) << 16); }
__device__ __forceinline__ float fsigmoid(float x) { return __builtin_amdgcn_rcpf(1.0f + __builtin_amdgcn_exp2f(-x * LOG2E)); }
__device__ __forceinline__ float wave_sum(float v) {
#pragma unroll
    for (int o = 1; o < 64; o <<= 1) v += __shfl_xor(v, o);
    return v;
}
__device__ __forceinline__ float wave_max(float v) {
#pragma unroll
    for (int o = 1; o < 64; o <<= 1) v = fmaxf(v, __shfl_xor(v, o));
    return v;
}
#define LDS_WAIT() asm volatile("s_waitcnt lgkmcnt(0)" ::: "memory")

namespace pg8 {
constexpr int BM = 256, BK = 64, HALF = 128, HTB = HALF * BK * 2, STAGE_BYTES = 8 * HTB, NXCD = 8, WGM = 8;
__host__ __device__ __forceinline__ int lds_byte(int r, int c) { const int st = (r >> 4) * 2 + (c >> 5), rr = r & 15, cc = c & 31, ob = rr * 64 + cc * 2; return st * 1024 + (ob ^ (((ob >> 9) & 1) << 5)); }
__host__ __device__ __forceinline__ void stage_rc(int b, int& R, int& C) { const int st = b / 1024, sb = b % 1024, swz = sb ^ (((sb >> 9) & 1) << 5); R = (st >> 1) * 16 + swz / 64; C = (st & 1) * 32 + (swz % 64) / 2; }
__host__ __device__ __forceinline__ int perm32(int rho) { const int n = rho >> 4, i = rho & 15; return 8 * (i >> 2) + 4 * n + (i & 3); }

struct Unit { int pm, pn, last; };
struct Gemm { const bf16_t* A; const bf16_t* Bt; int lda, ldb, K, a_pn_bytes, midt; };

struct StaticOrder {
    int nM, nN, nwg, G, c, per, reps;
    __device__ void init(int M, int N, int G_, int c_, int reps_ = 1) { nM = M / BM; nN = N / BM; nwg = nM * nN; G = G_; c = c_; per = c < nwg ? (nwg - c + G - 1) / G : 0; reps = reps_; }
    __device__ bool next(int i, Unit& u) const {
        if (i >= per * reps) return false;
        const int pass = i / per; u.last = (pass == reps - 1);
        const long L = (long)(i - pass * per) * G + c;
        int wgid = (int)L; { const int q = nwg / NXCD, r = nwg % NXCD, xcd = wgid % NXCD, off = wgid / NXCD; wgid = (xcd < r ? xcd * (q + 1) : r * (q + 1) + (xcd - r) * q) + off; }
        const int nig = WGM * nN, gid = wgid / nig, fm = gid * WGM, gsz = (nM - fm) < WGM ? (nM - fm) : WGM;
        u.pm = fm + ((wgid % nig) % gsz); u.pn = (wgid % nig) / gsz; return true;
    }
};

template <class Epi>
__device__ __forceinline__ void gemm_phase(LAS unsigned char* lds, const Gemm g, const StaticOrder& S, const Epi& E) {
    const int tid = threadIdx.x, wid = __builtin_amdgcn_readfirstlane(tid >> 6), lane = tid & 63, wr = wid >> 2, wc = wid & 3, fr = lane & 15, fq = lane >> 4;
    const int K = g.K, nt = K / BK;
    unsigned voffA[2], voffB[2];
#pragma unroll
    for (int i = 0; i < 2; ++i) { int R, C; stage_rc(tid * 16 + i * 8192, R, C); const int Rb = (R & ~31) + perm32(R & 31);
        voffA[i] = (unsigned)(R * g.lda + C) * 2u; voffB[i] = (unsigned)(Rb * g.ldb + C) * 2u; }
    const size_t kstep = (size_t)(BK * 2);
    const size_t hstepA = (size_t)HALF * g.lda * 2, hstepB = (size_t)HALF * g.ldb * 2;
    const size_t tstepA = 2 * hstepA, tstepB = 2 * hstepB;
    const unsigned ldsw = (unsigned)wid * 1024u;
    const int aoff = lds_byte(wr * 64 + fr, fq * 8), boff = lds_byte(wc * 32 + fr, fq * 8);
#define PG8_SA(b, h) (((b) * 2 + (h)) * HTB)
#define PG8_SB(b, h) ((4 + (b) * 2 + (h)) * HTB)
#define PG8_STAGE(bufoff, gbase, voff) do { _Pragma("unroll") for (int _i = 0; _i < 2; ++_i) \
        __builtin_amdgcn_global_load_lds((const unsigned*)((const char*)(gbase) + (voff)[_i]), (LAS unsigned*)(lds + (bufoff) + ldsw + _i * 8192), 16, 0, 0); } while (0)
#define PG8_LDA(dst, b, h) do { _Pragma("unroll") for (int m = 0; m < 4; ++m) _Pragma("unroll") for (int k = 0; k < 2; ++k) dst[m][k] = *(const LAS bf16x8*)(lds + PG8_SA(b, h) + aoff + m * 2048 + k * 1024); } while (0)
#define PG8_LDB(dst, b, h) do { _Pragma("unroll") for (int n = 0; n < 2; ++n) _Pragma("unroll") for (int k = 0; k < 2; ++k) dst[n][k] = *(const LAS bf16x8*)(lds + PG8_SB(b, h) + boff + n * 2048 + k * 1024); } while (0)
#define PG8_MMA(ai, bj, At, Bt) do { __builtin_amdgcn_s_setprio(1); _Pragma("unroll") for (int m = 0; m < 4; ++m) _Pragma("unroll") for (int n = 0; n < 2; ++n) _Pragma("unroll") for (int k = 0; k < 2; ++k) \
        acc[ai][bj][m][n] = __builtin_amdgcn_mfma_f32_16x16x32_bf16(Bt[n][k], At[m][k], acc[ai][bj][m][n], 0, 0, 0); __builtin_amdgcn_s_setprio(0); } while (0)
#define PG8_WAIT_V(n) asm volatile("s_waitcnt vmcnt(" #n ")" ::: "memory")
#define PG8_WAIT_L(n) asm volatile("s_waitcnt lgkmcnt(" #n ")" ::: "memory")
#define PG8_BAR __builtin_amdgcn_s_barrier()
#define PG8_SCHED __builtin_amdgcn_sched_barrier(0)
    Unit cur, nxt; int ui = 0;
    if (!S.next(0, cur)) return;
    f32x4 acc[2][2][4][2];
#pragma unroll
    for (int a = 0; a < 2; ++a)
#pragma unroll
        for (int b = 0; b < 2; ++b)
#pragma unroll
            for (int m = 0; m < 4; ++m)
#pragma unroll
                for (int n = 0; n < 2; ++n) acc[a][b][m][n] = (f32x4){0.f, 0.f, 0.f, 0.f};
    bf16x8 At[4][2], B0[2][2], B1[2][2];
    const char* cA = (const char*)g.A + (size_t)cur.pm * tstepA + (size_t)cur.pn * g.a_pn_bytes; const char* cB = (const char*)g.Bt + (size_t)cur.pn * tstepB;
    PG8_STAGE(PG8_SB(0, 0), cB, voffB); PG8_STAGE(PG8_SB(0, 1), cB + hstepB, voffB); PG8_STAGE(PG8_SA(0, 0), cA, voffA); PG8_STAGE(PG8_SA(0, 1), cA + hstepA, voffA);
    if (wr == 1) PG8_BAR;
    PG8_WAIT_V(2); PG8_BAR;
    PG8_STAGE(PG8_SB(1, 0), cB + kstep, voffB); PG8_STAGE(PG8_SA(1, 0), cA + kstep, voffA); PG8_STAGE(PG8_SB(1, 1), cB + hstepB + kstep, voffB);
    PG8_WAIT_V(6); PG8_BAR;
    for (;;) {
        const bool has_next = S.next(ui + 1, nxt);
        const char* nA = has_next ? (const char*)g.A + (size_t)nxt.pm * tstepA + (size_t)nxt.pn * g.a_pn_bytes : cA; const char* nB = has_next ? (const char*)g.Bt + (size_t)nxt.pn * tstepB : cB;
#pragma unroll 1
        for (int t = 0; t < nt; t += 2) {
            const bool last = (t == nt - 2);
            if constexpr (Epi::HAS_MID) { if (t == g.midt) { E.mid(acc, cur, wr, wc, fr, fq); } PG8_SCHED; }
            const char* a1 = cA + (size_t)(t + 1) * kstep;
            const char* a2 = last ? nA : cA + (size_t)(t + 2) * kstep; const char* b2 = last ? nB : cB + (size_t)(t + 2) * kstep;
            const char* a3 = a2 + kstep; const char* b3 = b2 + kstep;
            PG8_LDB(B0, 0, 0); PG8_LDB(B1, 0, 1); PG8_SCHED; PG8_LDA(At, 0, 0); PG8_STAGE(PG8_SA(1, 1), a1 + hstepA, voffA);
            PG8_WAIT_V(8); PG8_WAIT_L(0); PG8_BAR; PG8_MMA(0, 0, At, B0); PG8_MMA(0, 1, At, B1); PG8_BAR; PG8_SCHED;
            PG8_LDA(At, 0, 1); PG8_STAGE(PG8_SB(0, 0), b2, voffB); PG8_STAGE(PG8_SB(0, 1), b2 + hstepB, voffB); PG8_STAGE(PG8_SA(0, 0), a2, voffA);
            PG8_WAIT_V(8); PG8_WAIT_L(0); PG8_BAR; PG8_MMA(1, 0, At, B0); PG8_MMA(1, 1, At, B1); PG8_BAR; PG8_SCHED;
            PG8_LDB(B0, 1, 0); PG8_LDB(B1, 1, 1); PG8_SCHED; PG8_LDA(At, 1, 0); PG8_STAGE(PG8_SA(0, 1), a2 + hstepA, voffA);
            PG8_WAIT_V(8); PG8_WAIT_L(0); PG8_BAR; PG8_MMA(0, 0, At, B0); PG8_MMA(0, 1, At, B1); PG8_BAR; PG8_SCHED;
            PG8_LDA(At, 1, 1); PG8_STAGE(PG8_SB(1, 0), b3, voffB); PG8_STAGE(PG8_SB(1, 1), b3 + hstepB, voffB); PG8_STAGE(PG8_SA(1, 0), a3, voffA);
            PG8_WAIT_V(8); PG8_WAIT_L(0); PG8_BAR; PG8_MMA(1, 0, At, B0); PG8_MMA(1, 1, At, B1); PG8_BAR; PG8_SCHED;
        }
        if (wr == 0) PG8_BAR;
        E(acc, cur, wr, wc, fr, fq);
        if (!has_next) break;
#pragma unroll
        for (int a = 0; a < 2; ++a)
#pragma unroll
            for (int b = 0; b < 2; ++b)
#pragma unroll
                for (int m = 0; m < 4; ++m)
#pragma unroll
                    for (int n = 0; n < 2; ++n) acc[a][b][m][n] = (f32x4){0.f, 0.f, 0.f, 0.f};
        cur = nxt; cA = nA; cB = nB; ++ui;
        if (wr == 1) PG8_BAR;
    }
    PG8_WAIT_V(0);
    PG8_BAR;
#undef PG8_SA
#undef PG8_SB
#undef PG8_STAGE
#undef PG8_LDA
#undef PG8_LDB
#undef PG8_MMA
#undef PG8_WAIT_V
#undef PG8_WAIT_L
#undef PG8_BAR
#undef PG8_SCHED
}

typedef f32x4 Acc[2][2][4][2];
__device__ __forceinline__ u32x4 pack8(const f32x4 v0, const f32x4 v1) { u32x4 w; w.x = cvt_pk_bf16(v0[0], v0[1]); w.y = cvt_pk_bf16(v0[2], v0[3]); w.z = cvt_pk_bf16(v1[0], v1[1]); w.w = cvt_pk_bf16(v1[2], v1[3]); return w; }

struct EpiZ {
    static constexpr bool HAS_MID = false;
    bf16_t* Z;
    __device__ __forceinline__ void operator()(Acc& acc, const Unit& u, int wr, int wc, int fr, int fq) const {
        int row0 = u.pm * BM + wr * 64 + fr; asm volatile("" : "+v"(row0)); const int col0 = u.pn * BM + wc * 32 + 8 * fq; const bool sig = u.pn >= 5;
#pragma unroll
        for (int ai = 0; ai < 2; ++ai)
#pragma unroll
            for (int m = 0; m < 4; ++m) { bf16_t* rowp = Z + (size_t)(row0 + ai * HALF + m * 16) * INW + col0;
#pragma unroll
                for (int bj = 0; bj < 2; ++bj) { f32x4 v0 = acc[ai][bj][m][0], v1 = acc[ai][bj][m][1];
                    if (sig) {
#pragma unroll
                        for (int e = 0; e < 4; ++e) { v0[e] = fsigmoid(v0[e]); v1[e] = fsigmoid(v1[e]); } }
                    *(u32x4*)(rowp + bj * HALF) = pack8(v0, v1); } }
    }
};
struct EpiBf {
    static constexpr bool HAS_MID = false;
    bf16_t* O; int ldc;
    __device__ __forceinline__ void operator()(Acc& acc, const Unit& u, int wr, int wc, int fr, int fq) const {
        int row0 = u.pm * BM + wr * 64 + fr; asm volatile("" : "+v"(row0)); const int col0 = u.pn * BM + wc * 32 + 8 * fq;
#pragma unroll
        for (int ai = 0; ai < 2; ++ai)
#pragma unroll
            for (int m = 0; m < 4; ++m) { bf16_t* rowp = O + (size_t)(row0 + ai * HALF + m * 16) * ldc + col0;
#pragma unroll
                for (int bj = 0; bj < 2; ++bj) *(u32x4*)(rowp + bj * HALF) = pack8(acc[ai][bj][m][0], acc[ai][bj][m][1]); }
    }
};
struct EpiMerge {
    static constexpr bool HAS_MID = true;
    const bf16_t* Z; bf16_t* O;
    __device__ __forceinline__ void mid(Acc& acc, const Unit& u, int wr, int wc, int fr, int fq) const {
        int row0 = u.pm * BM + wr * 64 + fr; asm volatile("" : "+v"(row0)); const int col0 = u.pn * BM + wc * 32 + 8 * fq;
#pragma unroll
        for (int ai = 0; ai < 2; ++ai)
#pragma unroll
            for (int m = 0; m < 4; ++m) { const bf16_t* zr = Z + (size_t)(row0 + ai * HALF + m * 16) * INW + col0;
#pragma unroll
                for (int bj = 0; bj < 2; ++bj) { const u32x4 a = *(const u32x4*)(zr + ZC_GA + bj * HALF), b = *(const u32x4*)(zr + ZC_GB + bj * HALF);
#pragma unroll
                    for (int e = 0; e < 4; ++e) { const float r0 = bflo(a[e]) * __builtin_amdgcn_rcpf(bflo(b[e])), r1 = bfhi(a[e]) * __builtin_amdgcn_rcpf(bfhi(b[e]));
                        acc[ai][bj][m][e >> 1][(e & 1) * 2] *= r0; acc[ai][bj][m][e >> 1][(e & 1) * 2 + 1] *= r1; } }
                asm volatile("" ::: "memory"); }
    }
    __device__ __forceinline__ void operator()(Acc& acc, const Unit& u, int wr, int wc, int fr, int fq) const {
        int row0 = u.pm * BM + wr * 64 + fr; asm volatile("" : "+v"(row0)); const int col0 = u.pn * BM + wc * 32 + 8 * fq;
#pragma unroll
        for (int ai = 0; ai < 2; ++ai)
#pragma unroll
            for (int m = 0; m < 4; ++m) { const size_t row = (size_t)(row0 + ai * HALF + m * 16); const bf16_t* zr = Z + row * INW + col0; bf16_t* rowp = O + row * D + col0;
#pragma unroll
                for (int bj = 0; bj < 2; ++bj) { const u32x4 b = *(const u32x4*)(zr + ZC_GB + bj * HALF); f32x4 v0 = acc[ai][bj][m][0], v1 = acc[ai][bj][m][1];
                    v0[0] *= bflo(b[0]); v0[1] *= bfhi(b[0]); v0[2] *= bflo(b[1]); v0[3] *= bfhi(b[1]); v1[0] *= bflo(b[2]); v1[1] *= bfhi(b[2]); v1[2] *= bflo(b[3]); v1[3] *= bfhi(b[3]);
                    *(u32x4*)(rowp + bj * HALF) = pack8(v0, v1); } }
    }
};
struct EpiX1 {
    static constexpr bool HAS_MID = false;
    const float* xp; const float* xs; float* out; bf16_t* X1B; float* sumsq;
    __device__ __forceinline__ void operator()(Acc& acc, const Unit& u, int wr, int wc, int fr, int fq) const {
        if (!u.last) return;
        int row0 = u.pm * BM + wr * 64 + fr; asm volatile("" : "+v"(row0)); const int col0 = u.pn * BM + wc * 32 + 8 * fq;
#pragma unroll
        for (int ai = 0; ai < 2; ++ai)
#pragma unroll
            for (int m = 0; m < 4; ++m) { const int row = row0 + ai * HALF + m * 16; const bool valid = row < MV;
                const float* xr = (row < MP ? xp + (size_t)row * D : xs + (size_t)(valid ? row - MP : 0) * D) + col0;
                float ss = 0.f;
#pragma unroll
                for (int bj = 0; bj < 2; ++bj) { f32x4 v0 = acc[ai][bj][m][0], v1 = acc[ai][bj][m][1];
                    if (valid) { v0 += *(const f32x4*)(xr + bj * HALF); v1 += *(const f32x4*)(xr + bj * HALF + 4);
                        *(f32x4*)(out + (size_t)row * D + col0 + bj * HALF) = v0; *(f32x4*)(out + (size_t)row * D + col0 + bj * HALF + 4) = v1; }
                    ss += (v0[0] * v0[0] + v0[1] * v0[1]) + (v0[2] * v0[2] + v0[3] * v0[3]) + (v1[0] * v1[0] + v1[1] * v1[1]) + (v1[2] * v1[2] + v1[3] * v1[3]);
                    *(u32x4*)(X1B + (size_t)row * D + col0 + bj * HALF) = pack8(v0, v1); }
                ss += __shfl_xor(ss, 16); ss += __shfl_xor(ss, 32);
                if (fq == 0) atomicAdd(sumsq + row, ss); }
    }
};
struct EpiAct {
    static constexpr bool HAS_MID = false;
    const float* sumsq; bf16_t* ACT;
    __device__ __forceinline__ void operator()(Acc& acc, const Unit& u, int wr, int wc, int fr, int fq) const {
        int row0 = u.pm * BM + wr * 64 + fr; asm volatile("" : "+v"(row0)); const int col0 = u.pn * HALF + wc * 32 + 8 * fq;
#pragma unroll
        for (int ai = 0; ai < 2; ++ai)
#pragma unroll
            for (int m = 0; m < 4; ++m) { const int row = row0 + ai * HALF + m * 16; const float rstd = __builtin_amdgcn_rsqf(sumsq[row] * (1.0f / D) + EPS);
                f32x4 o[2];
#pragma unroll
                for (int n = 0; n < 2; ++n)
#pragma unroll
                    for (int e = 0; e < 4; ++e) { const float gt = acc[ai][0][m][n][e] * rstd, up = acc[ai][1][m][n][e] * rstd; o[n][e] = gt * up * fsigmoid(gt); }
                *(u32x4*)(ACT + (size_t)row * FF + col0) = pack8(o[0], o[1]); }
    }
};
struct EpiY {
    static constexpr bool HAS_MID = false;
    float* out;
    __device__ __forceinline__ void operator()(Acc& acc, const Unit& u, int wr, int wc, int fr, int fq) const {
        if (!u.last) return;
        int row0 = u.pm * BM + wr * 64 + fr; asm volatile("" : "+v"(row0)); const int col0 = u.pn * BM + wc * 32 + 8 * fq;
#pragma unroll
        for (int ai = 0; ai < 2; ++ai)
#pragma unroll
            for (int m = 0; m < 4; ++m) { const int row = row0 + ai * HALF + m * 16;
                if (row < MV) { float* orow = out + (size_t)row * D + col0;
#pragma unroll
                    for (int bj = 0; bj < 2; ++bj) { const f32x4 a = *(const f32x4*)(orow + bj * HALF), b = *(const f32x4*)(orow + bj * HALF + 4);
                        *(f32x4*)(orow + bj * HALF) = a + acc[ai][bj][m][0]; *(f32x4*)(orow + bj * HALF + 4) = b + acc[ai][bj][m][1]; } } }
    }
};
}

struct SrcPlain { const float* W; int N; __device__ __forceinline__ float operator()(int k, int n) const { return W[(size_t)k * N + n]; } };
struct SrcMix { const float* mix; const float* scale;
    __device__ __forceinline__ float operator()(int k, int n) const { return mix[((size_t)(n >> 7) * 128 + k) * 128 + (n & 127)] * scale[n]; } };
struct SrcCat { const float* wp; const float* wa;
    __device__ __forceinline__ float operator()(int k, int n) const { return k < 512 ? wp[(size_t)k * D + n] : wa[(size_t)(k - 512) * D + n]; } };
struct SrcGU { const float* wg; const float* wu; const float* nrm;
    __device__ __forceinline__ float operator()(int k, int n) const { const int t = n >> 8, j = n & 255, col = 128 * t + (j & 127); const float* w = (const float*)((uintptr_t)wg + (uintptr_t)(j >> 7) * ((uintptr_t)wu - (uintptr_t)wg)); return w[(size_t)k * FF + col] * nrm[k]; } };

template <class Src>
__device__ __forceinline__ void transpose_item(const Src src, bf16_t* WT, int ldk, int nblk, int item, LAS float* scr, int lane) {
    const int kb = item / nblk, nb = item % nblk, k0 = 64 * kb, n0 = 32 * nb;
    float tv[32];
#pragma unroll
    for (int i = 0; i < 32; ++i) tv[i] = src(k0 + 2 * i + (lane >> 5), n0 + (lane & 31));
#pragma unroll
    for (int i = 0; i < 32; ++i) scr[(2 * i + (lane >> 5)) * 33 + (lane & 31)] = tv[i];
    LDS_WAIT();
    const int c = lane & 7;
#pragma unroll
    for (int j = 0; j < 4; ++j) { const int n = (lane >> 3) + 8 * j; const LAS float* s = scr + (8 * c) * 33 + n;
        u32x4 o; o.x = cvt_pk_bf16(s[0 * 33], s[1 * 33]); o.y = cvt_pk_bf16(s[2 * 33], s[3 * 33]); o.z = cvt_pk_bf16(s[4 * 33], s[5 * 33]); o.w = cvt_pk_bf16(s[6 * 33], s[7 * 33]);
        *(u32x4*)(WT + (size_t)(n0 + n) * ldk + k0 + 8 * c) = o; }
    LDS_WAIT();
}

struct Args { const float* in[19]; float* out; unsigned char* ws; int ph_lo, ph_hi; };

template <class Epi>
__device__ __forceinline__ void small_gemm(LAS unsigned char* lds, const bf16_t* A, int lda, const bf16_t* Bt, int ldb, int K, int vcu, int G, const Epi& E) {
    const int tid = threadIdx.x, lane = tid & 63, wave = __builtin_amdgcn_readfirstlane(tid >> 6), fr = lane & 15, fq = lane >> 4, rh = wave & 1, ks = wave >> 1;
    const int kq = K >> 2, nsteps = kq >> 5;
    for (int u = vcu; u < 256; u += G) {
        const int r0 = 32 * (u & 3) + 16 * rh, n0 = 16 * (u >> 2);
        const bf16_t* ap = A + (size_t)(r0 + fr) * lda + ks * kq + 8 * fq; const bf16_t* bp = Bt + (size_t)(n0 + fr) * ldb + ks * kq + 8 * fq;
        f32x4 acc = (f32x4){0.f, 0.f, 0.f, 0.f};
#pragma unroll 8
        for (int s = 0; s < nsteps; ++s) { const bf16x8 af = *(const bf16x8*)(ap + 32 * s), bf = *(const bf16x8*)(bp + 32 * s);
            acc = __builtin_amdgcn_mfma_f32_16x16x32_bf16(bf, af, acc, 0, 0, 0); }
        LAS f32x4* red = (LAS f32x4*)lds;
        red[(ks * 2 + rh) * 64 + lane] = acc;
        __syncthreads();
        if (ks == 0) { const f32x4 p0 = red[(0 * 2 + rh) * 64 + lane], p1 = red[(1 * 2 + rh) * 64 + lane], p2 = red[(2 * 2 + rh) * 64 + lane], p3 = red[(3 * 2 + rh) * 64 + lane];
            E(p0, p1, p2, p3, r0 + fr, n0 + 4 * fq, fq); }
        __syncthreads();
    }
}
struct SEpiMerge { const bf16_t* Z; bf16_t* O;
    __device__ __forceinline__ void operator()(f32x4 p0, f32x4 p1, f32x4 p2, f32x4 p3, int n, int c, int fq) const {
        const bf16_t* zr = Z + (size_t)(MP + n) * INW + c; const u32x2 a = *(const u32x2*)(zr + ZC_GA), b = *(const u32x2*)(zr + ZC_GB);
        const f32x4 pool = p0 + p1, attn = p2 + p3;
        u32x2 w; w.x = cvt_pk_bf16(bflo(a.x) * pool[0] + bflo(b.x) * attn[0], bfhi(a.x) * pool[1] + bfhi(b.x) * attn[1]);
        w.y = cvt_pk_bf16(bflo(a.y) * pool[2] + bflo(b.y) * attn[2], bfhi(a.y) * pool[3] + bfhi(b.y) * attn[3]);
        *(u32x2*)(O + (size_t)(MP + n) * D + c) = w; } };
struct SEpiX1 { const float* xs; float* out; bf16_t* X1B; float* sumsq;
    __device__ __forceinline__ void operator()(f32x4 p0, f32x4 p1, f32x4 p2, f32x4 p3, int n, int c, int fq) const {
        const f32x4 v = *(const f32x4*)(xs + (size_t)n * D + c) + ((p0 + p1) + (p2 + p3));
        *(f32x4*)(out + (size_t)(MP + n) * D + c) = v;
        u32x2 w; w.x = cvt_pk_bf16(v[0], v[1]); w.y = cvt_pk_bf16(v[2], v[3]); *(u32x2*)(X1B + (size_t)(MP + n) * D + c) = w;
        float ss = (v[0] * v[0] + v[1] * v[1]) + (v[2] * v[2] + v[3] * v[3]); ss += __shfl_xor(ss, 16); ss += __shfl_xor(ss, 32);
        if (fq == 0) atomicAdd(sumsq + MP + n, ss); } };
struct SEpiY { float* out;
    __device__ __forceinline__ void operator()(f32x4 p0, f32x4 p1, f32x4 p2, f32x4 p3, int n, int c, int fq) const {
        float* o = out + (size_t)(MP + n) * D + c; *(f32x4*)o = *(const f32x4*)o + ((p0 + p1) + (p2 + p3)); } };


__device__ __forceinline__ int crow(int r, int hi) { return (r & 3) + 8 * (r >> 2) + 4 * hi; }
constexpr int KS_STRIDE = 144, VT_STRIDE = 520, LDS_VT = 256 * KS_STRIDE  , LDS_SMP = 73728;

__device__ __forceinline__ void attn_prompt_unit(const Args& a, LAS unsigned char* lds, int unit) {
    const int tid = threadIdx.x, lane = tid & 63, wave = __builtin_amdgcn_readfirstlane(tid >> 6);
    const int kh = unit & 1, qb = (unit >> 1) & 15, b = unit >> 5;
    const bf16_t* Z = (const bf16_t*)(a.ws + WS_Z); bf16_t* YY = (bf16_t*)(a.ws + WS_RB);
    const float* qnw = a.in[7]; const float* knw = a.in[8]; const float* sinks = a.in[9];
    const size_t rowbase = (size_t)b * SEQ; const int key0 = (qb - 1) * 128;
    {
        const int j = tid >> 1, half = tid & 1, pos = key0 + j; float v[32];
        if (pos >= 0) { const u32x4* src = (const u32x4*)(Z + (rowbase + pos) * INW + ZC_K + kh * 64 + 32 * half);
#pragma unroll
            for (int c = 0; c < 4; ++c) { const u32x4 w = src[c];
#pragma unroll
                for (int e = 0; e < 4; ++e) { v[c * 8 + 2 * e] = bflo(w[e]); v[c * 8 + 2 * e + 1] = bfhi(w[e]); } } }
        else {
#pragma unroll
            for (int i = 0; i < 32; ++i) v[i] = 0.f; }
        float ss = 0.f;
#pragma unroll
        for (int i = 0; i < 32; ++i) ss += v[i] * v[i];
        ss += __shfl_xor(ss, 1);
        const float rstd = __builtin_amdgcn_rsqf(ss * (1.0f / 64) + EPS);
#pragma unroll
        for (int c = 0; c < 8; ++c) { const f32x4 w = *(const f32x4*)(knw + 32 * half + 4 * c);
#pragma unroll
            for (int e = 0; e < 4; ++e) v[4 * c + e] = v[4 * c + e] * rstd * w[e]; }
        LAS u32x4* dst = (LAS u32x4*)(lds + j * KS_STRIDE + 64 * half);
#pragma unroll
        for (int c = 0; c < 4; ++c) { u32x4 w;
#pragma unroll
            for (int e = 0; e < 4; ++e) w[e] = cvt_pk_bf16(v[c * 8 + 2 * e], v[c * 8 + 2 * e + 1]);
            dst[c] = w; }
        if (qb == 15 && j >= 128) { float* o = a.out + O_KP + ((size_t)(b * 128 + (j - 128)) * 2 + kh) * 64 + 32 * half;
#pragma unroll
            for (int c = 0; c < 8; ++c) *(f32x4*)(o + 4 * c) = (f32x4){v[4 * c], v[4 * c + 1], v[4 * c + 2], v[4 * c + 3]}; }
    }
#pragma unroll
    for (int i = 0; i < 4; ++i) { const int c = tid + 512 * i, key = c & 255, dch = c >> 8, pos = key0 + key;
        u32x4 w = (u32x4){0u, 0u, 0u, 0u};
        if (pos >= 0) w = *(const u32x4*)(Z + (rowbase + pos) * INW + ZC_V + kh * 64 + 8 * dch);
        LAS bf16_t* vt = (LAS bf16_t*)(lds + LDS_VT) + key;
#pragma unroll
        for (int e = 0; e < 4; ++e) { vt[(8 * dch + 2 * e) * (VT_STRIDE / 2)] = (bf16_t)(w[e] & 0xffffu); vt[(8 * dch + 2 * e + 1) * (VT_STRIDE / 2)] = (bf16_t)(w[e] >> 16); }
        if (qb == 15 && key >= 128) { float* o = a.out + O_VP + ((size_t)(b * 128 + (key - 128)) * 2 + kh) * 64 + 8 * dch;
            *(f32x4*)o = (f32x4){bflo(w[0]), bfhi(w[0]), bflo(w[1]), bfhi(w[1])}; *(f32x4*)(o + 4) = (f32x4){bflo(w[2]), bfhi(w[2]), bflo(w[3]), bfhi(w[3])}; } }
    __syncthreads();
    const int hq = 4 * kh + (wave >> 1), ql = lane & 31, h = lane >> 5;
    const float sink2 = sinks[hq] * LOG2E;
#pragma unroll 1
    for (int gi = 0; gi < 2; ++gi) {
        const int g = 2 * (wave & 1) + gi; const size_t qrow = rowbase + (size_t)qb * 128 + 32 * g + ql;
        bf16x8 qf[4];
        { float v[32]; const bf16_t* qp = Z + qrow * INW + ZC_Q + hq * 64 + 8 * h;
#pragma unroll
            for (int ds = 0; ds < 4; ++ds) { const u32x4 w = *(const u32x4*)(qp + 16 * ds);
#pragma unroll
                for (int e = 0; e < 4; ++e) { v[ds * 8 + 2 * e] = bflo(w[e]); v[ds * 8 + 2 * e + 1] = bfhi(w[e]); } }
            float ss = 0.f;
#pragma unroll
            for (int i = 0; i < 32; ++i) ss += v[i] * v[i];
            ss += __shfl_xor(ss, 32);
            const float sc = __builtin_amdgcn_rsqf(ss * (1.0f / 64) + EPS) * C2;
#pragma unroll
            for (int ds = 0; ds < 4; ++ds) { const f32x4 w0 = *(const f32x4*)(qnw + 16 * ds + 8 * h), w1 = *(const f32x4*)(qnw + 16 * ds + 8 * h + 4); u32x4 p;
                p.x = cvt_pk_bf16(v[ds * 8 + 0] * sc * w0[0], v[ds * 8 + 1] * sc * w0[1]); p.y = cvt_pk_bf16(v[ds * 8 + 2] * sc * w0[2], v[ds * 8 + 3] * sc * w0[3]);
                p.z = cvt_pk_bf16(v[ds * 8 + 4] * sc * w1[0], v[ds * 8 + 5] * sc * w1[1]); p.w = cvt_pk_bf16(v[ds * 8 + 6] * sc * w1[2], v[ds * 8 + 7] * sc * w1[3]);
                qf[ds] = __builtin_bit_cast(bf16x8, p); } }
        f32x16 sc[5];
#pragma unroll
        for (int i = 0; i < 5; ++i) { f32x16 acc = {};
#pragma unroll
            for (int ds = 0; ds < 4; ++ds) { const bf16x8 kf = *(const LAS bf16x8*)(lds + (32 * (g + i) + ql) * KS_STRIDE + 32 * ds + 16 * h);
                acc = __builtin_amdgcn_mfma_f32_32x32x16_bf16(kf, qf[ds], acc, 0, 0, 0); }
            sc[i] = acc; }
        const int qr = 32 * g + ql; float mx = -1e30f;
#pragma unroll
        for (int i = 0; i < 5; ++i)
#pragma unroll
            for (int r = 0; r < 16; ++r) { const int j = 32 * (g + i) + crow(r, h); const bool valid = (j >= qr) && (j <= qr + 128) && (qb > 0 || j >= 128);
                const float s = valid ? sc[i][r] : -1e30f; sc[i][r] = s; mx = fmaxf(mx, s); }
        mx = fmaxf(mx, __shfl_xor(mx, 32));
        const float mref = fmaxf(mx, sink2); float lsum = 0.f;
#pragma unroll
        for (int i = 0; i < 5; ++i)
#pragma unroll
            for (int r = 0; r < 16; ++r) { const float p = __builtin_amdgcn_exp2f(sc[i][r] - mref); sc[i][r] = p; lsum += p; }
        lsum += __shfl_xor(lsum, 32);
        const float inv = 1.0f / (lsum + __builtin_amdgcn_exp2f(sink2 - mref));
        f32x16 o[2]; o[0] = (f32x16){}; o[1] = (f32x16){};
#pragma unroll
        for (int i = 0; i < 5; ++i)
#pragma unroll
            for (int s2 = 0; s2 < 2; ++s2) { u32x4 pw;
#pragma unroll
                for (int e = 0; e < 4; ++e) pw[e] = cvt_pk_bf16(sc[i][8 * s2 + 2 * e], sc[i][8 * s2 + 2 * e + 1]);
                const bf16x8 pf = __builtin_bit_cast(bf16x8, pw);
#pragma unroll
                for (int dt = 0; dt < 2; ++dt) { const LAS unsigned char* vp = lds + LDS_VT + (32 * dt + ql) * VT_STRIDE + 2 * (32 * (g + i) + 16 * s2 + 4 * h);
                    const u32x2 lo = *(const LAS u32x2*)vp, hi2 = *(const LAS u32x2*)(vp + 16);
                    const u32x4 vw = (u32x4){lo.x, lo.y, hi2.x, hi2.y};
                    o[dt] = __builtin_amdgcn_mfma_f32_32x32x16_bf16(__builtin_bit_cast(bf16x8, vw), pf, o[dt], 0, 0, 0); } }
        bf16_t* yp = YY + qrow * D + 512 + hq * 64 + 4 * h;
#pragma unroll
        for (int dt = 0; dt < 2; ++dt)
#pragma unroll
            for (int rq = 0; rq < 4; ++rq) { u32x2 w; w.x = cvt_pk_bf16(o[dt][4 * rq] * inv, o[dt][4 * rq + 1] * inv); w.y = cvt_pk_bf16(o[dt][4 * rq + 2] * inv, o[dt][4 * rq + 3] * inv);
                *(u32x2*)(yp + 32 * dt + 8 * rq) = w; }
    }
    __syncthreads();
}

__device__ __forceinline__ void attn_sample_unit(const Args& a, LAS unsigned char* lds, int su) {
    const int tid = threadIdx.x, lane = tid & 63, wave = __builtin_amdgcn_readfirstlane(tid >> 6);
    const int n = su >> 1, kh = su & 1;
    const float* ck = a.in[2] + (size_t)n * 16384; const float* cv = a.in[3] + (size_t)n * 16384;
    if (wave < 4) {
        const int hq = 4 * kh + wave;
        const bf16_t* zrow = (const bf16_t*)(a.ws + WS_Z) + (size_t)(MP + n) * INW; bf16_t* YY = (bf16_t*)(a.ws + WS_RB);
        LAS float* qs = (LAS float*)(lds + LDS_SMP + wave * 1024); LAS float* ps = qs + 64;
        const float xq = bf1(zrow[ZC_Q + hq * 64 + lane]); const float ssq = wave_sum(xq * xq);
        const float qn = xq * __builtin_amdgcn_rsqf(ssq * (1.0f / 64) + EPS) * a.in[7][lane] * C2;
        const float xk = bf1(zrow[ZC_K + kh * 64 + lane]); const float ssk = wave_sum(xk * xk);
        const float kn = xk * __builtin_amdgcn_rsqf(ssk * (1.0f / 64) + EPS) * a.in[8][lane];
        const float vn = bf1(zrow[ZC_V + kh * 64 + lane]);
        const float s_new = wave_sum(qn * kn);
        if (wave == 0) { a.out[O_KS + (size_t)n * 16384 + (127 * 2 + kh) * 64 + lane] = kn; a.out[O_VS + (size_t)n * 16384 + (127 * 2 + kh) * 64 + lane] = vn; }
        qs[lane] = qn; LDS_WAIT();
        float s0 = 0.f, s1 = 0.f;
        { const f32x4* k0 = (const f32x4*)(ck + (size_t)(lane * 2 + kh) * 64); const f32x4* k1 = (const f32x4*)(ck + (size_t)((lane + 64) * 2 + kh) * 64);
#pragma unroll
            for (int c = 0; c < 16; ++c) { const f32x4 q4 = *(const LAS f32x4*)(qs + 4 * c), x0 = k0[c], x1 = k1[c];
                s0 += (q4[0] * x0[0] + q4[1] * x0[1]) + (q4[2] * x0[2] + q4[3] * x0[3]); s1 += (q4[0] * x1[0] + q4[1] * x1[1]) + (q4[2] * x1[2] + q4[3] * x1[3]); } }
        const float sink2 = a.in[9][hq] * LOG2E;
        const float mref = fmaxf(fmaxf(wave_max(fmaxf(s0, s1)), s_new), sink2);
        const float p0 = __builtin_amdgcn_exp2f(s0 - mref), p1 = __builtin_amdgcn_exp2f(s1 - mref), pn = __builtin_amdgcn_exp2f(s_new - mref);
        const float l = wave_sum(p0 + p1) + pn + __builtin_amdgcn_exp2f(sink2 - mref);
        ps[lane] = p0; ps[lane + 64] = p1; LDS_WAIT();
        const int kg = lane >> 4, dc = lane & 15;
        f32x4 o = (f32x4){0.f, 0.f, 0.f, 0.f};
#pragma unroll 16
        for (int j = 0; j < 32; ++j) { const int key = 4 * j + kg; const f32x4 v = *(const f32x4*)(cv + (size_t)(key * 2 + kh) * 64 + 4 * dc); o += v * ps[key]; }
#pragma unroll
        for (int e = 0; e < 4; ++e) { o[e] += __shfl_xor(o[e], 16); o[e] += __shfl_xor(o[e], 32); }
        if (kg == 0) { const f32x4 vn4 = (f32x4){bf1(zrow[ZC_V + kh * 64 + 4 * dc]), bf1(zrow[ZC_V + kh * 64 + 4 * dc + 1]), bf1(zrow[ZC_V + kh * 64 + 4 * dc + 2]), bf1(zrow[ZC_V + kh * 64 + 4 * dc + 3])};
            const float il = 1.0f / l; const f32x4 r = (o + vn4 * pn) * il;
            u32x2 w; w.x = cvt_pk_bf16(r[0], r[1]); w.y = cvt_pk_bf16(r[2], r[3]);
            *(u32x2*)(YY + (size_t)(MP + n) * D + 512 + hq * 64 + 4 * dc) = w; }
    } else {
        const int t4 = tid - 256; f32x4 tk[8], tv[8];
#pragma unroll
        for (int q = 0; q < 8; ++q) { const int i = t4 + 256 * q, row = i >> 4, c = i & 15; const size_t so = (size_t)((row + 1) * 2 + kh) * 64 + 4 * c;
            if (i < 127 * 16) { tk[q] = *(const f32x4*)(ck + so); tv[q] = *(const f32x4*)(cv + so); } }
#pragma unroll
        for (int q = 0; q < 8; ++q) { const int i = t4 + 256 * q, row = i >> 4, c = i & 15; const size_t dd = (size_t)(row * 2 + kh) * 64 + 4 * c;
            if (i < 127 * 16) { *(f32x4*)(a.out + O_KS + (size_t)n * 16384 + dd) = tk[q]; *(f32x4*)(a.out + O_VS + (size_t)n * 16384 + dd) = tv[q]; } }
    }
    __syncthreads();
}

constexpr int PL_STRIDE = 272;
template <int W>
__device__ __forceinline__ void pool_task(const Args& a, LAS unsigned char* wl, int blk, int g, int lane) {
    const bf16_t* Z = (const bf16_t*)(a.ws + WS_Z); bf16_t* YY = (bf16_t*)(a.ws + WS_RB); const bf16_t* WM = (const bf16_t*)(a.ws + WS_MIX);
    const int r0 = 32 * blk, row = lane & 31, h = lane >> 5;
    f32x16 acc[4];
#pragma unroll
    for (int nt = 0; nt < 4; ++nt) acc[nt] = (f32x16){};
    if (r0 < MP) {
        const int t0 = r0 & (SEQ - 1), b = r0 >> 11;
#pragma unroll
        for (int it = 0; it < 12; ++it) { const int rr = 4 * it + (lane >> 4);
            if (rr < 47) { u32x4 v = (u32x4){0u, 0u, 0u, 0u};
                if (t0 > 0 || rr >= 15) v = *(const u32x4*)(Z + (size_t)(r0 - 15 + rr) * INW + 128 * g + 8 * (lane & 15));
                *(LAS u32x4*)(wl + rr * PL_STRIDE + 16 * (lane & 15)) = v; } }
        LDS_WAIT();
        const int t = t0 + row; const float rc = 1.0f / (float)min(W, t + 1);
#pragma unroll 1
        for (int ks = 0; ks < 8; ++ks) {
            const LAS unsigned char* base = wl + (15 + row) * PL_STRIDE + (16 * ks + 8 * h) * 2;
            float s[8], u[8];
            { const u32x4 x = *(const LAS u32x4*)base;
#pragma unroll
                for (int e = 0; e < 4; ++e) { u[2 * e] = bflo(x[e]); u[2 * e + 1] = bfhi(x[e]); s[2 * e] = u[2 * e]; s[2 * e + 1] = u[2 * e + 1]; } }
#pragma unroll
            for (int i = 1; i < W; ++i) { const u32x4 x = *(const LAS u32x4*)(base - i * PL_STRIDE);
#pragma unroll
                for (int e = 0; e < 4; ++e) { s[2 * e] += bflo(x[e]); s[2 * e + 1] += bfhi(x[e]); } }
            u32x4 y;
#pragma unroll
            for (int e = 0; e < 4; ++e) y[e] = cvt_pk_bf16(s[2 * e] * rc - u[2 * e], s[2 * e + 1] * rc - u[2 * e + 1]);
            const bf16x8 af = __builtin_bit_cast(bf16x8, y);
            if (t >= SEQ - 15) { float* o = a.out + O_PP + ((size_t)b * 15 + (t - (SEQ - 15))) * PW + 128 * g + 16 * ks + 8 * h;
                *(f32x4*)o = (f32x4){u[0], u[1], u[2], u[3]}; *(f32x4*)(o + 4) = (f32x4){u[4], u[5], u[6], u[7]}; }
#pragma unroll
            for (int nt = 0; nt < 4; ++nt) { const bf16x8 bfr = *(const bf16x8*)(WM + (size_t)(128 * g + 32 * nt + row) * 128 + 16 * ks + 8 * h);
                acc[nt] = __builtin_amdgcn_mfma_f32_32x32x16_bf16(af, bfr, acc[nt], 0, 0, 0); }
        }
    } else {
        const int n = r0 - MP + row; const float* st = a.in[4] + (size_t)n * 15 * PW; float* po = a.out + O_PS + (size_t)n * 15 * PW; const float rc = 1.0f / (float)W;
#pragma unroll 1
        for (int ks = 0; ks < 8; ++ks) {
            const int c0 = 128 * g + 16 * ks + 8 * h;
            float s[8], u[8];
            { const u32x4 x = *(const u32x4*)(Z + (size_t)(MP + n) * INW + c0);
#pragma unroll
                for (int e = 0; e < 4; ++e) { u[2 * e] = bflo(x[e]); u[2 * e + 1] = bfhi(x[e]); s[2 * e] = u[2 * e]; s[2 * e + 1] = u[2 * e + 1]; } }
#pragma unroll
            for (int i = 1; i < W; ++i) { const f32x4 x0 = *(const f32x4*)(st + (size_t)(15 - i) * PW + c0), x1 = *(const f32x4*)(st + (size_t)(15 - i) * PW + c0 + 4);
#pragma unroll
                for (int e = 0; e < 4; ++e) { s[e] += x0[e]; s[4 + e] += x1[e]; } }
            *(f32x4*)(po + 14 * PW + c0) = (f32x4){u[0], u[1], u[2], u[3]}; *(f32x4*)(po + 14 * PW + c0 + 4) = (f32x4){u[4], u[5], u[6], u[7]};
            u32x4 y;
#pragma unroll
            for (int e = 0; e < 4; ++e) y[e] = cvt_pk_bf16(s[2 * e] * rc - u[2 * e], s[2 * e + 1] * rc - u[2 * e + 1]);
            const bf16x8 af = __builtin_bit_cast(bf16x8, y);
#pragma unroll
            for (int nt = 0; nt < 4; ++nt) { const bf16x8 bfr = *(const bf16x8*)(WM + (size_t)(128 * g + 32 * nt + row) * 128 + 16 * ks + 8 * h);
                acc[nt] = __builtin_amdgcn_mfma_f32_32x32x16_bf16(af, bfr, acc[nt], 0, 0, 0); }
        }
    }
#pragma unroll
    for (int nt = 0; nt < 4; ++nt)
#pragma unroll
        for (int r = 0; r < 16; ++r) YY[(size_t)(r0 + crow(r, h)) * D + 128 * g + 32 * nt + row] = (bf16_t)(cvt_pk_bf16(acc[nt][r], 0.f) & 0xffffu);
    LDS_WAIT();
}
__device__ __forceinline__ void pool_tasks(const Args& a, LAS unsigned char* lds, int gw, int ngw) {
    const int lane = threadIdx.x & 63, wave = __builtin_amdgcn_readfirstlane(threadIdx.x >> 6);
    LAS unsigned char* wl = lds + wave * 16384;
    constexpr int NT = (MV / 32) * 4, NSB = (NS / 32) * 4;
    for (int p = 0; p * ngw < NT; ++p) {
        const int wt = ((gw + p * (ngw >> 1)) % ngw) + p * ngw;
        if (wt >= NT) continue;
        const int w2 = wt < NSB ? (MP / 32) * 4 + wt : wt - NSB;
        const int blk = w2 >> 2, g = w2 & 3;
        if (g == 0) pool_task<2>(a, wl, blk, 0, lane); else if (g == 1) pool_task<4>(a, wl, blk, 1, lane); else if (g == 2) pool_task<8>(a, wl, blk, 2, lane); else pool_task<16>(a, wl, blk, 3, lane);
    }
}
__device__ __forceinline__ void state_roll(const Args& a, int gtid, int gthreads) {
    const f32x4* src = (const f32x4*)a.in[4]; f32x4* dst = (f32x4*)(a.out + O_PS);
    for (int i0 = gtid; i0 < NS * 1792; i0 += 2 * gthreads) { const int i1 = i0 + gthreads; const bool two = i1 < NS * 1792;
        const int n0 = i0 / 1792, j0 = i0 - n0 * 1792, n1 = two ? i1 / 1792 : 0, j1 = two ? i1 - n1 * 1792 : 0;
        const f32x4 v0 = src[(size_t)n0 * 1920 + 128 + j0], v1 = src[(size_t)n1 * 1920 + 128 + j1];
        dst[(size_t)n0 * 1920 + j0] = v0; if (two) dst[(size_t)n1 * 1920 + j1] = v1; }
}

#define XB_TMO      128
#define XB_XCNT(j)  (256  + 64 * (j))
#define XB_XSUB(j)  (1280 + 64 * (j))
#define XB_XGEN(j)  (2304 + 64 * (j))
#define XB_TOP      3328
#define XB_TOPGEN   3392
#define XCD_BAR_WORDS 3456
#define XB_SPIN_CAP (1u << 18)
__device__ __forceinline__ unsigned xb_ld(unsigned* p)              { return __hip_atomic_load(p, __ATOMIC_RELAXED, __HIP_MEMORY_SCOPE_AGENT); }
__device__ __forceinline__ unsigned xb_add(unsigned* p, unsigned v) { return __hip_atomic_fetch_add(p, v, __ATOMIC_RELAXED, __HIP_MEMORY_SCOPE_AGENT); }
__device__ __forceinline__ unsigned xb_xcc_id() { return (unsigned)__builtin_amdgcn_s_getreg((3 << 11) | 20) & 0xFu; }
#define XB_SPIN(cond, bar) do { unsigned _sp = 0; while (cond) { __builtin_amdgcn_s_sleep(1); \
    if ((++_sp & 255u) == 0u) { if (xb_ld(&(bar)[XB_TMO])) break; if (_sp > XB_SPIN_CAP) { atomicAdd(&(bar)[XB_TMO], 1u); break; } } } } while (0)
struct XcdBarrier { unsigned* bar; unsigned x; volatile LAS unsigned* st; };
__device__ __forceinline__ XcdBarrier xcd_barrier_post(unsigned* bar, volatile LAS unsigned* st) {
    XcdBarrier b; b.bar = bar; b.x = xb_xcc_id(); b.st = st;
    if (threadIdx.x == 0) (void)xb_add(&bar[XB_XCNT(b.x)], 1u);
    return b;
}
__device__ __forceinline__ void xcd_barrier_complete(unsigned* bar, unsigned x, unsigned& nloc, unsigned& nx) {
    const unsigned G = gridDim.x * gridDim.y * gridDim.z;
    unsigned sum, cnt, mine, sp = 0u;
    for (;;) {
        sum = 0u; cnt = 0u; mine = 0u;
#pragma unroll
        for (unsigned j = 0; j < 16; ++j) { const unsigned c = xb_ld(&bar[XB_XCNT(j)]); sum += c; cnt += (c > 0u) ? 1u : 0u; mine = (j == x) ? c : mine; }
        if (sum == G) break;
        __builtin_amdgcn_s_sleep(1);
        if ((++sp & 255u) == 0u) { if (xb_ld(&bar[XB_TMO])) break; if (sp > XB_SPIN_CAP) { atomicAdd(&bar[XB_TMO], 1u); break; } }
    }
    nloc = mine > 0u ? mine : 1u; nx = cnt > 0u ? cnt : 1u;
}
__device__ __forceinline__ void xcd_barrier(const XcdBarrier& b) {
    asm volatile("s_waitcnt vmcnt(0)" ::: "memory");
    __syncthreads();
    if (threadIdx.x == 0) {
        unsigned* bar = b.bar;
        __builtin_amdgcn_s_waitcnt(0);
        unsigned nloc = b.st[0], nx = b.st[1];
        if (nloc == 0u) { xcd_barrier_complete(bar, b.x, nloc, nx); b.st[0] = nloc; b.st[1] = nx; }
        const unsigned old = xb_add(&bar[XB_XSUB(b.x)], 1u);
        const unsigned gen = old / nloc;
        if (old + 1u == (gen + 1u) * nloc) {
            __builtin_amdgcn_fence(__ATOMIC_RELEASE, "agent");
            asm volatile("s_waitcnt vmcnt(0)" ::: "memory");
            const unsigned og = xb_add(&bar[XB_TOP], 1u);
            const unsigned tg = og / nx;
            if (og + 1u == (tg + 1u) * nx) xb_add(&bar[XB_TOPGEN], 1u);
            else XB_SPIN(xb_ld(&bar[XB_TOPGEN]) == tg, bar);
            __builtin_amdgcn_fence(__ATOMIC_ACQUIRE, "agent");
            xb_add(&bar[XB_XGEN(b.x)], 1u);
            asm volatile("s_waitcnt vmcnt(0)" ::: "memory");
        } else {
            XB_SPIN(xb_ld(&bar[XB_XGEN(b.x)]) == gen, bar);
            __builtin_amdgcn_fence(__ATOMIC_ACQUIRE, "agent");
            asm volatile("s_waitcnt vmcnt(0)" ::: "memory");
        }
    }
    __syncthreads();
}

__global__ void __launch_bounds__(512, 2) fwd_megakernel(Args a) {
    extern __shared__ __attribute__((aligned(16))) unsigned char lds_raw[];
    LAS unsigned char* lds = (LAS unsigned char*)lds_raw;
    cg::grid_group grid = cg::this_grid();
    const int tid = threadIdx.x, lane = tid & 63, wave = __builtin_amdgcn_readfirstlane(tid >> 6);
    const int G = gridDim.x, bx = blockIdx.x;
    const int vcu = (G % 8 == 0) ? (bx % 8) * (G / 8) + bx / 8 : bx;
    unsigned char* ws = a.ws;
    bf16_t* WIN = (bf16_t*)(ws + WS_WIN); bf16_t* WMIX = (bf16_t*)(ws + WS_MIX); bf16_t* WCAT = (bf16_t*)(ws + WS_WCAT); bf16_t* WOUT = (bf16_t*)(ws + WS_WOUT);
    bf16_t* WGU = (bf16_t*)(ws + WS_WGU); bf16_t* WDN = (bf16_t*)(ws + WS_WDN);
    bf16_t* RA = (bf16_t*)(ws + WS_RA); bf16_t* RB = (bf16_t*)(ws + WS_RB); bf16_t* Z = (bf16_t*)(ws + WS_Z);
    float* SUMSQ = (float*)(ws + WS_SUMSQ);
    const int lo = a.ph_lo, hi = a.ph_hi;
    if (tid < 2) ((volatile LAS unsigned*)(lds + LDS_MISC))[tid] = 0u;
    __syncthreads();
    XcdBarrier xbar = xcd_barrier_post((unsigned*)(ws + WS_BAR), (volatile LAS unsigned*)(lds + LDS_MISC));
    if (hi < 0) grid.sync();
#ifndef PH_MASK
#define PH_MASK 255
#endif
#define IN(k) (((PH_MASK >> (k)) & 1) && lo <= (k) && (k) < hi)
#ifndef DUP_MASK
#define DUP_MASK 0
#endif
#ifndef SMALL_REP
#define SMALL_REP 0
#endif
#ifndef EXTRA_SYNCS
#define EXTRA_SYNCS 0
#endif
#define REP(k) for (int rep_ = 0; rep_ < 1 + ((DUP_MASK >> (k)) & 1); ++rep_)
#define LASTREP(k) (rep_ == ((DUP_MASK >> (k)) & 1))
#define SEAM(k) do { if (IN(k) && IN((k) + 1)) { xcd_barrier(xbar); for (int xs_ = 0; xs_ < EXTRA_SYNCS; ++xs_) xcd_barrier(xbar); } } while (0)

    if (IN(0)) REP(0) {
        LAS float* scr = (LAS float*)(lds + wave * 16384);
        const int gw = vcu * 8 + wave, NGW = G * 8;
        constexpr int I_IN = 16 * 104, I_MIX = 2 * 16;
        for (int it = gw; it < I_IN + I_MIX; it += NGW) {
            if (it < I_IN) transpose_item(SrcPlain{a.in[6], INW}, WIN, D, 104, it, scr, lane);
            else transpose_item(SrcMix{a.in[10], a.in[11]}, WMIX, 128, 16, it - I_IN, scr, lane);
        }
        const float* g1 = a.in[5];
        for (int m0 = gw; m0 < MPAD; m0 += 2 * NGW) {
            f32x4 v[2][4];
#pragma unroll
            for (int q = 0; q < 2; ++q) { const int m = m0 + q * NGW;
                if (m < MV) { const f32x4* xr = (const f32x4*)(m < MP ? a.in[0] + (size_t)m * D : a.in[1] + (size_t)(m - MP) * D) + lane;
#pragma unroll
                    for (int j = 0; j < 4; ++j) v[q][j] = xr[64 * j]; }
                else {
#pragma unroll
                    for (int j = 0; j < 4; ++j) v[q][j] = (f32x4){0.f, 0.f, 0.f, 0.f}; } }
#pragma unroll
            for (int q = 0; q < 2; ++q) { const int m = m0 + q * NGW;
                if (m < MPAD) { float sq = 0.f;
#pragma unroll
                    for (int j = 0; j < 4; ++j) sq += (v[q][j].x * v[q][j].x + v[q][j].y * v[q][j].y) + (v[q][j].z * v[q][j].z + v[q][j].w * v[q][j].w);
                    const float rstd = __builtin_amdgcn_rsqf(wave_sum(sq) * (1.f / D) + EPS);
                    unsigned long long* o8 = (unsigned long long*)(RA + (size_t)m * D) + lane;
#pragma unroll
                    for (int j = 0; j < 4; ++j) { const f32x4 gg = ((const f32x4*)g1)[lane + 64 * j];
                        o8[64 * j] = (unsigned long long)cvt_pk_bf16(v[q][j].x * rstd * gg.x, v[q][j].y * rstd * gg.y) | ((unsigned long long)cvt_pk_bf16(v[q][j].z * rstd * gg.z, v[q][j].w * rstd * gg.w) << 32); }
                    if (m >= MV) { unsigned long long* y8 = (unsigned long long*)(RB + (size_t)m * D) + lane;
#pragma unroll
                        for (int j = 0; j < 4; ++j) y8[64 * j] = 0ull; } } }
        }
        for (int i = vcu * 512 + tid; i < MPAD; i += G * 512) SUMSQ[i] = 0.f;
    }
    SEAM(0);
    if (IN(1)) {
        pg8::Gemm g{RA, WIN, D, D, D, 0, -1}; pg8::StaticOrder S; S.init(MPAD, INW, G, bx, 1 + ((DUP_MASK >> 1) & 1));
        pg8::gemm_phase(lds, g, S, pg8::EpiZ{Z});
        { const int maxper = (S.nwg + G - 1) / G, rem = S.nwg - (maxper - 1) * G; const bool all = rem >= G; const int nid = all ? G : G - rem, rk = all ? bx : bx - rem;
            if (rk >= 0) { LAS float* scr = (LAS float*)(lds + wave * 16384);
                constexpr int I_CAT = 16 * 32, I_OUT = 16 * 32, I_GU = 16 * 176, I_DN = 44 * 32;
                for (int it = rk * 8 + wave; it < I_CAT + I_OUT + I_GU + I_DN; it += nid * 8) {
                    int r = it;
                    if (r < I_CAT) { transpose_item(SrcCat{a.in[12], a.in[13]}, WCAT, D, 32, r, scr, lane); continue; } r -= I_CAT;
                    if (r < I_OUT) { transpose_item(SrcPlain{a.in[14], D}, WOUT, D, 32, r, scr, lane); continue; } r -= I_OUT;
                    if (r < I_GU) { transpose_item(SrcGU{a.in[16], a.in[17], a.in[15]}, WGU, D, 176, r, scr, lane); continue; } r -= I_GU;
                    transpose_item(SrcPlain{a.in[18], D}, WDN, FF, 32, r, scr, lane);
                } } }
    }
    SEAM(1);
    if (IN(2)) REP(2) {
        state_roll(a, vcu * 512 + tid, G * 512);
        for (int u = vcu; u < 256; u += G) attn_prompt_unit(a, lds, u);
        for (int su = vcu; su < 2 * NS; su += G) attn_sample_unit(a, lds, su);
        pool_tasks(a, lds, vcu * 8 + wave, G * 8);
    }
    SEAM(2);
    if (IN(4)) {
        for (int sr_ = 0; sr_ < 1 + SMALL_REP; ++sr_) small_gemm(lds, RB + (size_t)MP * D, D, WCAT, D, D, vcu, G, SEpiMerge{Z, RA});
        pg8::Gemm g{RB, WCAT, D, D, D, 0, 8}; pg8::StaticOrder S; S.init(MP, D, G, bx, 1 + ((DUP_MASK >> 4) & 1));
        pg8::gemm_phase(lds, g, S, pg8::EpiMerge{Z, RA});
    }
    SEAM(4);
    if (IN(5)) {
        small_gemm(lds, RA + (size_t)MP * D, D, WOUT, D, D, vcu, G, SEpiX1{a.in[1], a.out + O_Y, RB, SUMSQ});
        pg8::Gemm g{RA, WOUT, D, D, D, 0, -1}; pg8::StaticOrder S; S.init(MP, D, G, bx, 1 + ((DUP_MASK >> 5) & 1));
        pg8::gemm_phase(lds, g, S, pg8::EpiX1{a.in[0], a.in[1], a.out + O_Y, RB, SUMSQ});
    }
    SEAM(5);
    if (IN(6)) {
        pg8::Gemm g{RB, WGU, D, D, D, 0, -1}; pg8::StaticOrder S; S.init(MPAD, 2 * FF, G, bx, 1 + ((DUP_MASK >> 6) & 1));
        pg8::gemm_phase(lds, g, S, pg8::EpiAct{SUMSQ, Z});
    }
    SEAM(6);
    if (IN(7)) {
        small_gemm(lds, Z + (size_t)MP * FF, FF, WDN, FF, FF, vcu, G, SEpiY{a.out + O_Y});
        pg8::Gemm g{Z, WDN, FF, FF, FF, 0, -1}; pg8::StaticOrder S; S.init(MP, D, G, bx, 1 + ((DUP_MASK >> 7) & 1));
        pg8::gemm_phase(lds, g, S, pg8::EpiY{a.out + O_Y});
    }
#undef IN
#undef SEAM
}

#ifndef MK_N_LAUNCHES
#define MK_N_LAUNCHES 1
#endif
extern "C" void kernel_launch(void* const* d_in, const int* in_sizes, int n_in, void* d_out, int out_size, void* d_ws, size_t ws_size, hipStream_t stream) {
    static int grid = 0;
    if (grid == 0) {
        int dev = 0, cus = 0, per_cu = 0;
        if (n_in != 19 || ws_size < WS_END) { fprintf(stderr, "kernel_launch: unexpected inputs (n_in %d, ws %zu)\n", n_in, ws_size); grid = -1; return; }
        hipGetDevice(&dev); hipDeviceGetAttribute(&cus, hipDeviceAttributeMultiprocessorCount, dev);
        if (hipFuncSetAttribute((const void*)fwd_megakernel, hipFuncAttributeMaxDynamicSharedMemorySize, LDS_BYTES) != hipSuccess) { fprintf(stderr, "kernel_launch: hipFuncSetAttribute failed\n"); grid = -1; return; }
        if (hipOccupancyMaxActiveBlocksPerMultiprocessor(&per_cu, (const void*)fwd_megakernel, 512, LDS_BYTES) != hipSuccess || per_cu < 1) { fprintf(stderr, "kernel_launch: occupancy query says %d\n", per_cu); per_cu = 1; }
        (void)hipGetLastError();
        grid = cus * 1;
        if (per_cu < 1) grid = -1;
    }
    if (grid < 0) return;
    if (hipMemsetAsync((char*)d_ws + WS_BAR, 0, WS_BAR_BYTES, stream) != hipSuccess) { fprintf(stderr, "kernel_launch: memset failed\n"); return; }
    Args a{};
    for (int i = 0; i < 19; ++i) a.in[i] = (const float*)d_in[i];
    a.out = (float*)d_out; a.ws = (unsigned char*)d_ws;
#if MK_N_LAUNCHES == 1
    a.ph_lo = 0; a.ph_hi = 8;
    void* args[] = {&a};
    hipError_t e = hipLaunchCooperativeKernel((const void*)fwd_megakernel, dim3(grid), dim3(512), args, LDS_BYTES, stream);
    if (e != hipSuccess) fprintf(stderr, "cooperative launch failed: %s (grid %d)\n", hipGetErrorString(e), grid);
#else
    for (int p = 0; p < 8; ++p) { a.ph_lo = p; a.ph_hi = p + 1; hipLaunchKernelGGL(fwd_megakernel, dim3(grid), dim3(512), LDS_BYTES, stream, a); }
#endif
}
```

```cpp
#include <hip/hip_runtime.h>
#include <hip/hip_cooperative_groups.h>
#include <cstdio>
#include <cstdint>
namespace cg = cooperative_groups;

#define LAS __attribute__((address_space(3)))
typedef unsigned short bf16_t;
typedef short bf16x8 __attribute__((ext_vector_type(8)));
typedef short s16x4 __attribute__((ext_vector_type(4)));
typedef float f32x4 __attribute__((ext_vector_type(4)));
typedef float f32x16 __attribute__((ext_vector_type(16)));
typedef unsigned u32x4 __attribute__((ext_vector_type(4)));
typedef unsigned u32x2 __attribute__((ext_vector_type(2)));

constexpr int D = 1024, SEQ = 2048, NB = 8, MP = NB * SEQ, NS = 128, MV = MP + NS, MPAD = 16640;
constexpr int INW = 3328, FF = 2816, PW = 512;
constexpr int ZC_Q = 512, ZC_K = 1024, ZC_V = 1152, ZC_GA = 1280, ZC_GB = 2304;
constexpr float EPS = 1e-6f;
constexpr float LOG2E = 1.4426950408889634f;
constexpr float C2 = 0.125f * LOG2E;
constexpr size_t O_Y = 0, O_KP = 16908288, O_VP = 17039360, O_PP = 17170432, O_KS = 17231872, O_VS = 19329024, O_PS = 21426176;
constexpr size_t MiB = 1u << 20;
constexpr size_t WS_SUMSQ = 0;
constexpr size_t WS_BAR = 1 * MiB, WS_BAR_BYTES = 16384;
constexpr size_t WS_WIN = 2 * MiB, WS_MIX = 9 * MiB, WS_WCAT = 10 * MiB, WS_WOUT = 12 * MiB, WS_WGU = 14 * MiB, WS_WDN = 25 * MiB;
constexpr size_t WS_RA = 32 * MiB;
constexpr size_t WS_RB = 65 * MiB;
constexpr size_t WS_YPRE = 98 * MiB;
constexpr size_t WS_Z = 115 * MiB;
constexpr size_t WS_END = 222 * MiB;
constexpr int LDS_BYTES = 147456;
constexpr int LDS_MISC = 135168;

__device__ __forceinline__ unsigned cvt_pk_bf16(float lo, float hi) { unsigned r; asm("v_cvt_pk_bf16_f32 %0, %1, %2" : "=v"(r) : "v"(lo), "v"(hi)); return r; }
__device__ __forceinline__ float bflo(unsigned u) { return __uint_as_float(u << 16); }
__device__ __forceinline__ float bfhi(unsigned u) { return __uint_as_float(u & 0xffff0000u); }
__device__ __forceinline__ float bf1(bf16_t u) { return __uint_as_float(((unsigned)u) << 16); }
__device__ __forceinline__ float fsigmoid(float x) { return __builtin_amdgcn_rcpf(1.0f + __builtin_amdgcn_exp2f(-x * LOG2E)); }
__device__ __forceinline__ float wave_sum(float v) {
#pragma unroll
    for (int o = 1; o < 64; o <<= 1) v += __shfl_xor(v, o);
    return v;
}
__device__ __forceinline__ float wave_max(float v) {
#pragma unroll
    for (int o = 1; o < 64; o <<= 1) v = fmaxf(v, __shfl_xor(v, o));
    return v;
}
#define LDS_WAIT() asm volatile("s_waitcnt lgkmcnt(0)" ::: "memory")

namespace pg8 {
constexpr int BM = 256, BK = 64, HALF = 128, HTB = HALF * BK * 2, STAGE_BYTES = 8 * HTB, NXCD = 8, WGM = 8;
__host__ __device__ __forceinline__ int lds_byte(int r, int c) { const int st = (r >> 4) * 2 + (c >> 5), rr = r & 15, cc = c & 31, ob = rr * 64 + cc * 2; return st * 1024 + (ob ^ (((ob >> 9) & 1) << 5)); }
__host__ __device__ __forceinline__ void stage_rc(int b, int& R, int& C) { const int st = b / 1024, sb = b % 1024, swz = sb ^ (((sb >> 9) & 1) << 5); R = (st >> 1) * 16 + swz / 64; C = (st & 1) * 32 + (swz % 64) / 2; }
__host__ __device__ __forceinline__ int perm32(int rho) { const int n = rho >> 4, i = rho & 15; return 8 * (i >> 2) + 4 * n + (i & 3); }

struct Unit { int pm, pn, last; };
struct Gemm { const bf16_t* A; const bf16_t* Bt; int lda, ldb, K, a_pn_bytes, midt; };

struct StaticOrder {
    int nM, nN, nwg, G, c, per, reps;
    __device__ void init(int M, int N, int G_, int c_, int reps_ = 1) { nM = M / BM; nN = N / BM; nwg = nM * nN; G = G_; c = c_; per = c < nwg ? (nwg - c + G - 1) / G : 0; reps = reps_; }
    __device__ bool next(int i, Unit& u) const {
        if (i >= per * reps) return false;
        const int pass = i / per; u.last = (pass == reps - 1);
        const long L = (long)(i - pass * per) * G + c;
        int wgid = (int)L; { const int q = nwg / NXCD, r = nwg % NXCD, xcd = wgid % NXCD, off = wgid / NXCD; wgid = (xcd < r ? xcd * (q + 1) : r * (q + 1) + (xcd - r) * q) + off; }
        const int nig = WGM * nN, gid = wgid / nig, fm = gid * WGM, gsz = (nM - fm) < WGM ? (nM - fm) : WGM;
        u.pm = fm + ((wgid % nig) % gsz); u.pn = (wgid % nig) / gsz; return true;
    }
};

template <class Epi>
__device__ __forceinline__ void gemm_phase(LAS unsigned char* lds, const Gemm g, const StaticOrder& S, const Epi& E) {
    const int tid = threadIdx.x, wid = __builtin_amdgcn_readfirstlane(tid >> 6), lane = tid & 63, wr = wid >> 2, wc = wid & 3, fr = lane & 15, fq = lane >> 4;
    const int K = g.K, nt = K / BK;
    unsigned voffA[2], voffB[2];
#pragma unroll
    for (int i = 0; i < 2; ++i) { int R, C; stage_rc(tid * 16 + i * 8192, R, C); const int Rb = (R & ~31) + perm32(R & 31);
        voffA[i] = (unsigned)(R * g.lda + C) * 2u; voffB[i] = (unsigned)(Rb * g.ldb + C) * 2u; }
    const size_t kstep = (size_t)(BK * 2);
    const size_t hstepA = (size_t)HALF * g.lda * 2, hstepB = (size_t)HALF * g.ldb * 2;
    const size_t tstepA = 2 * hstepA, tstepB = 2 * hstepB;
    const unsigned ldsw = (unsigned)wid * 1024u;
    const int aoff = lds_byte(wr * 64 + fr, fq * 8), boff = lds_byte(wc * 32 + fr, fq * 8);
#define PG8_SA(b, h) (((b) * 2 + (h)) * HTB)
#define PG8_SB(b, h) ((4 + (b) * 2 + (h)) * HTB)
#define PG8_STAGE(bufoff, gbase, voff) do { _Pragma("unroll") for (int _i = 0; _i < 2; ++_i) \
        __builtin_amdgcn_global_load_lds((const unsigned*)((const char*)(gbase) + (voff)[_i]), (LAS unsigned*)(lds + (bufoff) + ldsw + _i * 8192), 16, 0, 0); } while (0)
#define PG8_LDA(dst, b, h) do { _Pragma("unroll") for (int m = 0; m < 4; ++m) _Pragma("unroll") for (int k = 0; k < 2; ++k) dst[m][k] = *(const LAS bf16x8*)(lds + PG8_SA(b, h) + aoff + m * 2048 + k * 1024); } while (0)
#define PG8_LDB(dst, b, h) do { _Pragma("unroll") for (int n = 0; n < 2; ++n) _Pragma("unroll") for (int k = 0; k < 2; ++k) dst[n][k] = *(const LAS bf16x8*)(lds + PG8_SB(b, h) + boff + n * 2048 + k * 1024); } while (0)
#define PG8_MMA(ai, bj, At, Bt) do { __builtin_amdgcn_s_setprio(1); _Pragma("unroll") for (int m = 0; m < 4; ++m) _Pragma("unroll") for (int n = 0; n < 2; ++n) _Pragma("unroll") for (int k = 0; k < 2; ++k) \
        acc[ai][bj][m][n] = __builtin_amdgcn_mfma_f32_16x16x32_bf16(Bt[n][k], At[m][k], acc[ai][bj][m][n], 0, 0, 0); __builtin_amdgcn_s_setprio(0); } while (0)
#define PG8_WAIT_V(n) asm volatile("s_waitcnt vmcnt(" #n ")" ::: "memory")
#define PG8_WAIT_L(n) asm volatile("s_waitcnt lgkmcnt(" #n ")" ::: "memory")
#define PG8_BAR __builtin_amdgcn_s_barrier()
#define PG8_SCHED __builtin_amdgcn_sched_barrier(0)
    Unit cur, nxt; int ui = 0;
    if (!S.next(0, cur)) return;
    f32x4 acc[2][2][4][2];
#pragma unroll
    for (int a = 0; a < 2; ++a)
#pragma unroll
        for (int b = 0; b < 2; ++b)
#pragma unroll
            for (int m = 0; m < 4; ++m)
#pragma unroll
                for (int n = 0; n < 2; ++n) acc[a][b][m][n] = (f32x4){0.f, 0.f, 0.f, 0.f};
    bf16x8 At[4][2], B0[2][2], B1[2][2];
    const char* cA = (const char*)g.A + (size_t)cur.pm * tstepA + (size_t)cur.pn * g.a_pn_bytes; const char* cB = (const char*)g.Bt + (size_t)cur.pn * tstepB;
    PG8_STAGE(PG8_SB(0, 0), cB, voffB); PG8_STAGE(PG8_SB(0, 1), cB + hstepB, voffB); PG8_STAGE(PG8_SA(0, 0), cA, voffA); PG8_STAGE(PG8_SA(0, 1), cA + hstepA, voffA);
    if (wr == 1) PG8_BAR;
    PG8_WAIT_V(2); PG8_BAR;
    PG8_STAGE(PG8_SB(1, 0), cB + kstep, voffB); PG8_STAGE(PG8_SA(1, 0), cA + kstep, voffA); PG8_STAGE(PG8_SB(1, 1), cB + hstepB + kstep, voffB);
    PG8_WAIT_V(6); PG8_BAR;
    for (;;) {
        const bool has_next = S.next(ui + 1, nxt);
        const char* nA = has_next ? (const char*)g.A + (size_t)nxt.pm * tstepA + (size_t)nxt.pn * g.a_pn_bytes : cA; const char* nB = has_next ? (const char*)g.Bt + (size_t)nxt.pn * tstepB : cB;
#pragma unroll 1
        for (int t = 0; t < nt; t += 2) {
            const bool last = (t == nt - 2);
            if constexpr (Epi::HAS_MID) { if (t == g.midt) { E.mid(acc, cur, wr, wc, fr, fq); } PG8_SCHED; }
            const char* a1 = cA + (size_t)(t + 1) * kstep;
            const char* a2 = last ? nA : cA + (size_t)(t + 2) * kstep; const char* b2 = last ? nB : cB + (size_t)(t + 2) * kstep;
            const char* a3 = a2 + kstep; const char* b3 = b2 + kstep;
            PG8_LDB(B0, 0, 0); PG8_LDB(B1, 0, 1); PG8_SCHED; PG8_LDA(At, 0, 0); PG8_STAGE(PG8_SA(1, 1), a1 + hstepA, voffA);
            PG8_WAIT_V(8); PG8_WAIT_L(0); PG8_BAR; PG8_MMA(0, 0, At, B0); PG8_MMA(0, 1, At, B1); PG8_BAR; PG8_SCHED;
            PG8_LDA(At, 0, 1); PG8_STAGE(PG8_SB(0, 0), b2, voffB); PG8_STAGE(PG8_SB(0, 1), b2 + hstepB, voffB); PG8_STAGE(PG8_SA(0, 0), a2, voffA);
            PG8_WAIT_V(8); PG8_WAIT_L(0); PG8_BAR; PG8_MMA(1, 0, At, B0); PG8_MMA(1, 1, At, B1); PG8_BAR; PG8_SCHED;
            PG8_LDB(B0, 1, 0); PG8_LDB(B1, 1, 1); PG8_SCHED; PG8_LDA(At, 1, 0); PG8_STAGE(PG8_SA(0, 1), a2 + hstepA, voffA);
            PG8_WAIT_V(8); PG8_WAIT_L(0); PG8_BAR; PG8_MMA(0, 0, At, B0); PG8_MMA(0, 1, At, B1); PG8_BAR; PG8_SCHED;
            PG8_LDA(At, 1, 1); PG8_STAGE(PG8_SB(1, 0), b3, voffB); PG8_STAGE(PG8_SB(1, 1), b3 + hstepB, voffB); PG8_STAGE(PG8_SA(1, 0), a3, voffA);
            PG8_WAIT_V(8); PG8_WAIT_L(0); PG8_BAR; PG8_MMA(1, 0, At, B0); PG8_MMA(1, 1, At, B1); PG8_BAR; PG8_SCHED;
        }
        if (wr == 0) PG8_BAR;
        E(acc, cur, wr, wc, fr, fq);
        if (!has_next) break;
#pragma unroll
        for (int a = 0; a < 2; ++a)
#pragma unroll
            for (int b = 0; b < 2; ++b)
#pragma unroll
                for (int m = 0; m < 4; ++m)
#pragma unroll
                    for (int n = 0; n < 2; ++n) acc[a][b][m][n] = (f32x4){0.f, 0.f, 0.f, 0.f};
        cur = nxt; cA = nA; cB = nB; ++ui;
        if (wr == 1) PG8_BAR;
    }
    PG8_WAIT_V(0);
    PG8_BAR;
#undef PG8_SA
#undef PG8_SB
#undef PG8_STAGE
#undef PG8_LDA
#undef PG8_LDB
#undef PG8_MMA
#undef PG8_WAIT_V
#undef PG8_WAIT_L
#undef PG8_BAR
#undef PG8_SCHED
}

typedef f32x4 Acc[2][2][4][2];
__device__ __forceinline__ u32x4 pack8(const f32x4 v0, const f32x4 v1) { u32x4 w; w.x = cvt_pk_bf16(v0[0], v0[1]); w.y = cvt_pk_bf16(v0[2], v0[3]); w.z = cvt_pk_bf16(v1[0], v1[1]); w.w = cvt_pk_bf16(v1[2], v1[3]); return w; }

struct EpiZ {
    static constexpr bool HAS_MID = false;
    bf16_t* Z;
    __device__ __forceinline__ void operator()(Acc& acc, const Unit& u, int wr, int wc, int fr, int fq) const {
        int row0 = u.pm * BM + wr * 64 + fr; asm volatile("" : "+v"(row0)); const int col0 = u.pn * BM + wc * 32 + 8 * fq; const bool sig = u.pn >= 5;
#pragma unroll
        for (int ai = 0; ai < 2; ++ai)
#pragma unroll
            for (int m = 0; m < 4; ++m) { bf16_t* rowp = Z + (size_t)(row0 + ai * HALF + m * 16) * INW + col0;
#pragma unroll
                for (int bj = 0; bj < 2; ++bj) { f32x4 v0 = acc[ai][bj][m][0], v1 = acc[ai][bj][m][1];
                    if (sig) {
#pragma unroll
                        for (int e = 0; e < 4; ++e) { v0[e] = fsigmoid(v0[e]); v1[e] = fsigmoid(v1[e]); } }
                    *(u32x4*)(rowp + bj * HALF) = pack8(v0, v1); } }
    }
};
struct EpiBf {
    static constexpr bool HAS_MID = false;
    bf16_t* O; int ldc;
    __device__ __forceinline__ void operator()(Acc& acc, const Unit& u, int wr, int wc, int fr, int fq) const {
        int row0 = u.pm * BM + wr * 64 + fr; asm volatile("" : "+v"(row0)); const int col0 = u.pn * BM + wc * 32 + 8 * fq;
#pragma unroll
        for (int ai = 0; ai < 2; ++ai)
#pragma unroll
            for (int m = 0; m < 4; ++m) { bf16_t* rowp = O + (size_t)(row0 + ai * HALF + m * 16) * ldc + col0;
#pragma unroll
                for (int bj = 0; bj < 2; ++bj) *(u32x4*)(rowp + bj * HALF) = pack8(acc[ai][bj][m][0], acc[ai][bj][m][1]); }
    }
};
struct EpiMerge {
    static constexpr bool HAS_MID = true;
    const bf16_t* Z; bf16_t* O;
    __device__ __forceinline__ void mid(Acc& acc, const Unit& u, int wr, int wc, int fr, int fq) const {
        int row0 = u.pm * BM + wr * 64 + fr; asm volatile("" : "+v"(row0)); const int col0 = u.pn * BM + wc * 32 + 8 * fq;
#pragma unroll
        for (int ai = 0; ai < 2; ++ai)
#pragma unroll
            for (int m = 0; m < 4; ++m) { const bf16_t* zr = Z + (size_t)(row0 + ai * HALF + m * 16) * INW + col0;
#pragma unroll
                for (int bj = 0; bj < 2; ++bj) { const u32x4 a = *(const u32x4*)(zr + ZC_GA + bj * HALF), b = *(const u32x4*)(zr + ZC_GB + bj * HALF);
#pragma unroll
                    for (int e = 0; e < 4; ++e) { const float r0 = bflo(a[e]) * __builtin_amdgcn_rcpf(bflo(b[e])), r1 = bfhi(a[e]) * __builtin_amdgcn_rcpf(bfhi(b[e]));
                        acc[ai][bj][m][e >> 1][(e & 1) * 2] *= r0; acc[ai][bj][m][e >> 1][(e & 1) * 2 + 1] *= r1; } }
                asm volatile("" ::: "memory"); }
    }
    __device__ __forceinline__ void operator()(Acc& acc, const Unit& u, int wr, int wc, int fr, int fq) const {
        int row0 = u.pm * BM + wr * 64 + fr; asm volatile("" : "+v"(row0)); const int col0 = u.pn * BM + wc * 32 + 8 * fq;
#pragma unroll
        for (int ai = 0; ai < 2; ++ai)
#pragma unroll
            for (int m = 0; m < 4; ++m) { const size_t row = (size_t)(row0 + ai * HALF + m * 16); const bf16_t* zr = Z + row * INW + col0; bf16_t* rowp = O + row * D + col0;
#pragma unroll
                for (int bj = 0; bj < 2; ++bj) { const u32x4 b = *(const u32x4*)(zr + ZC_GB + bj * HALF); f32x4 v0 = acc[ai][bj][m][0], v1 = acc[ai][bj][m][1];
                    v0[0] *= bflo(b[0]); v0[1] *= bfhi(b[0]); v0[2] *= bflo(b[1]); v0[3] *= bfhi(b[1]); v1[0] *= bflo(b[2]); v1[1] *= bfhi(b[2]); v1[2] *= bflo(b[3]); v1[3] *= bfhi(b[3]);
                    *(u32x4*)(rowp + bj * HALF) = pack8(v0, v1); } }
    }
};
struct EpiX1 {
    static constexpr bool HAS_MID = false;
    const float* xp; const float* xs; float* out; bf16_t* X1B; float* sumsq;
    __device__ __forceinline__ void operator()(Acc& acc, const Unit& u, int wr, int wc, int fr, int fq) const {
        if (!u.last) return;
        int row0 = u.pm * BM + wr * 64 + fr; asm volatile("" : "+v"(row0)); const int col0 = u.pn * BM + wc * 32 + 8 * fq;
#pragma unroll
        for (int ai = 0; ai < 2; ++ai)
#pragma unroll
            for (int m = 0; m < 4; ++m) { const int row = row0 + ai * HALF + m * 16; const bool valid = row < MV;
                const float* xr = (row < MP ? xp + (size_t)row * D : xs + (size_t)(valid ? row - MP : 0) * D) + col0;
                float ss = 0.f;
#pragma unroll
                for (int bj = 0; bj < 2; ++bj) { f32x4 v0 = acc[ai][bj][m][0], v1 = acc[ai][bj][m][1];
                    if (valid) { v0 += *(const f32x4*)(xr + bj * HALF); v1 += *(const f32x4*)(xr + bj * HALF + 4); }
                    ss += (v0[0] * v0[0] + v0[1] * v0[1]) + (v0[2] * v0[2] + v0[3] * v0[3]) + (v1[0] * v1[0] + v1[1] * v1[1]) + (v1[2] * v1[2] + v1[3] * v1[3]);
                    *(u32x4*)(X1B + (size_t)row * D + col0 + bj * HALF) = pack8(v0, v1); }
                ss += __shfl_xor(ss, 16); ss += __shfl_xor(ss, 32);
                if (fq == 0) atomicAdd(sumsq + row, ss); }
    }
};
struct EpiAct {
    static constexpr bool HAS_MID = false;
    const float* sumsq; bf16_t* ACT;
    __device__ __forceinline__ void operator()(Acc& acc, const Unit& u, int wr, int wc, int fr, int fq) const {
        int row0 = u.pm * BM + wr * 64 + fr; asm volatile("" : "+v"(row0)); const int col0 = u.pn * HALF + wc * 32 + 8 * fq;
#pragma unroll
        for (int ai = 0; ai < 2; ++ai)
#pragma unroll
            for (int m = 0; m < 4; ++m) { const int row = row0 + ai * HALF + m * 16; const float rstd = __builtin_amdgcn_rsqf(sumsq[row] * (1.0f / D) + EPS);
                f32x4 o[2];
#pragma unroll
                for (int n = 0; n < 2; ++n)
#pragma unroll
                    for (int e = 0; e < 4; ++e) { const float gt = acc[ai][0][m][n][e] * rstd, up = acc[ai][1][m][n][e] * rstd; o[n][e] = gt * up * fsigmoid(gt); }
                *(u32x4*)(ACT + (size_t)row * FF + col0) = pack8(o[0], o[1]); }
    }
};
struct EpiY {
    static constexpr bool HAS_MID = false;
    const bf16_t* X1B; float* out;
    __device__ __forceinline__ void operator()(Acc& acc, const Unit& u, int wr, int wc, int fr, int fq) const {
        if (!u.last) return;
        int row0 = u.pm * BM + wr * 64 + fr; asm volatile("" : "+v"(row0)); const int col0 = u.pn * BM + wc * 32 + 8 * fq;
#pragma unroll
        for (int ai = 0; ai < 2; ++ai)
#pragma unroll
            for (int m = 0; m < 4; ++m) { const int row = row0 + ai * HALF + m * 16;
                if (row < MV) { float* orow = out + (size_t)row * D + col0; const bf16_t* xr = X1B + (size_t)row * D + col0;
#pragma unroll
                    for (int bj = 0; bj < 2; ++bj) { const u32x4 x = *(const u32x4*)(xr + bj * HALF);
                        *(f32x4*)(orow + bj * HALF) = (f32x4){bflo(x[0]), bfhi(x[0]), bflo(x[1]), bfhi(x[1])} + acc[ai][bj][m][0];
                        *(f32x4*)(orow + bj * HALF + 4) = (f32x4){bflo(x[2]), bfhi(x[2]), bflo(x[3]), bfhi(x[3])} + acc[ai][bj][m][1]; } } }
    }
};
}

struct SrcPlain { const float* W; int N; __device__ __forceinline__ float operator()(int k, int n) const { return W[(size_t)k * N + n]; } };
struct SrcMix { const float* mix; const float* scale;
    __device__ __forceinline__ float operator()(int k, int n) const { return mix[((size_t)(n >> 7) * 128 + k) * 128 + (n & 127)] * scale[n]; } };
struct SrcCat { const float* wp; const float* wa;
    __device__ __forceinline__ float operator()(int k, int n) const { return k < 512 ? wp[(size_t)k * D + n] : wa[(size_t)(k - 512) * D + n]; } };
struct SrcGU { const float* wg; const float* wu; const float* nrm;
    __device__ __forceinline__ float operator()(int k, int n) const { const int t = n >> 8, j = n & 255, col = 128 * t + (j & 127); const float* w = (const float*)((uintptr_t)wg + (uintptr_t)(j >> 7) * ((uintptr_t)wu - (uintptr_t)wg)); return w[(size_t)k * FF + col] * nrm[k]; } };

template <class Src>
__device__ __forceinline__ void transpose_item(const Src src, bf16_t* WT, int ldk, int nblk, int item, LAS float* scr, int lane) {
    const int kb = item / nblk, nb = item % nblk, k0 = 64 * kb, n0 = 32 * nb;
    float tv[32];
#pragma unroll
    for (int i = 0; i < 32; ++i) tv[i] = src(k0 + 2 * i + (lane >> 5), n0 + (lane & 31));
#pragma unroll
    for (int i = 0; i < 32; ++i) scr[(2 * i + (lane >> 5)) * 33 + (lane & 31)] = tv[i];
    LDS_WAIT();
    const int c = lane & 7;
#pragma unroll
    for (int j = 0; j < 4; ++j) { const int n = (lane >> 3) + 8 * j; const LAS float* s = scr + (8 * c) * 33 + n;
        u32x4 o; o.x = cvt_pk_bf16(s[0 * 33], s[1 * 33]); o.y = cvt_pk_bf16(s[2 * 33], s[3 * 33]); o.z = cvt_pk_bf16(s[4 * 33], s[5 * 33]); o.w = cvt_pk_bf16(s[6 * 33], s[7 * 33]);
        *(u32x4*)(WT + (size_t)(n0 + n) * ldk + k0 + 8 * c) = o; }
    LDS_WAIT();
}

struct Args { const float* in[19]; float* out; unsigned char* ws; int ph_lo, ph_hi; };

template <class Epi>
__device__ __forceinline__ void small_gemm(LAS unsigned char* lds, const bf16_t* A, int lda, const bf16_t* Bt, int ldb, int K, int vcu, int G, const Epi& E) {
    const int tid = threadIdx.x, lane = tid & 63, wave = __builtin_amdgcn_readfirstlane(tid >> 6), fr = lane & 15, fq = lane >> 4, rh = wave & 1, ks = wave >> 1;
    const int kq = K >> 2, nsteps = kq >> 5;
    for (int u = vcu; u < 256; u += G) {
        const int r0 = 32 * (u & 3) + 16 * rh, n0 = 16 * (u >> 2);
        const bf16_t* ap = A + (size_t)(r0 + fr) * lda + ks * kq + 8 * fq; const bf16_t* bp = Bt + (size_t)(n0 + fr) * ldb + ks * kq + 8 * fq;
        f32x4 acc = (f32x4){0.f, 0.f, 0.f, 0.f};
#pragma unroll 8
        for (int s = 0; s < nsteps; ++s) { const bf16x8 af = *(const bf16x8*)(ap + 32 * s), bf = *(const bf16x8*)(bp + 32 * s);
            acc = __builtin_amdgcn_mfma_f32_16x16x32_bf16(bf, af, acc, 0, 0, 0); }
        LAS f32x4* red = (LAS f32x4*)lds;
        red[(ks * 2 + rh) * 64 + lane] = acc;
        __syncthreads();
        if (ks == 0) { const f32x4 p0 = red[(0 * 2 + rh) * 64 + lane], p1 = red[(1 * 2 + rh) * 64 + lane], p2 = red[(2 * 2 + rh) * 64 + lane], p3 = red[(3 * 2 + rh) * 64 + lane];
            E(p0, p1, p2, p3, r0 + fr, n0 + 4 * fq, fq); }
        __syncthreads();
    }
}
struct SEpiMerge { const bf16_t* Z; bf16_t* O;
    __device__ __forceinline__ void operator()(f32x4 p0, f32x4 p1, f32x4 p2, f32x4 p3, int n, int c, int fq) const {
        const bf16_t* zr = Z + (size_t)(MP + n) * INW + c; const u32x2 a = *(const u32x2*)(zr + ZC_GA), b = *(const u32x2*)(zr + ZC_GB);
        const f32x4 pool = p0 + p1, attn = p2 + p3;
        u32x2 w; w.x = cvt_pk_bf16(bflo(a.x) * pool[0] + bflo(b.x) * attn[0], bfhi(a.x) * pool[1] + bfhi(b.x) * attn[1]);
        w.y = cvt_pk_bf16(bflo(a.y) * pool[2] + bflo(b.y) * attn[2], bfhi(a.y) * pool[3] + bfhi(b.y) * attn[3]);
        *(u32x2*)(O + (size_t)(MP + n) * D + c) = w; } };
struct SEpiX1 { const float* xs; float* out; bf16_t* X1B; float* sumsq;
    __device__ __forceinline__ void operator()(f32x4 p0, f32x4 p1, f32x4 p2, f32x4 p3, int n, int c, int fq) const {
        const f32x4 v = *(const f32x4*)(xs + (size_t)n * D + c) + ((p0 + p1) + (p2 + p3));
        u32x2 w; w.x = cvt_pk_bf16(v[0], v[1]); w.y = cvt_pk_bf16(v[2], v[3]); *(u32x2*)(X1B + (size_t)(MP + n) * D + c) = w;
        float ss = (v[0] * v[0] + v[1] * v[1]) + (v[2] * v[2] + v[3] * v[3]); ss += __shfl_xor(ss, 16); ss += __shfl_xor(ss, 32);
        if (fq == 0) atomicAdd(sumsq + MP + n, ss); } };
struct SEpiY { const bf16_t* X1B; float* out;
    __device__ __forceinline__ void operator()(f32x4 p0, f32x4 p1, f32x4 p2, f32x4 p3, int n, int c, int fq) const {
        const u32x2 x = *(const u32x2*)(X1B + (size_t)(MP + n) * D + c);
        *(f32x4*)(out + (size_t)(MP + n) * D + c) = (f32x4){bflo(x.x), bfhi(x.x), bflo(x.y), bfhi(x.y)} + ((p0 + p1) + (p2 + p3)); } };

__device__ __forceinline__ int crow(int r, int hi) { return (r & 3) + 8 * (r >> 2) + 4 * hi; }
constexpr int KS_STRIDE = 144, VT_STRIDE = 520, LDS_VT = 256 * KS_STRIDE  , LDS_SMP = 73728;

__device__ __forceinline__ void attn_prompt_unit(const Args& a, LAS unsigned char* lds, int unit) {
    const int tid = threadIdx.x, lane = tid & 63, wave = __builtin_amdgcn_readfirstlane(tid >> 6);
    const int kh = unit & 1, qb = (unit >> 1) & 15, b = unit >> 5;
    const bf16_t* Z = (const bf16_t*)(a.ws + WS_Z); bf16_t* YY = (bf16_t*)(a.ws + WS_RB);
    const float* qnw = a.in[7]; const float* knw = a.in[8]; const float* sinks = a.in[9];
    const size_t rowbase = (size_t)b * SEQ; const int key0 = (qb - 1) * 128;
    {
        const int j = tid >> 1, half = tid & 1, pos = key0 + j; float v[32];
        if (pos >= 0) { const u32x4* src = (const u32x4*)(Z + (rowbase + pos) * INW + ZC_K + kh * 64 + 32 * half);
#pragma unroll
            for (int c = 0; c < 4; ++c) { const u32x4 w = src[c];
#pragma unroll
                for (int e = 0; e < 4; ++e) { v[c * 8 + 2 * e] = bflo(w[e]); v[c * 8 + 2 * e + 1] = bfhi(w[e]); } } }
        else {
#pragma unroll
            for (int i = 0; i < 32; ++i) v[i] = 0.f; }
        float ss = 0.f;
#pragma unroll
        for (int i = 0; i < 32; ++i) ss += v[i] * v[i];
        ss += __shfl_xor(ss, 1);
        const float rstd = __builtin_amdgcn_rsqf(ss * (1.0f / 64) + EPS);
#pragma unroll
        for (int c = 0; c < 8; ++c) { const f32x4 w = *(const f32x4*)(knw + 32 * half + 4 * c);
#pragma unroll
            for (int e = 0; e < 4; ++e) v[4 * c + e] = v[4 * c + e] * rstd * w[e]; }
        LAS u32x4* dst = (LAS u32x4*)(lds + j * KS_STRIDE + 64 * half);
#pragma unroll
        for (int c = 0; c < 4; ++c) { u32x4 w;
#pragma unroll
            for (int e = 0; e < 4; ++e) w[e] = cvt_pk_bf16(v[c * 8 + 2 * e], v[c * 8 + 2 * e + 1]);
            dst[c] = w; }
        if (qb == 15 && j >= 128) { float* o = a.out + O_KP + ((size_t)(b * 128 + (j - 128)) * 2 + kh) * 64 + 32 * half;
#pragma unroll
            for (int c = 0; c < 8; ++c) *(f32x4*)(o + 4 * c) = (f32x4){v[4 * c], v[4 * c + 1], v[4 * c + 2], v[4 * c + 3]}; }
    }
#pragma unroll
    for (int i = 0; i < 4; ++i) { const int c = tid + 512 * i, key = c & 255, dch = c >> 8, pos = key0 + key;
        u32x4 w = (u32x4){0u, 0u, 0u, 0u};
        if (pos >= 0) w = *(const u32x4*)(Z + (rowbase + pos) * INW + ZC_V + kh * 64 + 8 * dch);
        LAS bf16_t* vt = (LAS bf16_t*)(lds + LDS_VT) + key;
#pragma unroll
        for (int e = 0; e < 4; ++e) { vt[(8 * dch + 2 * e) * (VT_STRIDE / 2)] = (bf16_t)(w[e] & 0xffffu); vt[(8 * dch + 2 * e + 1) * (VT_STRIDE / 2)] = (bf16_t)(w[e] >> 16); }
        if (qb == 15 && key >= 128) { float* o = a.out + O_VP + ((size_t)(b * 128 + (key - 128)) * 2 + kh) * 64 + 8 * dch;
            *(f32x4*)o = (f32x4){bflo(w[0]), bfhi(w[0]), bflo(w[1]), bfhi(w[1])}; *(f32x4*)(o + 4) = (f32x4){bflo(w[2]), bfhi(w[2]), bflo(w[3]), bfhi(w[3])}; } }
    __syncthreads();
    const int hq = 4 * kh + (wave >> 1), ql = lane & 31, h = lane >> 5;
    const float sink2 = sinks[hq] * LOG2E;
#pragma unroll 1
    for (int gi = 0; gi < 2; ++gi) {
        const int g = 2 * (wave & 1) + gi; const size_t qrow = rowbase + (size_t)qb * 128 + 32 * g + ql;
        bf16x8 qf[4];
        { float v[32]; const bf16_t* qp = Z + qrow * INW + ZC_Q + hq * 64 + 8 * h;
#pragma unroll
            for (int ds = 0; ds < 4; ++ds) { const u32x4 w = *(const u32x4*)(qp + 16 * ds);
#pragma unroll
                for (int e = 0; e < 4; ++e) { v[ds * 8 + 2 * e] = bflo(w[e]); v[ds * 8 + 2 * e + 1] = bfhi(w[e]); } }
            float ss = 0.f;
#pragma unroll
            for (int i = 0; i < 32; ++i) ss += v[i] * v[i];
            ss += __shfl_xor(ss, 32);
            const float sc = __builtin_amdgcn_rsqf(ss * (1.0f / 64) + EPS) * C2;
#pragma unroll
            for (int ds = 0; ds < 4; ++ds) { const f32x4 w0 = *(const f32x4*)(qnw + 16 * ds + 8 * h), w1 = *(const f32x4*)(qnw + 16 * ds + 8 * h + 4); u32x4 p;
                p.x = cvt_pk_bf16(v[ds * 8 + 0] * sc * w0[0], v[ds * 8 + 1] * sc * w0[1]); p.y = cvt_pk_bf16(v[ds * 8 + 2] * sc * w0[2], v[ds * 8 + 3] * sc * w0[3]);
                p.z = cvt_pk_bf16(v[ds * 8 + 4] * sc * w1[0], v[ds * 8 + 5] * sc * w1[1]); p.w = cvt_pk_bf16(v[ds * 8 + 6] * sc * w1[2], v[ds * 8 + 7] * sc * w1[3]);
                qf[ds] = __builtin_bit_cast(bf16x8, p); } }
        f32x16 sc[5];
#pragma unroll
        for (int i = 0; i < 5; ++i) { f32x16 acc = {};
#pragma unroll
            for (int ds = 0; ds < 4; ++ds) { const bf16x8 kf = *(const LAS bf16x8*)(lds + (32 * (g + i) + ql) * KS_STRIDE + 32 * ds + 16 * h);
                acc = __builtin_amdgcn_mfma_f32_32x32x16_bf16(kf, qf[ds], acc, 0, 0, 0); }
            sc[i] = acc; }
        const int qr = 32 * g + ql; float mx = -1e30f;
#pragma unroll
        for (int i = 0; i < 5; ++i)
#pragma unroll
            for (int r = 0; r < 16; ++r) { const int j = 32 * (g + i) + crow(r, h); const bool valid = (j >= qr) && (j <= qr + 128) && (qb > 0 || j >= 128);
                const float s = valid ? sc[i][r] : -1e30f; sc[i][r] = s; mx = fmaxf(mx, s); }
        mx = fmaxf(mx, __shfl_xor(mx, 32));
        const float mref = fmaxf(mx, sink2); float lsum = 0.f;
#pragma unroll
        for (int i = 0; i < 5; ++i)
#pragma unroll
            for (int r = 0; r < 16; ++r) { const float p = __builtin_amdgcn_exp2f(sc[i][r] - mref); sc[i][r] = p; lsum += p; }
        lsum += __shfl_xor(lsum, 32);
        const float inv = 1.0f / (lsum + __builtin_amdgcn_exp2f(sink2 - mref));
        f32x16 o[2]; o[0] = (f32x16){}; o[1] = (f32x16){};
#pragma unroll
        for (int i = 0; i < 5; ++i)
#pragma unroll
            for (int s2 = 0; s2 < 2; ++s2) { u32x4 pw;
#pragma unroll
                for (int e = 0; e < 4; ++e) pw[e] = cvt_pk_bf16(sc[i][8 * s2 + 2 * e], sc[i][8 * s2 + 2 * e + 1]);
                const bf16x8 pf = __builtin_bit_cast(bf16x8, pw);
#pragma unroll
                for (int dt = 0; dt < 2; ++dt) { const LAS unsigned char* vp = lds + LDS_VT + (32 * dt + ql) * VT_STRIDE + 2 * (32 * (g + i) + 16 * s2 + 4 * h);
                    const u32x2 lo = *(const LAS u32x2*)vp, hi2 = *(const LAS u32x2*)(vp + 16);
                    const u32x4 vw = (u32x4){lo.x, lo.y, hi2.x, hi2.y};
                    o[dt] = __builtin_amdgcn_mfma_f32_32x32x16_bf16(__builtin_bit_cast(bf16x8, vw), pf, o[dt], 0, 0, 0); } }
        bf16_t* yp = YY + qrow * D + 512 + hq * 64 + 4 * h;
#pragma unroll
        for (int dt = 0; dt < 2; ++dt)
#pragma unroll
            for (int rq = 0; rq < 4; ++rq) { u32x2 w; w.x = cvt_pk_bf16(o[dt][4 * rq] * inv, o[dt][4 * rq + 1] * inv); w.y = cvt_pk_bf16(o[dt][4 * rq + 2] * inv, o[dt][4 * rq + 3] * inv);
                *(u32x2*)(yp + 32 * dt + 8 * rq) = w; }
    }
    __syncthreads();
}

__device__ __forceinline__ void attn_sample_unit(const Args& a, LAS unsigned char* lds, int su) {
    const int tid = threadIdx.x, lane = tid & 63, wave = __builtin_amdgcn_readfirstlane(tid >> 6);
    const int n = su >> 1, kh = su & 1;
    const float* ck = a.in[2] + (size_t)n * 16384; const float* cv = a.in[3] + (size_t)n * 16384;
    if (wave < 4) {
        const int hq = 4 * kh + wave;
        const bf16_t* zrow = (const bf16_t*)(a.ws + WS_Z) + (size_t)(MP + n) * INW; bf16_t* YY = (bf16_t*)(a.ws + WS_RB);
        LAS float* qs = (LAS float*)(lds + LDS_SMP + wave * 1024); LAS float* ps = qs + 64;
        const float xq = bf1(zrow[ZC_Q + hq * 64 + lane]); const float ssq = wave_sum(xq * xq);
        const float qn = xq * __builtin_amdgcn_rsqf(ssq * (1.0f / 64) + EPS) * a.in[7][lane] * C2;
        const float xk = bf1(zrow[ZC_K + kh * 64 + lane]); const float ssk = wave_sum(xk * xk);
        const float kn = xk * __builtin_amdgcn_rsqf(ssk * (1.0f / 64) + EPS) * a.in[8][lane];
        const float vn = bf1(zrow[ZC_V + kh * 64 + lane]);
        const float s_new = wave_sum(qn * kn);
        if (wave == 0) { a.out[O_KS + (size_t)n * 16384 + (127 * 2 + kh) * 64 + lane] = kn; a.out[O_VS + (size_t)n * 16384 + (127 * 2 + kh) * 64 + lane] = vn; }
        qs[lane] = qn; LDS_WAIT();
        float s0 = 0.f, s1 = 0.f;
        { const f32x4* k0 = (const f32x4*)(ck + (size_t)(lane * 2 + kh) * 64); const f32x4* k1 = (const f32x4*)(ck + (size_t)((lane + 64) * 2 + kh) * 64);
#pragma unroll
            for (int c = 0; c < 16; ++c) { const f32x4 q4 = *(const LAS f32x4*)(qs + 4 * c), x0 = k0[c], x1 = k1[c];
                s0 += (q4[0] * x0[0] + q4[1] * x0[1]) + (q4[2] * x0[2] + q4[3] * x0[3]); s1 += (q4[0] * x1[0] + q4[1] * x1[1]) + (q4[2] * x1[2] + q4[3] * x1[3]); } }
        const float sink2 = a.in[9][hq] * LOG2E;
        const float mref = fmaxf(fmaxf(wave_max(fmaxf(s0, s1)), s_new), sink2);
        const float p0 = __builtin_amdgcn_exp2f(s0 - mref), p1 = __builtin_amdgcn_exp2f(s1 - mref), pn = __builtin_amdgcn_exp2f(s_new - mref);
        const float l = wave_sum(p0 + p1) + pn + __builtin_amdgcn_exp2f(sink2 - mref);
        ps[lane] = p0; ps[lane + 64] = p1; LDS_WAIT();
        const int kg = lane >> 4, dc = lane & 15;
        f32x4 o = (f32x4){0.f, 0.f, 0.f, 0.f};
#pragma unroll 16
        for (int j = 0; j < 32; ++j) { const int key = 4 * j + kg; const f32x4 v = *(const f32x4*)(cv + (size_t)(key * 2 + kh) * 64 + 4 * dc); o += v * ps[key]; }
#pragma unroll
        for (int e = 0; e < 4; ++e) { o[e] += __shfl_xor(o[e], 16); o[e] += __shfl_xor(o[e], 32); }
        if (kg == 0) { const f32x4 vn4 = (f32x4){bf1(zrow[ZC_V + kh * 64 + 4 * dc]), bf1(zrow[ZC_V + kh * 64 + 4 * dc + 1]), bf1(zrow[ZC_V + kh * 64 + 4 * dc + 2]), bf1(zrow[ZC_V + kh * 64 + 4 * dc + 3])};
            const float il = 1.0f / l; const f32x4 r = (o + vn4 * pn) * il;
            u32x2 w; w.x = cvt_pk_bf16(r[0], r[1]); w.y = cvt_pk_bf16(r[2], r[3]);
            *(u32x2*)(YY + (size_t)(MP + n) * D + 512 + hq * 64 + 4 * dc) = w; }
    } else {
        const int t4 = tid - 256; f32x4 tk[8], tv[8];
#pragma unroll
        for (int q = 0; q < 8; ++q) { const int i = t4 + 256 * q, row = i >> 4, c = i & 15; const size_t so = (size_t)((row + 1) * 2 + kh) * 64 + 4 * c;
            if (i < 127 * 16) { tk[q] = *(const f32x4*)(ck + so); tv[q] = *(const f32x4*)(cv + so); } }
#pragma unroll
        for (int q = 0; q < 8; ++q) { const int i = t4 + 256 * q, row = i >> 4, c = i & 15; const size_t dd = (size_t)(row * 2 + kh) * 64 + 4 * c;
            if (i < 127 * 16) { *(f32x4*)(a.out + O_KS + (size_t)n * 16384 + dd) = tk[q]; *(f32x4*)(a.out + O_VS + (size_t)n * 16384 + dd) = tv[q]; } }
    }
    __syncthreads();
}

constexpr int PL_STRIDE = 272;
template <int W>
__device__ __forceinline__ void pool_task(const Args& a, LAS unsigned char* wl, int blk, int g, int lane) {
    const bf16_t* Z = (const bf16_t*)(a.ws + WS_Z); bf16_t* YY = (bf16_t*)(a.ws + WS_RB); const bf16_t* WM = (const bf16_t*)(a.ws + WS_MIX);
    const int r0 = 32 * blk, row = lane & 31, h = lane >> 5;
    f32x16 acc[4];
#pragma unroll
    for (int nt = 0; nt < 4; ++nt) acc[nt] = (f32x16){};
    if (r0 < MP) {
        const int t0 = r0 & (SEQ - 1), b = r0 >> 11;
#pragma unroll
        for (int it = 0; it < 12; ++it) { const int rr = 4 * it + (lane >> 4);
            if (rr < 47) { u32x4 v = (u32x4){0u, 0u, 0u, 0u};
                if (t0 > 0 || rr >= 15) v = *(const u32x4*)(Z + (size_t)(r0 - 15 + rr) * INW + 128 * g + 8 * (lane & 15));
                *(LAS u32x4*)(wl + rr * PL_STRIDE + 16 * (lane & 15)) = v; } }
        LDS_WAIT();
        const int t = t0 + row; const float rc = 1.0f / (float)min(W, t + 1);
#pragma unroll 1
        for (int ks = 0; ks < 8; ++ks) {
            const LAS unsigned char* base = wl + (15 + row) * PL_STRIDE + (16 * ks + 8 * h) * 2;
            float s[8], u[8];
            { const u32x4 x = *(const LAS u32x4*)base;
#pragma unroll
                for (int e = 0; e < 4; ++e) { u[2 * e] = bflo(x[e]); u[2 * e + 1] = bfhi(x[e]); s[2 * e] = u[2 * e]; s[2 * e + 1] = u[2 * e + 1]; } }
#pragma unroll
            for (int i = 1; i < W; ++i) { const u32x4 x = *(const LAS u32x4*)(base - i * PL_STRIDE);
#pragma unroll
                for (int e = 0; e < 4; ++e) { s[2 * e] += bflo(x[e]); s[2 * e + 1] += bfhi(x[e]); } }
            u32x4 y;
#pragma unroll
            for (int e = 0; e < 4; ++e) y[e] = cvt_pk_bf16(s[2 * e] * rc - u[2 * e], s[2 * e + 1] * rc - u[2 * e + 1]);
            const bf16x8 af = __builtin_bit_cast(bf16x8, y);
            if (t >= SEQ - 15) { float* o = a.out + O_PP + ((size_t)b * 15 + (t - (SEQ - 15))) * PW + 128 * g + 16 * ks + 8 * h;
                *(f32x4*)o = (f32x4){u[0], u[1], u[2], u[3]}; *(f32x4*)(o + 4) = (f32x4){u[4], u[5], u[6], u[7]}; }
#pragma unroll
            for (int nt = 0; nt < 4; ++nt) { const bf16x8 bfr = *(const bf16x8*)(WM + (size_t)(128 * g + 32 * nt + row) * 128 + 16 * ks + 8 * h);
                acc[nt] = __builtin_amdgcn_mfma_f32_32x32x16_bf16(af, bfr, acc[nt], 0, 0, 0); }
        }
    } else {
        const int n = r0 - MP + row; const float* st = a.in[4] + (size_t)n * 15 * PW; float* po = a.out + O_PS + (size_t)n * 15 * PW; const float rc = 1.0f / (float)W;
#pragma unroll 1
        for (int ks = 0; ks < 8; ++ks) {
            const int c0 = 128 * g + 16 * ks + 8 * h;
            float s[8], u[8];
            { const u32x4 x = *(const u32x4*)(Z + (size_t)(MP + n) * INW + c0);
#pragma unroll
                for (int e = 0; e < 4; ++e) { u[2 * e] = bflo(x[e]); u[2 * e + 1] = bfhi(x[e]); s[2 * e] = u[2 * e]; s[2 * e + 1] = u[2 * e + 1]; } }
#pragma unroll
            for (int i = 1; i < W; ++i) { const f32x4 x0 = *(const f32x4*)(st + (size_t)(15 - i) * PW + c0), x1 = *(const f32x4*)(st + (size_t)(15 - i) * PW + c0 + 4);
#pragma unroll
                for (int e = 0; e < 4; ++e) { s[e] += x0[e]; s[4 + e] += x1[e]; } }
            *(f32x4*)(po + 14 * PW + c0) = (f32x4){u[0], u[1], u[2], u[3]}; *(f32x4*)(po + 14 * PW + c0 + 4) = (f32x4){u[4], u[5], u[6], u[7]};
            u32x4 y;
#pragma unroll
            for (int e = 0; e < 4; ++e) y[e] = cvt_pk_bf16(s[2 * e] * rc - u[2 * e], s[2 * e + 1] * rc - u[2 * e + 1]);
            const bf16x8 af = __builtin_bit_cast(bf16x8, y);
#pragma unroll
            for (int nt = 0; nt < 4; ++nt) { const bf16x8 bfr = *(const bf16x8*)(WM + (size_t)(128 * g + 32 * nt + row) * 128 + 16 * ks + 8 * h);
                acc[nt] = __builtin_amdgcn_mfma_f32_32x32x16_bf16(af, bfr, acc[nt], 0, 0, 0); }
        }
    }
#pragma unroll
    for (int nt = 0; nt < 4; ++nt)
#pragma unroll
        for (int r = 0; r < 16; ++r) YY[(size_t)(r0 + crow(r, h)) * D + 128 * g + 32 * nt + row] = (bf16_t)(cvt_pk_bf16(acc[nt][r], 0.f) & 0xffffu);
    LDS_WAIT();
}
__device__ __forceinline__ void pool_tasks(const Args& a, LAS unsigned char* lds, int gw, int ngw) {
    const int lane = threadIdx.x & 63, wave = __builtin_amdgcn_readfirstlane(threadIdx.x >> 6);
    LAS unsigned char* wl = lds + wave * 16384;
    constexpr int NT = (MV / 32) * 4, NSB = (NS / 32) * 4;
    for (int p = 0; p * ngw < NT; ++p) {
        const int wt = ((gw + p * (ngw >> 1)) % ngw) + p * ngw;
        if (wt >= NT) continue;
        const int w2 = wt < NSB ? (MP / 32) * 4 + wt : wt - NSB;
        const int blk = w2 >> 2, g = w2 & 3;
        if (g == 0) pool_task<2>(a, wl, blk, 0, lane); else if (g == 1) pool_task<4>(a, wl, blk, 1, lane); else if (g == 2) pool_task<8>(a, wl, blk, 2, lane); else pool_task<16>(a, wl, blk, 3, lane);
    }
}
__device__ __forceinline__ void state_roll(const Args& a, int gtid, int gthreads) {
    const f32x4* src = (const f32x4*)a.in[4]; f32x4* dst = (f32x4*)(a.out + O_PS);
    for (int i0 = gtid; i0 < NS * 1792; i0 += 2 * gthreads) { const int i1 = i0 + gthreads; const bool two = i1 < NS * 1792;
        const int n0 = i0 / 1792, j0 = i0 - n0 * 1792, n1 = two ? i1 / 1792 : 0, j1 = two ? i1 - n1 * 1792 : 0;
        const f32x4 v0 = src[(size_t)n0 * 1920 + 128 + j0], v1 = src[(size_t)n1 * 1920 + 128 + j1];
        dst[(size_t)n0 * 1920 + j0] = v0; if (two) dst[(size_t)n1 * 1920 + j1] = v1; }
}

#define XB_TMO      128
#define XB_XCNT(j)  (256  + 64 * (j))
#define XB_XSUB(j)  (1280 + 64 * (j))
#define XB_XGEN(j)  (2304 + 64 * (j))
#define XB_TOP      3328
#define XB_TOPGEN   3392
#define XCD_BAR_WORDS 3456
#define XB_SPIN_CAP (1u << 18)
__device__ __forceinline__ unsigned xb_ld(unsigned* p)              { return __hip_atomic_load(p, __ATOMIC_RELAXED, __HIP_MEMORY_SCOPE_AGENT); }
__device__ __forceinline__ unsigned xb_add(unsigned* p, unsigned v) { return __hip_atomic_fetch_add(p, v, __ATOMIC_RELAXED, __HIP_MEMORY_SCOPE_AGENT); }
__device__ __forceinline__ unsigned xb_xcc_id() { return (unsigned)__builtin_amdgcn_s_getreg((3 << 11) | 20) & 0xFu; }
#define XB_SPIN(cond, bar) do { unsigned _sp = 0; while (cond) { __builtin_amdgcn_s_sleep(1); \
    if ((++_sp & 255u) == 0u) { if (xb_ld(&(bar)[XB_TMO])) break; if (_sp > XB_SPIN_CAP) { atomicAdd(&(bar)[XB_TMO], 1u); break; } } } } while (0)
struct XcdBarrier { unsigned* bar; unsigned x; volatile LAS unsigned* st; };
__device__ __forceinline__ XcdBarrier xcd_barrier_post(unsigned* bar, volatile LAS unsigned* st) {
    XcdBarrier b; b.bar = bar; b.x = xb_xcc_id(); b.st = st;
    if (threadIdx.x == 0) (void)xb_add(&bar[XB_XCNT(b.x)], 1u);
    return b;
}
__device__ __forceinline__ void xcd_barrier_complete(unsigned* bar, unsigned x, unsigned& nloc, unsigned& nx) {
    const unsigned G = gridDim.x * gridDim.y * gridDim.z;
    unsigned sum, cnt, mine, sp = 0u;
    for (;;) {
        sum = 0u; cnt = 0u; mine = 0u;
#pragma unroll
        for (unsigned j = 0; j < 16; ++j) { const unsigned c = xb_ld(&bar[XB_XCNT(j)]); sum += c; cnt += (c > 0u) ? 1u : 0u; mine = (j == x) ? c : mine; }
        if (sum == G) break;
        __builtin_amdgcn_s_sleep(1);
        if ((++sp & 255u) == 0u) { if (xb_ld(&bar[XB_TMO])) break; if (sp > XB_SPIN_CAP) { atomicAdd(&bar[XB_TMO], 1u); break; } }
    }
    nloc = mine > 0u ? mine : 1u; nx = cnt > 0u ? cnt : 1u;
}
__device__ __forceinline__ void xcd_barrier(const XcdBarrier& b) {
    asm volatile("s_waitcnt vmcnt(0)" ::: "memory");
    __syncthreads();
    if (threadIdx.x == 0) {
        unsigned* bar = b.bar;
        __builtin_amdgcn_s_waitcnt(0);
        unsigned nloc = b.st[0], nx = b.st[1];
        if (nloc == 0u) { xcd_barrier_complete(bar, b.x, nloc, nx); b.st[0] = nloc; b.st[1] = nx; }
        const unsigned old = xb_add(&bar[XB_XSUB(b.x)], 1u);
        const unsigned gen = old / nloc;
        if (old + 1u == (gen + 1u) * nloc) {
            __builtin_amdgcn_fence(__ATOMIC_RELEASE, "agent");
            asm volatile("s_waitcnt vmcnt(0)" ::: "memory");
            const unsigned og = xb_add(&bar[XB_TOP], 1u);
            const unsigned tg = og / nx;
            if (og + 1u == (tg + 1u) * nx) xb_add(&bar[XB_TOPGEN], 1u);
            else XB_SPIN(xb_ld(&bar[XB_TOPGEN]) == tg, bar);
            __builtin_amdgcn_fence(__ATOMIC_ACQUIRE, "agent");
            xb_add(&bar[XB_XGEN(b.x)], 1u);
            asm volatile("s_waitcnt vmcnt(0)" ::: "memory");
        } else {
            XB_SPIN(xb_ld(&bar[XB_XGEN(b.x)]) == gen, bar);
            __builtin_amdgcn_fence(__ATOMIC_ACQUIRE, "agent");
            asm volatile("s_waitcnt vmcnt(0)" ::: "memory");
        }
    }
    __syncthreads();
}

__global__ void __launch_bounds__(512, 2) fwd_megakernel(Args a) {
    extern __shared__ __attribute__((aligned(16))) unsigned char lds_raw[];
    LAS unsigned char* lds = (LAS unsigned char*)lds_raw;
    cg::grid_group grid = cg::this_grid();
    const int tid = threadIdx.x, lane = tid & 63, wave = __builtin_amdgcn_readfirstlane(tid >> 6);
    const int G = gridDim.x, bx = blockIdx.x;
    const int vcu = (G % 8 == 0) ? (bx % 8) * (G / 8) + bx / 8 : bx;
    unsigned char* ws = a.ws;
    bf16_t* WIN = (bf16_t*)(ws + WS_WIN); bf16_t* WMIX = (bf16_t*)(ws + WS_MIX); bf16_t* WCAT = (bf16_t*)(ws + WS_WCAT); bf16_t* WOUT = (bf16_t*)(ws + WS_WOUT);
    bf16_t* WGU = (bf16_t*)(ws + WS_WGU); bf16_t* WDN = (bf16_t*)(ws + WS_WDN);
    bf16_t* RA = (bf16_t*)(ws + WS_RA); bf16_t* RB = (bf16_t*)(ws + WS_RB); bf16_t* Z = (bf16_t*)(ws + WS_Z);
    float* SUMSQ = (float*)(ws + WS_SUMSQ);
    const int lo = a.ph_lo, hi = a.ph_hi;
    if (tid < 2) ((volatile LAS unsigned*)(lds + LDS_MISC))[tid] = 0u;
    __syncthreads();
    XcdBarrier xbar = xcd_barrier_post((unsigned*)(ws + WS_BAR), (volatile LAS unsigned*)(lds + LDS_MISC));
    if (hi < 0) grid.sync();
#ifndef PH_MASK
#define PH_MASK 255
#endif
#define IN(k) (((PH_MASK >> (k)) & 1) && lo <= (k) && (k) < hi)
#ifndef DUP_MASK
#define DUP_MASK 0
#endif
#ifndef SMALL_REP
#define SMALL_REP 0
#endif
#ifndef EXTRA_SYNCS
#define EXTRA_SYNCS 0
#endif
#define REP(k) for (int rep_ = 0; rep_ < 1 + ((DUP_MASK >> (k)) & 1); ++rep_)
#define LASTREP(k) (rep_ == ((DUP_MASK >> (k)) & 1))
#define SEAM(k) do { if (IN(k) && IN((k) + 1)) { xcd_barrier(xbar); for (int xs_ = 0; xs_ < EXTRA_SYNCS; ++xs_) xcd_barrier(xbar); } } while (0)

    if (IN(0)) REP(0) {
        LAS float* scr = (LAS float*)(lds + wave * 16384);
        const int gw = vcu * 8 + wave, NGW = G * 8;
        constexpr int I_IN = 16 * 104, I_MIX = 2 * 16;
        for (int it = gw; it < I_IN + I_MIX; it += NGW) {
            if (it < I_IN) transpose_item(SrcPlain{a.in[6], INW}, WIN, D, 104, it, scr, lane);
            else transpose_item(SrcMix{a.in[10], a.in[11]}, WMIX, 128, 16, it - I_IN, scr, lane);
        }
        const float* g1 = a.in[5];
        for (int m0 = gw; m0 < MPAD; m0 += 2 * NGW) {
            f32x4 v[2][4];
#pragma unroll
            for (int q = 0; q < 2; ++q) { const int m = m0 + q * NGW;
                if (m < MV) { const f32x4* xr = (const f32x4*)(m < MP ? a.in[0] + (size_t)m * D : a.in[1] + (size_t)(m - MP) * D) + lane;
#pragma unroll
                    for (int j = 0; j < 4; ++j) v[q][j] = xr[64 * j]; }
                else {
#pragma unroll
                    for (int j = 0; j < 4; ++j) v[q][j] = (f32x4){0.f, 0.f, 0.f, 0.f}; } }
#pragma unroll
            for (int q = 0; q < 2; ++q) { const int m = m0 + q * NGW;
                if (m < MPAD) { float sq = 0.f;
#pragma unroll
                    for (int j = 0; j < 4; ++j) sq += (v[q][j].x * v[q][j].x + v[q][j].y * v[q][j].y) + (v[q][j].z * v[q][j].z + v[q][j].w * v[q][j].w);
                    const float rstd = __builtin_amdgcn_rsqf(wave_sum(sq) * (1.f / D) + EPS);
                    unsigned long long* o8 = (unsigned long long*)(RA + (size_t)m * D) + lane;
#pragma unroll
                    for (int j = 0; j < 4; ++j) { const f32x4 gg = ((const f32x4*)g1)[lane + 64 * j];
                        o8[64 * j] = (unsigned long long)cvt_pk_bf16(v[q][j].x * rstd * gg.x, v[q][j].y * rstd * gg.y) | ((unsigned long long)cvt_pk_bf16(v[q][j].z * rstd * gg.z, v[q][j].w * rstd * gg.w) << 32); }
                    if (m >= MV) { unsigned long long* y8 = (unsigned long long*)(RB + (size_t)m * D) + lane;
#pragma unroll
                        for (int j = 0; j < 4; ++j) y8[64 * j] = 0ull; } } }
        }
        for (int i = vcu * 512 + tid; i < MPAD; i += G * 512) SUMSQ[i] = 0.f;
    }
    SEAM(0);
    if (IN(1)) {
        pg8::Gemm g{RA, WIN, D, D, D, 0, -1}; pg8::StaticOrder S; S.init(MPAD, INW, G, bx, 1 + ((DUP_MASK >> 1) & 1));
        pg8::gemm_phase(lds, g, S, pg8::EpiZ{Z});
        { const int maxper = (S.nwg + G - 1) / G, rem = S.nwg - (maxper - 1) * G; const bool all = rem >= G; const int nid = all ? G : G - rem, rk = all ? bx : bx - rem;
            if (rk >= 0) { LAS float* scr = (LAS float*)(lds + wave * 16384);
                constexpr int I_CAT = 16 * 32, I_OUT = 16 * 32, I_GU = 16 * 176, I_DN = 44 * 32;
                for (int it = rk * 8 + wave; it < I_CAT + I_OUT + I_GU + I_DN; it += nid * 8) {
                    int r = it;
                    if (r < I_CAT) { transpose_item(SrcCat{a.in[12], a.in[13]}, WCAT, D, 32, r, scr, lane); continue; } r -= I_CAT;
                    if (r < I_OUT) { transpose_item(SrcPlain{a.in[14], D}, WOUT, D, 32, r, scr, lane); continue; } r -= I_OUT;
                    if (r < I_GU) { transpose_item(SrcGU{a.in[16], a.in[17], a.in[15]}, WGU, D, 176, r, scr, lane); continue; } r -= I_GU;
                    transpose_item(SrcPlain{a.in[18], D}, WDN, FF, 32, r, scr, lane);
                } } }
    }
    SEAM(1);
    if (IN(2)) REP(2) {
        state_roll(a, vcu * 512 + tid, G * 512);
        for (int u = vcu; u < 256; u += G) attn_prompt_unit(a, lds, u);
        for (int su = vcu; su < 2 * NS; su += G) attn_sample_unit(a, lds, su);
        pool_tasks(a, lds, vcu * 8 + wave, G * 8);
    }
    SEAM(2);
    if (IN(4)) {
        pg8::Gemm g{RB, WCAT, D, D, D, 0, 8}; pg8::StaticOrder S; S.init(MP, D, G, bx, 1 + ((DUP_MASK >> 4) & 1));
        pg8::gemm_phase(lds, g, S, pg8::EpiMerge{Z, RA});

        for (int sr_ = 0; sr_ < 1 + SMALL_REP; ++sr_) small_gemm(lds, RB + (size_t)MP * D, D, WCAT, D, D, vcu, G, SEpiMerge{Z, RA});    }
    SEAM(4);
    if (IN(5)) {
        pg8::Gemm g{RA, WOUT, D, D, D, 0, -1}; pg8::StaticOrder S; S.init(MP, D, G, bx, 1 + ((DUP_MASK >> 5) & 1));
        pg8::gemm_phase(lds, g, S, pg8::EpiX1{a.in[0], a.in[1], a.out + O_Y, RB, SUMSQ});

        small_gemm(lds, RA + (size_t)MP * D, D, WOUT, D, D, vcu, G, SEpiX1{a.in[1], a.out + O_Y, RB, SUMSQ});    }
    SEAM(5);
    if (IN(6)) {
        pg8::Gemm g{RB, WGU, D, D, D, 0, -1}; pg8::StaticOrder S; S.init(MPAD, 2 * FF, G, bx, 1 + ((DUP_MASK >> 6) & 1));
        pg8::gemm_phase(lds, g, S, pg8::EpiAct{SUMSQ, Z});
    }
    SEAM(6);
    if (IN(7)) {
        pg8::Gemm g{Z, WDN, FF, FF, FF, 0, -1}; pg8::StaticOrder S; S.init(MP, D, G, bx, 1 + ((DUP_MASK >> 7) & 1));
        pg8::gemm_phase(lds, g, S, pg8::EpiY{RB, a.out + O_Y});

        small_gemm(lds, Z + (size_t)MP * FF, FF, WDN, FF, FF, vcu, G, SEpiY{RB, a.out + O_Y});    }
#undef IN
#undef SEAM
}

#ifndef MK_N_LAUNCHES
#define MK_N_LAUNCHES 1
#endif
extern "C" void kernel_launch(void* const* d_in, const int* in_sizes, int n_in, void* d_out, int out_size, void* d_ws, size_t ws_size, hipStream_t stream) {
    static int grid = 0;
    if (grid == 0) {
        int dev = 0, cus = 0, per_cu = 0;
        if (n_in != 19 || ws_size < WS_END) { fprintf(stderr, "kernel_launch: unexpected inputs (n_in %d, ws %zu)\n", n_in, ws_size); grid = -1; return; }
        hipGetDevice(&dev); hipDeviceGetAttribute(&cus, hipDeviceAttributeMultiprocessorCount, dev);
        if (hipFuncSetAttribute((const void*)fwd_megakernel, hipFuncAttributeMaxDynamicSharedMemorySize, LDS_BYTES) != hipSuccess) { fprintf(stderr, "kernel_launch: hipFuncSetAttribute failed\n"); grid = -1; return; }
        if (hipOccupancyMaxActiveBlocksPerMultiprocessor(&per_cu, (const void*)fwd_megakernel, 512, LDS_BYTES) != hipSuccess || per_cu < 1) { fprintf(stderr, "kernel_launch: occupancy query says %d\n", per_cu); per_cu = 1; }
        (void)hipGetLastError();
        grid = cus * 1;
        if (per_cu < 1) grid = -1;
    }
    if (grid < 0) return;
    if (hipMemsetAsync((char*)d_ws + WS_BAR, 0, WS_BAR_BYTES, stream) != hipSuccess) { fprintf(stderr, "kernel_launch: memset failed\n"); return; }
    Args a{};
    for (int i = 0; i < 19; ++i) a.in[i] = (const float*)d_in[i];
    a.out = (float*)d_out; a.ws = (unsigned char*)d_ws;
#if MK_N_LAUNCHES == 1
    a.ph_lo = 0; a.ph_hi = 8;
    void* args[] = {&a};
    hipError_t e = hipLaunchCooperativeKernel((const void*)fwd_megakernel, dim3(grid), dim3(512), args, LDS_BYTES, stream);
    if (e != hipSuccess) fprintf(stderr, "cooperative launch failed: %s (grid %d)\n", hipGetErrorString(e), grid);
#else
    for (int p = 0; p < 8; ++p) { a.ph_lo = p; a.ph_hi = p + 1; hipLaunchKernelGGL(fwd_megakernel, dim3(grid), dim3(512), LDS_BYTES, stream, a); }
#endif
}
```

```cpp
#include <hip/hip_runtime.h>
#include <hip/hip_cooperative_groups.h>
#include <cstdio>
#include <cstdint>
namespace cg = cooperative_groups;

#define LAS __attribute__((address_space(3)))
#ifndef AMP_PHASE
#define AMP_PHASE -1
#endif
typedef unsigned short bf16_t;
typedef short bf16x8 __attribute__((ext_vector_type(8)));
typedef short s16x4 __attribute__((ext_vector_type(4)));
typedef float f32x4 __attribute__((ext_vector_type(4)));
typedef float f32x16 __attribute__((ext_vector_type(16)));
typedef unsigned u32x4 __attribute__((ext_vector_type(4)));
typedef unsigned u32x2 __attribute__((ext_vector_type(2)));

constexpr int D = 1024, SEQ = 2048, NB = 8, MP = NB * SEQ, NS = 128, MV = MP + NS, MPAD = 16640;
constexpr int INW = 3328, FF = 2816, PW = 512;
constexpr int ZC_Q = 512, ZC_K = 1024, ZC_V = 1152, ZC_GA = 1280, ZC_GB = 2304;
constexpr float EPS = 1e-6f;
constexpr float LOG2E = 1.4426950408889634f;
constexpr float C2 = 0.125f * LOG2E;
constexpr size_t O_Y = 0, O_KP = 16908288, O_VP = 17039360, O_PP = 17170432, O_KS = 17231872, O_VS = 19329024, O_PS = 21426176;
constexpr size_t MiB = 1u << 20;
constexpr size_t WS_SUMSQ = 0;
constexpr size_t WS_SPOOL = 1 * MiB + 65536;
constexpr size_t WS_BAR = 1 * MiB, WS_BAR_BYTES = 16384;
constexpr size_t WS_WIN = 2 * MiB, WS_MIX = 9 * MiB, WS_WCAT = 10 * MiB, WS_WOUT = 12 * MiB, WS_WGU = 14 * MiB, WS_WDN = 25 * MiB;
constexpr size_t WS_RA = 32 * MiB;
constexpr size_t WS_RB = 65 * MiB;
constexpr size_t WS_YPRE = 98 * MiB;
constexpr size_t WS_Z = 115 * MiB;
constexpr size_t WS_END = 222 * MiB;
constexpr int LDS_BYTES = 147456;
constexpr int LDS_MISC = 135168;

__device__ __forceinline__ unsigned cvt_pk_bf16(float lo, float hi) { unsigned r; asm("v_cvt_pk_bf16_f32 %0, %1, %2" : "=v"(r) : "v"(lo), "v"(hi)); return r; }
__device__ __forceinline__ float bflo(unsigned u) { return __uint_as_float(u << 16); }
__device__ __forceinline__ float bfhi(unsigned u) { return __uint_as_float(u & 0xffff0000u); }
__device__ __forceinline__ float bf1(bf16_t u) { return __uint_as_float(((unsigned)u) << 16); }
__device__ __forceinline__ float fsigmoid(float x) { return __builtin_amdgcn_rcpf(1.0f + __builtin_amdgcn_exp2f(-x * LOG2E)); }
__device__ __forceinline__ float wave_sum(float v) {
#pragma unroll
    for (int o = 1; o < 64; o <<= 1) v += __shfl_xor(v, o);
    return v;
}
__device__ __forceinline__ float wave_max(float v) {
#pragma unroll
    for (int o = 1; o < 64; o <<= 1) v = fmaxf(v, __shfl_xor(v, o));
    return v;
}
#define LDS_WAIT() asm volatile("s_waitcnt lgkmcnt(0)" ::: "memory")

namespace pg8 {
constexpr int BM = 256, BK = 64, HALF = 128, HTB = HALF * BK * 2, STAGE_BYTES = 8 * HTB, NXCD = 8, WGM = 8;
__host__ __device__ __forceinline__ int lds_byte(int r, int c) { const int st = (r >> 4) * 2 + (c >> 5), rr = r & 15, cc = c & 31, ob = rr * 64 + cc * 2; return st * 1024 + (ob ^ (((ob >> 9) & 1) << 5)); }
__host__ __device__ __forceinline__ void stage_rc(int b, int& R, int& C) { const int st = b / 1024, sb = b % 1024, swz = sb ^ (((sb >> 9) & 1) << 5); R = (st >> 1) * 16 + swz / 64; C = (st & 1) * 32 + (swz % 64) / 2; }
__host__ __device__ __forceinline__ int perm32(int rho) { const int n = rho >> 4, i = rho & 15; return 8 * (i >> 2) + 4 * n + (i & 3); }

struct Unit { int pm, pn, last; };
struct Gemm { const bf16_t* A; const bf16_t* Bt; int lda, ldb, K, a_pn_bytes, midt; };

struct StaticOrder {
    int nM, nN, nwg, G, c, per, reps;
    __device__ void init(int M, int N, int G_, int c_, int reps_ = 1) { nM = M / BM; nN = N / BM; nwg = nM * nN; G = G_; c = c_; per = c < nwg ? (nwg - c + G - 1) / G : 0; reps = reps_; }
    __device__ bool next(int i, Unit& u) const {
        if (i >= per * reps) return false;
        const int pass = i / per; u.last = (pass == reps - 1);
        const long L = (long)(i - pass * per) * G + c;
        int wgid = (int)L; { const int q = nwg / NXCD, r = nwg % NXCD, xcd = wgid % NXCD, off = wgid / NXCD; wgid = (xcd < r ? xcd * (q + 1) : r * (q + 1) + (xcd - r) * q) + off; }
        const int nig = WGM * nN, gid = wgid / nig, fm = gid * WGM, gsz = (nM - fm) < WGM ? (nM - fm) : WGM;
        u.pm = fm + ((wgid % nig) % gsz); u.pn = (wgid % nig) / gsz; return true;
    }
};

template <class Epi>
__device__ __forceinline__ void gemm_phase(LAS unsigned char* lds, const Gemm g, const StaticOrder& S, const Epi& E) {
    const int tid = threadIdx.x, wid = __builtin_amdgcn_readfirstlane(tid >> 6), lane = tid & 63, wr = wid >> 2, wc = wid & 3, fr = lane & 15, fq = lane >> 4;
    const int K = g.K, nt = K / BK;
    unsigned voffA[2], voffB[2];
#pragma unroll
    for (int i = 0; i < 2; ++i) { int R, C; stage_rc(tid * 16 + i * 8192, R, C); const int Rb = (R & ~31) + perm32(R & 31);
        voffA[i] = (unsigned)(R * g.lda + C) * 2u; voffB[i] = (unsigned)(Rb * g.ldb + C) * 2u; }
    const size_t kstep = (size_t)(BK * 2);
    const size_t hstepA = (size_t)HALF * g.lda * 2, hstepB = (size_t)HALF * g.ldb * 2;
    const size_t tstepA = 2 * hstepA, tstepB = 2 * hstepB;
    const unsigned ldsw = (unsigned)wid * 1024u;
    const int aoff = lds_byte(wr * 64 + fr, fq * 8), boff = lds_byte(wc * 32 + fr, fq * 8);
#define PG8_SA(b, h) (((b) * 2 + (h)) * HTB)
#define PG8_SB(b, h) ((4 + (b) * 2 + (h)) * HTB)
#define PG8_STAGE(bufoff, gbase, voff) do { _Pragma("unroll") for (int _i = 0; _i < 2; ++_i) \
        __builtin_amdgcn_global_load_lds((const unsigned*)((const char*)(gbase) + (voff)[_i]), (LAS unsigned*)(lds + (bufoff) + ldsw + _i * 8192), 16, 0, 0); } while (0)
#define PG8_LDA(dst, b, h) do { _Pragma("unroll") for (int m = 0; m < 4; ++m) _Pragma("unroll") for (int k = 0; k < 2; ++k) dst[m][k] = *(const LAS bf16x8*)(lds + PG8_SA(b, h) + aoff + m * 2048 + k * 1024); } while (0)
#define PG8_LDB(dst, b, h) do { _Pragma("unroll") for (int n = 0; n < 2; ++n) _Pragma("unroll") for (int k = 0; k < 2; ++k) dst[n][k] = *(const LAS bf16x8*)(lds + PG8_SB(b, h) + boff + n * 2048 + k * 1024); } while (0)
#define PG8_MMA(ai, bj, At, Bt) do { __builtin_amdgcn_s_setprio(1); _Pragma("unroll") for (int m = 0; m < 4; ++m) _Pragma("unroll") for (int n = 0; n < 2; ++n) _Pragma("unroll") for (int k = 0; k < 2; ++k) \
        acc[ai][bj][m][n] = __builtin_amdgcn_mfma_f32_16x16x32_bf16(Bt[n][k], At[m][k], acc[ai][bj][m][n], 0, 0, 0); __builtin_amdgcn_s_setprio(0); } while (0)
#define PG8_WAIT_V(n) asm volatile("s_waitcnt vmcnt(" #n ")" ::: "memory")
#define PG8_WAIT_L(n) asm volatile("s_waitcnt lgkmcnt(" #n ")" ::: "memory")
#define PG8_BAR __builtin_amdgcn_s_barrier()
#define PG8_SCHED __builtin_amdgcn_sched_barrier(0)
    Unit cur, nxt; int ui = 0;
    if (!S.next(0, cur)) return;
    f32x4 acc[2][2][4][2];
#pragma unroll
    for (int a = 0; a < 2; ++a)
#pragma unroll
        for (int b = 0; b < 2; ++b)
#pragma unroll
            for (int m = 0; m < 4; ++m)
#pragma unroll
                for (int n = 0; n < 2; ++n) acc[a][b][m][n] = (f32x4){0.f, 0.f, 0.f, 0.f};
    bf16x8 At[4][2], B0[2][2], B1[2][2];
    const char* cA = (const char*)g.A + (size_t)cur.pm * tstepA + (size_t)cur.pn * g.a_pn_bytes; const char* cB = (const char*)g.Bt + (size_t)cur.pn * tstepB;
    PG8_STAGE(PG8_SB(0, 0), cB, voffB); PG8_STAGE(PG8_SB(0, 1), cB + hstepB, voffB); PG8_STAGE(PG8_SA(0, 0), cA, voffA); PG8_STAGE(PG8_SA(0, 1), cA + hstepA, voffA);
    if (wr == 1) PG8_BAR;
    PG8_WAIT_V(2); PG8_BAR;
    PG8_STAGE(PG8_SB(1, 0), cB + kstep, voffB); PG8_STAGE(PG8_SA(1, 0), cA + kstep, voffA); PG8_STAGE(PG8_SB(1, 1), cB + hstepB + kstep, voffB);
    PG8_WAIT_V(6); PG8_BAR;
    for (;;) {
        const bool has_next = S.next(ui + 1, nxt);
        const char* nA = has_next ? (const char*)g.A + (size_t)nxt.pm * tstepA + (size_t)nxt.pn * g.a_pn_bytes : cA; const char* nB = has_next ? (const char*)g.Bt + (size_t)nxt.pn * tstepB : cB;
#pragma unroll 1
        for (int t = 0; t < nt; t += 2) {
            const bool last = (t == nt - 2);
            if constexpr (Epi::HAS_MID) { if (t == g.midt) { E.mid(acc, cur, wr, wc, fr, fq); } PG8_SCHED; }
            const char* a1 = cA + (size_t)(t + 1) * kstep;
            const char* a2 = last ? nA : cA + (size_t)(t + 2) * kstep; const char* b2 = last ? nB : cB + (size_t)(t + 2) * kstep;
            const char* a3 = a2 + kstep; const char* b3 = b2 + kstep;
            PG8_LDB(B0, 0, 0); PG8_LDB(B1, 0, 1); PG8_SCHED; PG8_LDA(At, 0, 0); PG8_STAGE(PG8_SA(1, 1), a1 + hstepA, voffA);
            PG8_WAIT_V(8); PG8_WAIT_L(0); PG8_BAR; PG8_MMA(0, 0, At, B0); PG8_MMA(0, 1, At, B1); PG8_BAR; PG8_SCHED;
            PG8_LDA(At, 0, 1); PG8_STAGE(PG8_SB(0, 0), b2, voffB); PG8_STAGE(PG8_SB(0, 1), b2 + hstepB, voffB); PG8_STAGE(PG8_SA(0, 0), a2, voffA);
            PG8_WAIT_V(8); PG8_WAIT_L(0); PG8_BAR; PG8_MMA(1, 0, At, B0); PG8_MMA(1, 1, At, B1); PG8_BAR; PG8_SCHED;
            PG8_LDB(B0, 1, 0); PG8_LDB(B1, 1, 1); PG8_SCHED; PG8_LDA(At, 1, 0); PG8_STAGE(PG8_SA(0, 1), a2 + hstepA, voffA);
            PG8_WAIT_V(8); PG8_WAIT_L(0); PG8_BAR; PG8_MMA(0, 0, At, B0); PG8_MMA(0, 1, At, B1); PG8_BAR; PG8_SCHED;
            PG8_LDA(At, 1, 1); PG8_STAGE(PG8_SB(1, 0), b3, voffB); PG8_STAGE(PG8_SB(1, 1), b3 + hstepB, voffB); PG8_STAGE(PG8_SA(1, 0), a3, voffA);
            PG8_WAIT_V(8); PG8_WAIT_L(0); PG8_BAR; PG8_MMA(1, 0, At, B0); PG8_MMA(1, 1, At, B1); PG8_BAR; PG8_SCHED;
        }
        if (wr == 0) PG8_BAR;
        E(acc, cur, wr, wc, fr, fq);
        if (!has_next) break;
#pragma unroll
        for (int a = 0; a < 2; ++a)
#pragma unroll
            for (int b = 0; b < 2; ++b)
#pragma unroll
                for (int m = 0; m < 4; ++m)
#pragma unroll
                    for (int n = 0; n < 2; ++n) acc[a][b][m][n] = (f32x4){0.f, 0.f, 0.f, 0.f};
        cur = nxt; cA = nA; cB = nB; ++ui;
        if (wr == 1) PG8_BAR;
    }
    PG8_WAIT_V(0);
    PG8_BAR;
#undef PG8_SA
#undef PG8_SB
#undef PG8_STAGE
#undef PG8_LDA
#undef PG8_LDB
#undef PG8_MMA
#undef PG8_WAIT_V
#undef PG8_WAIT_L
#undef PG8_BAR
#undef PG8_SCHED
}

typedef f32x4 Acc[2][2][4][2];
__device__ __forceinline__ u32x4 pack8(const f32x4 v0, const f32x4 v1) { u32x4 w; w.x = cvt_pk_bf16(v0[0], v0[1]); w.y = cvt_pk_bf16(v0[2], v0[3]); w.z = cvt_pk_bf16(v1[0], v1[1]); w.w = cvt_pk_bf16(v1[2], v1[3]); return w; }

struct EpiZ {
    static constexpr bool HAS_MID = false;
    bf16_t* Z;
    __device__ __forceinline__ void operator()(Acc& acc, const Unit& u, int wr, int wc, int fr, int fq) const {
        int row0 = u.pm * BM + wr * 64 + fr; asm volatile("" : "+v"(row0)); const int col0 = u.pn * BM + wc * 32 + 8 * fq; const bool sig = u.pn >= 5;
#pragma unroll
        for (int ai = 0; ai < 2; ++ai)
#pragma unroll
            for (int m = 0; m < 4; ++m) { bf16_t* rowp = Z + (size_t)(row0 + ai * HALF + m * 16) * INW + col0;
                f32x4 a0 = acc[ai][0][m][0], a1 = acc[ai][0][m][1], b0 = acc[ai][1][m][0], b1 = acc[ai][1][m][1];
                if (sig) {
#pragma unroll
                    for (int e = 0; e < 4; ++e) { const float ea0 = __builtin_amdgcn_exp2f(-a0[e] * LOG2E), eb0 = __builtin_amdgcn_exp2f(-b0[e] * LOG2E), ea1 = __builtin_amdgcn_exp2f(-a1[e] * LOG2E), eb1 = __builtin_amdgcn_exp2f(-b1[e] * LOG2E);
                        a0[e] = (1.0f + eb0) * __builtin_amdgcn_rcpf(1.0f + ea0); b0[e] = __builtin_amdgcn_rcpf(1.0f + eb0);
                        a1[e] = (1.0f + eb1) * __builtin_amdgcn_rcpf(1.0f + ea1); b1[e] = __builtin_amdgcn_rcpf(1.0f + eb1); } }
                *(u32x4*)(rowp) = pack8(a0, a1); *(u32x4*)(rowp + HALF) = pack8(b0, b1); }
    }
};
struct EpiBf {
    static constexpr bool HAS_MID = false;
    bf16_t* O; int ldc;
    __device__ __forceinline__ void operator()(Acc& acc, const Unit& u, int wr, int wc, int fr, int fq) const {
        int row0 = u.pm * BM + wr * 64 + fr; asm volatile("" : "+v"(row0)); const int col0 = u.pn * BM + wc * 32 + 8 * fq;
#pragma unroll
        for (int ai = 0; ai < 2; ++ai)
#pragma unroll
            for (int m = 0; m < 4; ++m) { bf16_t* rowp = O + (size_t)(row0 + ai * HALF + m * 16) * ldc + col0;
#pragma unroll
                for (int bj = 0; bj < 2; ++bj) *(u32x4*)(rowp + bj * HALF) = pack8(acc[ai][bj][m][0], acc[ai][bj][m][1]); }
    }
};
struct EpiMerge {
    static constexpr bool HAS_MID = true;
    const bf16_t* Z; bf16_t* O;
    __device__ __forceinline__ void mid(Acc& acc, const Unit& u, int wr, int wc, int fr, int fq) const {
        int row0 = u.pm * BM + wr * 64 + fr; asm volatile("" : "+v"(row0)); const int zc0 = ZC_GA + 512 * u.pn + wc * 32 + 8 * fq;
        u32x4 gw[2][4][2];
#pragma unroll
        for (int ai = 0; ai < 2; ++ai)
#pragma unroll
            for (int m = 0; m < 4; ++m) { const bf16_t* zr = Z + (size_t)(row0 + ai * HALF + m * 16) * INW + zc0;
#pragma unroll
                for (int bj = 0; bj < 2; ++bj) gw[ai][m][bj] = *(const u32x4*)(zr + 256 * bj); }
#pragma unroll
        for (int ai = 0; ai < 2; ++ai)
#pragma unroll
            for (int m = 0; m < 4; ++m)
#pragma unroll
                for (int bj = 0; bj < 2; ++bj) { const u32x4 a = gw[ai][m][bj];
#pragma unroll
                    for (int e = 0; e < 4; ++e) { acc[ai][bj][m][e >> 1][(e & 1) * 2] *= bflo(a[e]); acc[ai][bj][m][e >> 1][(e & 1) * 2 + 1] *= bfhi(a[e]); } }
    }
    __device__ __forceinline__ void operator()(Acc& acc, const Unit& u, int wr, int wc, int fr, int fq) const {
        int row0 = u.pm * BM + wr * 64 + fr; asm volatile("" : "+v"(row0)); const int col0 = u.pn * BM + wc * 32 + 8 * fq, zc0 = ZC_GA + 512 * u.pn + wc * 32 + 8 * fq + 128;
        u32x4 gw[2][4][2];
#pragma unroll
        for (int ai = 0; ai < 2; ++ai)
#pragma unroll
            for (int m = 0; m < 4; ++m) { const bf16_t* zr = Z + (size_t)(row0 + ai * HALF + m * 16) * INW + zc0;
#pragma unroll
                for (int bj = 0; bj < 2; ++bj) gw[ai][m][bj] = *(const u32x4*)(zr + 256 * bj); }
#pragma unroll
        for (int ai = 0; ai < 2; ++ai)
#pragma unroll
            for (int m = 0; m < 4; ++m) { bf16_t* rowp = O + (size_t)(row0 + ai * HALF + m * 16) * D + col0;
#pragma unroll
                for (int bj = 0; bj < 2; ++bj) { const u32x4 b = gw[ai][m][bj]; f32x4 v0 = acc[ai][bj][m][0], v1 = acc[ai][bj][m][1];
                    v0[0] *= bflo(b[0]); v0[1] *= bfhi(b[0]); v0[2] *= bflo(b[1]); v0[3] *= bfhi(b[1]); v1[0] *= bflo(b[2]); v1[1] *= bfhi(b[2]); v1[2] *= bflo(b[3]); v1[3] *= bfhi(b[3]);
                    *(u32x4*)(rowp + bj * HALF) = pack8(v0, v1); } }
    }
};
struct EpiX1 {
    static constexpr bool HAS_MID = false;
    const float* xp; const float* xs; float* out; bf16_t* X1B; float* sumsq;
    __device__ __forceinline__ void operator()(Acc& acc, const Unit& u, int wr, int wc, int fr, int fq) const {
        if (!u.last) return;
        int row0 = u.pm * BM + wr * 64 + fr; asm volatile("" : "+v"(row0)); const int col0 = u.pn * BM + wc * 32 + 8 * fq;
#pragma unroll
        for (int ai = 0; ai < 2; ++ai) {
            f32x4 xv[4][2][2];
#pragma unroll
            for (int m = 0; m < 4; ++m) { const int row = row0 + ai * HALF + m * 16; const bool valid = row < MV;
                const float* xr = (row < MP ? xp + (size_t)row * D : xs + (size_t)(valid ? row - MP : 0) * D) + col0;
#pragma unroll
                for (int bj = 0; bj < 2; ++bj) { xv[m][bj][0] = valid ? *(const f32x4*)(xr + bj * HALF) : (f32x4){0.f, 0.f, 0.f, 0.f}; xv[m][bj][1] = valid ? *(const f32x4*)(xr + bj * HALF + 4) : (f32x4){0.f, 0.f, 0.f, 0.f}; } }
#pragma unroll
            for (int m = 0; m < 4; ++m) { const int row = row0 + ai * HALF + m * 16; float ss = 0.f;
#pragma unroll
                for (int bj = 0; bj < 2; ++bj) { const f32x4 v0 = acc[ai][bj][m][0] + xv[m][bj][0], v1 = acc[ai][bj][m][1] + xv[m][bj][1];
                    ss += (v0[0] * v0[0] + v0[1] * v0[1]) + (v0[2] * v0[2] + v0[3] * v0[3]) + (v1[0] * v1[0] + v1[1] * v1[1]) + (v1[2] * v1[2] + v1[3] * v1[3]);
                    *(u32x4*)(X1B + (size_t)row * D + col0 + bj * HALF) = pack8(v0, v1); }
                ss += __shfl_xor(ss, 16); ss += __shfl_xor(ss, 32);
                if (fq == 0) atomicAdd(sumsq + row, ss); }
            asm volatile("" ::: "memory"); }
    }
};
struct EpiAct {
    static constexpr bool HAS_MID = false;
    const float* sumsq; bf16_t* ACT;
    __device__ __forceinline__ void operator()(Acc& acc, const Unit& u, int wr, int wc, int fr, int fq) const {
        int row0 = u.pm * BM + wr * 64 + fr; asm volatile("" : "+v"(row0)); const int col0 = u.pn * HALF + wc * 32 + 8 * fq;
        float rs[2][4];
#pragma unroll
        for (int ai = 0; ai < 2; ++ai)
#pragma unroll
            for (int m = 0; m < 4; ++m) rs[ai][m] = sumsq[row0 + ai * HALF + m * 16];
#pragma unroll
        for (int ai = 0; ai < 2; ++ai)
#pragma unroll
            for (int m = 0; m < 4; ++m) { const int row = row0 + ai * HALF + m * 16; const float rstd = __builtin_amdgcn_rsqf(rs[ai][m] * (1.0f / D) + EPS);
                f32x4 o[2];
#pragma unroll
                for (int n = 0; n < 2; ++n)
#pragma unroll
                    for (int e = 0; e < 4; ++e) { const float gt = acc[ai][0][m][n][e] * rstd, up = acc[ai][1][m][n][e] * rstd; o[n][e] = gt * up * fsigmoid(gt); }
                *(u32x4*)(ACT + (size_t)row * FF + col0) = pack8(o[0], o[1]); }
    }
};
struct EpiY {
    static constexpr bool HAS_MID = false;
    const bf16_t* X1B; float* out;
    __device__ __forceinline__ void operator()(Acc& acc, const Unit& u, int wr, int wc, int fr, int fq) const {
        if (!u.last) return;
        int row0 = u.pm * BM + wr * 64 + fr; asm volatile("" : "+v"(row0)); const int col0 = u.pn * BM + wc * 32 + 8 * fq;
        u32x4 xw[2][4][2];
#pragma unroll
        for (int ai = 0; ai < 2; ++ai)
#pragma unroll
            for (int m = 0; m < 4; ++m) { const int row = row0 + ai * HALF + m * 16; const bf16_t* xr = X1B + (size_t)row * D + col0;
#pragma unroll
                for (int bj = 0; bj < 2; ++bj) xw[ai][m][bj] = *(const u32x4*)(xr + bj * HALF); }
#pragma unroll
        for (int ai = 0; ai < 2; ++ai)
#pragma unroll
            for (int m = 0; m < 4; ++m) { const int row = row0 + ai * HALF + m * 16;
                if (row < MV) { float* orow = out + (size_t)row * D + col0;
#pragma unroll
                    for (int bj = 0; bj < 2; ++bj) { const u32x4 x = xw[ai][m][bj];
                        *(f32x4*)(orow + bj * HALF) = (f32x4){bflo(x[0]), bfhi(x[0]), bflo(x[1]), bfhi(x[1])} + acc[ai][bj][m][0];
                        *(f32x4*)(orow + bj * HALF + 4) = (f32x4){bflo(x[2]), bfhi(x[2]), bflo(x[3]), bfhi(x[3])} + acc[ai][bj][m][1]; } } }
    }
};
}

struct SrcPlain { const float* W; int N; __device__ __forceinline__ float operator()(int k, int n) const { return W[(size_t)k * N + n]; } };
struct SrcWin { const float* W;
    __device__ __forceinline__ float operator()(int k, int n) const { int c = n; if (n >= ZC_GA) { const int t = (n - ZC_GA) >> 8, j = (n - ZC_GA) & 255; c = (j < 128 ? ZC_GA : ZC_GB) + 128 * t + (j & 127); } return W[(size_t)k * INW + c]; } };
struct SrcMix { const float* mix; const float* scale;
    __device__ __forceinline__ float operator()(int k, int n) const { return mix[((size_t)(n >> 7) * 128 + k) * 128 + (n & 127)] * scale[n]; } };
struct SrcCat { const float* wp; const float* wa;
    __device__ __forceinline__ float operator()(int k, int n) const { return k < 512 ? wp[(size_t)k * D + n] : wa[(size_t)(k - 512) * D + n]; } };
struct SrcGU { const float* wg; const float* wu; const float* nrm;
    __device__ __forceinline__ float operator()(int k, int n) const { const int t = n >> 8, j = n & 255, col = 128 * t + (j & 127); const float* w = (const float*)((uintptr_t)wg + (uintptr_t)(j >> 7) * ((uintptr_t)wu - (uintptr_t)wg)); return w[(size_t)k * FF + col] * nrm[k]; } };

template <class Src>
__device__ __forceinline__ void transpose_item(const Src src, bf16_t* WT, int ldk, int nblk, int item, LAS float* scr, int lane) {
    const int kb = item / nblk, nb = item % nblk, k0 = 64 * kb, n0 = 32 * nb;
    float tv[32];
#pragma unroll
    for (int i = 0; i < 32; ++i) tv[i] = src(k0 + 2 * i + (lane >> 5), n0 + (lane & 31));
#pragma unroll
    for (int i = 0; i < 32; ++i) scr[(2 * i + (lane >> 5)) * 33 + (lane & 31)] = tv[i];
    LDS_WAIT();
    const int c = lane & 7;
#pragma unroll
    for (int j = 0; j < 4; ++j) { const int n = (lane >> 3) + 8 * j; const LAS float* s = scr + (8 * c) * 33 + n;
        u32x4 o; o.x = cvt_pk_bf16(s[0 * 33], s[1 * 33]); o.y = cvt_pk_bf16(s[2 * 33], s[3 * 33]); o.z = cvt_pk_bf16(s[4 * 33], s[5 * 33]); o.w = cvt_pk_bf16(s[6 * 33], s[7 * 33]);
        *(u32x4*)(WT + (size_t)(n0 + n) * ldk + k0 + 8 * c) = o; }
    LDS_WAIT();
}

struct Args { const float* in[19]; float* out; unsigned char* ws; int ph_lo, ph_hi; };

template <int NSTEPS, class Epi>
__device__ __forceinline__ void small_gemm(LAS unsigned char* lds, const bf16_t* A, int lda, const bf16_t* Bt, int ldb, int K, int vcu, int G, const Epi& E) {
    const int tid = threadIdx.x, lane = tid & 63, wave = __builtin_amdgcn_readfirstlane(tid >> 6), fr = lane & 15, fq = lane >> 4, rh = wave & 1, ks = wave >> 1;
    const int kq = K >> 2;
    for (int u = vcu; u < 256; u += G) {
        const int r0 = 32 * (u & 3) + 16 * rh, n0 = 16 * (u >> 2);
        const bf16_t* ap = A + (size_t)(r0 + fr) * lda + ks * kq + 8 * fq; const bf16_t* bp = Bt + (size_t)(n0 + fr) * ldb + ks * kq + 8 * fq;
        f32x4 acc = (f32x4){0.f, 0.f, 0.f, 0.f};
        bf16x8 af[NSTEPS], bf[NSTEPS];
#pragma unroll
        for (int s = 0; s < NSTEPS; ++s) { af[s] = *(const bf16x8*)(ap + 32 * s); bf[s] = *(const bf16x8*)(bp + 32 * s); }
#pragma unroll
        for (int s = 0; s < NSTEPS; ++s) acc = __builtin_amdgcn_mfma_f32_16x16x32_bf16(bf[s], af[s], acc, 0, 0, 0);
        LAS f32x4* red = (LAS f32x4*)lds;
        red[(ks * 2 + rh) * 64 + lane] = acc;
        __syncthreads();
        if (ks == 0) { const f32x4 p0 = red[(0 * 2 + rh) * 64 + lane], p1 = red[(1 * 2 + rh) * 64 + lane], p2 = red[(2 * 2 + rh) * 64 + lane], p3 = red[(3 * 2 + rh) * 64 + lane];
            E(p0, p1, p2, p3, r0 + fr, n0 + 4 * fq, fq); }
        __syncthreads();
    }
}
struct SEpiMerge { const bf16_t* Z; bf16_t* O;
    __device__ __forceinline__ void operator()(f32x4 p0, f32x4 p1, f32x4 p2, f32x4 p3, int n, int c, int fq) const {
        const bf16_t* zr = Z + (size_t)(MP + n) * INW + ZC_GA + 256 * (c >> 7) + (c & 127); const u32x2 r = *(const u32x2*)zr, b = *(const u32x2*)(zr + 128);
        const f32x4 pool = p0 + p1, attn = p2 + p3;
        u32x2 w; w.x = cvt_pk_bf16(bflo(b.x) * (bflo(r.x) * pool[0] + attn[0]), bfhi(b.x) * (bfhi(r.x) * pool[1] + attn[1]));
        w.y = cvt_pk_bf16(bflo(b.y) * (bflo(r.y) * pool[2] + attn[2]), bfhi(b.y) * (bfhi(r.y) * pool[3] + attn[3]));
        *(u32x2*)(O + (size_t)(MP + n) * D + c) = w; } };
struct SEpiX1 { const float* xs; float* out; bf16_t* X1B; float* sumsq;
    __device__ __forceinline__ void operator()(f32x4 p0, f32x4 p1, f32x4 p2, f32x4 p3, int n, int c, int fq) const {
        const f32x4 v = *(const f32x4*)(xs + (size_t)n * D + c) + ((p0 + p1) + (p2 + p3));
        u32x2 w; w.x = cvt_pk_bf16(v[0], v[1]); w.y = cvt_pk_bf16(v[2], v[3]); *(u32x2*)(X1B + (size_t)(MP + n) * D + c) = w;
        float ss = (v[0] * v[0] + v[1] * v[1]) + (v[2] * v[2] + v[3] * v[3]); ss += __shfl_xor(ss, 16); ss += __shfl_xor(ss, 32);
        if (fq == 0) atomicAdd(sumsq + MP + n, ss); } };
struct SEpiY { const bf16_t* X1B; float* out;
    __device__ __forceinline__ void operator()(f32x4 p0, f32x4 p1, f32x4 p2, f32x4 p3, int n, int c, int fq) const {
        const u32x2 x = *(const u32x2*)(X1B + (size_t)(MP + n) * D + c);
        *(f32x4*)(out + (size_t)(MP + n) * D + c) = (f32x4){bflo(x.x), bfhi(x.x), bflo(x.y), bfhi(x.y)} + ((p0 + p1) + (p2 + p3)); } };

__device__ __forceinline__ int crow(int r, int hi) { return (r & 3) + 8 * (r >> 2) + 4 * hi; }
constexpr int KS_STRIDE = 144, VT_STRIDE = 520, LDS_VT = 256 * KS_STRIDE  , LDS_SMP = 131072;

__device__ __forceinline__ void attn_prompt_unit(const Args& a, LAS unsigned char* lds, int unit) {
    const int tid = threadIdx.x, lane = tid & 63, wave = __builtin_amdgcn_readfirstlane(tid >> 6);
    const int kh = unit & 1, qb = (unit >> 1) & 15, b = unit >> 5;
    const bf16_t* Z = (const bf16_t*)(a.ws + WS_Z); bf16_t* YY = (bf16_t*)(a.ws + WS_RB);
    const float* qnw = a.in[7]; const float* knw = a.in[8]; const float* sinks = a.in[9];
    const size_t rowbase = (size_t)b * SEQ; const int key0 = (qb - 1) * 128;
    const int hq = 4 * kh + (wave >> 1), ql = lane & 31, h = lane >> 5;
    u32x4 qraw[2][4];
#pragma unroll
    for (int gi = 0; gi < 2; ++gi) { const bf16_t* qp = Z + (rowbase + (size_t)qb * 128 + 32 * (2 * (wave & 1) + gi) + ql) * INW + ZC_Q + hq * 64 + 8 * h;
#pragma unroll
        for (int ds = 0; ds < 4; ++ds) qraw[gi][ds] = *(const u32x4*)(qp + 16 * ds); }
    u32x4 vraw[4];
#pragma unroll
    for (int i = 0; i < 4; ++i) { const int c = tid + 512 * i, key = c & 255, dch = c >> 8, pos = key0 + key;
        vraw[i] = (u32x4){0u, 0u, 0u, 0u};
        if (pos >= 0) vraw[i] = *(const u32x4*)(Z + (rowbase + pos) * INW + ZC_V + kh * 64 + 8 * dch); }
    {
        const int j = tid >> 1, half = tid & 1, pos = key0 + j; float v[32];
        if (pos >= 0) { const u32x4* src = (const u32x4*)(Z + (rowbase + pos) * INW + ZC_K + kh * 64 + 32 * half);
#pragma unroll
            for (int c = 0; c < 4; ++c) { const u32x4 w = src[c];
#pragma unroll
                for (int e = 0; e < 4; ++e) { v[c * 8 + 2 * e] = bflo(w[e]); v[c * 8 + 2 * e + 1] = bfhi(w[e]); } } }
        else {
#pragma unroll
            for (int i = 0; i < 32; ++i) v[i] = 0.f; }
        float ss = 0.f;
#pragma unroll
        for (int i = 0; i < 32; ++i) ss += v[i] * v[i];
        ss += __shfl_xor(ss, 1);
        const float rstd = __builtin_amdgcn_rsqf(ss * (1.0f / 64) + EPS);
#pragma unroll
        for (int c = 0; c < 8; ++c) { const f32x4 w = *(const f32x4*)(knw + 32 * half + 4 * c);
#pragma unroll
            for (int e = 0; e < 4; ++e) v[4 * c + e] = v[4 * c + e] * rstd * w[e]; }
        LAS u32x4* dst = (LAS u32x4*)(lds + j * KS_STRIDE + 64 * half);
#pragma unroll
        for (int c = 0; c < 4; ++c) { u32x4 w;
#pragma unroll
            for (int e = 0; e < 4; ++e) w[e] = cvt_pk_bf16(v[c * 8 + 2 * e], v[c * 8 + 2 * e + 1]);
            dst[c] = w; }
        if (qb == 15 && j >= 128) { float* o = a.out + O_KP + ((size_t)(b * 128 + (j - 128)) * 2 + kh) * 64 + 32 * half;
#pragma unroll
            for (int c = 0; c < 8; ++c) *(f32x4*)(o + 4 * c) = (f32x4){v[4 * c], v[4 * c + 1], v[4 * c + 2], v[4 * c + 3]}; }
    }
#pragma unroll
    for (int i = 0; i < 4; ++i) { const int c = tid + 512 * i, key = c & 255, dch = c >> 8, pos = key0 + key;
        const u32x4 w = vraw[i];
        LAS bf16_t* vt = (LAS bf16_t*)(lds + LDS_VT) + key;
#pragma unroll
        for (int e = 0; e < 4; ++e) { vt[(8 * dch + 2 * e) * (VT_STRIDE / 2)] = (bf16_t)(w[e] & 0xffffu); vt[(8 * dch + 2 * e + 1) * (VT_STRIDE / 2)] = (bf16_t)(w[e] >> 16); }
        if (qb == 15 && key >= 128) { float* o = a.out + O_VP + ((size_t)(b * 128 + (key - 128)) * 2 + kh) * 64 + 8 * dch;
            *(f32x4*)o = (f32x4){bflo(w[0]), bfhi(w[0]), bflo(w[1]), bfhi(w[1])}; *(f32x4*)(o + 4) = (f32x4){bflo(w[2]), bfhi(w[2]), bflo(w[3]), bfhi(w[3])}; } }
    __syncthreads();
    const float sink2 = sinks[hq] * LOG2E;
    f32x16 scs[2][5];
#pragma unroll
    for (int gi = 0; gi < 2; ++gi) {
        const int g = 2 * (wave & 1) + gi;
        bf16x8 qf[4];
        { float v[32];
#pragma unroll
            for (int ds = 0; ds < 4; ++ds) { const u32x4 w = qraw[gi][ds];
#pragma unroll
                for (int e = 0; e < 4; ++e) { v[ds * 8 + 2 * e] = bflo(w[e]); v[ds * 8 + 2 * e + 1] = bfhi(w[e]); } }
            float ss = 0.f;
#pragma unroll
            for (int i = 0; i < 32; ++i) ss += v[i] * v[i];
            ss += __shfl_xor(ss, 32);
            const float sc = __builtin_amdgcn_rsqf(ss * (1.0f / 64) + EPS) * C2;
#pragma unroll
            for (int ds = 0; ds < 4; ++ds) { const f32x4 w0 = *(const f32x4*)(qnw + 16 * ds + 8 * h), w1 = *(const f32x4*)(qnw + 16 * ds + 8 * h + 4); u32x4 p;
                p.x = cvt_pk_bf16(v[ds * 8 + 0] * sc * w0[0], v[ds * 8 + 1] * sc * w0[1]); p.y = cvt_pk_bf16(v[ds * 8 + 2] * sc * w0[2], v[ds * 8 + 3] * sc * w0[3]);
                p.z = cvt_pk_bf16(v[ds * 8 + 4] * sc * w1[0], v[ds * 8 + 5] * sc * w1[1]); p.w = cvt_pk_bf16(v[ds * 8 + 6] * sc * w1[2], v[ds * 8 + 7] * sc * w1[3]);
                qf[ds] = __builtin_bit_cast(bf16x8, p); } }
        __builtin_amdgcn_s_setprio(1);
#pragma unroll
        for (int i = 0; i < 5; ++i) { f32x16 acc = {};
#pragma unroll
            for (int ds = 0; ds < 4; ++ds) { const bf16x8 kf = *(const LAS bf16x8*)(lds + (32 * (g + i) + ql) * KS_STRIDE + 32 * ds + 16 * h);
                acc = __builtin_amdgcn_mfma_f32_32x32x16_bf16(kf, qf[ds], acc, 0, 0, 0); }
            scs[gi][i] = acc; }
        __builtin_amdgcn_s_setprio(0);
    }
    __builtin_amdgcn_sched_barrier(0);
#pragma unroll
    for (int gi = 0; gi < 2; ++gi) {
        const int g = 2 * (wave & 1) + gi; const size_t qrow = rowbase + (size_t)qb * 128 + 32 * g + ql;
        f32x16 (&sc)[5] = scs[gi];
        const int dsel = ql - 4 * h; float mx = -1e30f;
#pragma unroll
        for (int i = 0; i < 5; ++i) {
            if (qb == 0 && g + i < 4) {
#pragma unroll
                for (int r = 0; r < 16; ++r) sc[i][r] = -1e30f;
            } else {
#pragma unroll
                for (int r = 0; r < 16; ++r) { float s = sc[i][r];
                    if (i == 0) s = (crow(r, 0) >= dsel) ? s : -1e30f;
                    if (i == 4) s = (crow(r, 0) <= dsel) ? s : -1e30f;
                    sc[i][r] = s; mx = fmaxf(mx, s); } } }
        mx = fmaxf(mx, __shfl_xor(mx, 32));
        const float mref = fmaxf(mx, sink2); float lsum = 0.f;
#pragma unroll
        for (int i = 0; i < 5; ++i)
#pragma unroll
            for (int r = 0; r < 16; ++r) { const float p = __builtin_amdgcn_exp2f(sc[i][r] - mref); sc[i][r] = p; lsum += p; }
        lsum += __shfl_xor(lsum, 32);
        const float inv = 1.0f / (lsum + __builtin_amdgcn_exp2f(sink2 - mref));
        f32x16 o[2]; o[0] = (f32x16){}; o[1] = (f32x16){};
        __builtin_amdgcn_s_setprio(1);
#pragma unroll
        for (int i = 0; i < 5; ++i)
#pragma unroll
            for (int s2 = 0; s2 < 2; ++s2) { u32x4 pw;
#pragma unroll
                for (int e = 0; e < 4; ++e) pw[e] = cvt_pk_bf16(sc[i][8 * s2 + 2 * e], sc[i][8 * s2 + 2 * e + 1]);
                const bf16x8 pf = __builtin_bit_cast(bf16x8, pw);
#pragma unroll
                for (int dt = 0; dt < 2; ++dt) { const LAS unsigned char* vp = lds + LDS_VT + (32 * dt + ql) * VT_STRIDE + 2 * (32 * (g + i) + 16 * s2 + 4 * h);
                    const u32x2 lo = *(const LAS u32x2*)vp, hi2 = *(const LAS u32x2*)(vp + 16);
                    const u32x4 vw = (u32x4){lo.x, lo.y, hi2.x, hi2.y};
                    o[dt] = __builtin_amdgcn_mfma_f32_32x32x16_bf16(__builtin_bit_cast(bf16x8, vw), pf, o[dt], 0, 0, 0); } }
        __builtin_amdgcn_s_setprio(0);
        bf16_t* yp = YY + qrow * D + 512 + hq * 64 + 4 * h;
#pragma unroll
        for (int dt = 0; dt < 2; ++dt)
#pragma unroll
            for (int rq = 0; rq < 4; ++rq) { u32x2 w; w.x = cvt_pk_bf16(o[dt][4 * rq] * inv, o[dt][4 * rq + 1] * inv); w.y = cvt_pk_bf16(o[dt][4 * rq + 2] * inv, o[dt][4 * rq + 3] * inv);
                *(u32x2*)(yp + 32 * dt + 8 * rq) = w; }
        __builtin_amdgcn_sched_barrier(0);
    }
    __syncthreads();
}

__device__ __forceinline__ void attn_sample_unit(const Args& a, LAS unsigned char* lds, int su) {
    const int tid = threadIdx.x, lane = tid & 63, wave = __builtin_amdgcn_readfirstlane(tid >> 6);
    const int n = su >> 1, kh = su & 1;
    const float* ck = a.in[2] + (size_t)n * 16384; const float* cv = a.in[3] + (size_t)n * 16384;
    if (wave < 4) {
        const int hq = 4 * kh + wave;
        const bf16_t* zrow = (const bf16_t*)(a.ws + WS_Z) + (size_t)(MP + n) * INW; bf16_t* YY = (bf16_t*)(a.ws + WS_RB);
        LAS float* qs = (LAS float*)(lds + LDS_SMP + wave * 1024); LAS float* ps = qs + 64;
        const float xq = bf1(zrow[ZC_Q + hq * 64 + lane]); const float ssq = wave_sum(xq * xq);
        const float qn = xq * __builtin_amdgcn_rsqf(ssq * (1.0f / 64) + EPS) * a.in[7][lane] * C2;
        const float xk = bf1(zrow[ZC_K + kh * 64 + lane]); const float ssk = wave_sum(xk * xk);
        const float kn = xk * __builtin_amdgcn_rsqf(ssk * (1.0f / 64) + EPS) * a.in[8][lane];
        const float vn = bf1(zrow[ZC_V + kh * 64 + lane]);
        const float s_new = wave_sum(qn * kn);
        if (wave == 0) { a.out[O_KS + (size_t)n * 16384 + (127 * 2 + kh) * 64 + lane] = kn; a.out[O_VS + (size_t)n * 16384 + (127 * 2 + kh) * 64 + lane] = vn; }
        qs[lane] = qn; LDS_WAIT();
        float s0 = 0.f, s1 = 0.f;
        { const f32x4* k0 = (const f32x4*)(ck + (size_t)(lane * 2 + kh) * 64); const f32x4* k1 = (const f32x4*)(ck + (size_t)((lane + 64) * 2 + kh) * 64);
#pragma unroll
            for (int c = 0; c < 16; ++c) { const f32x4 q4 = *(const LAS f32x4*)(qs + 4 * c), x0 = k0[c], x1 = k1[c];
                s0 += (q4[0] * x0[0] + q4[1] * x0[1]) + (q4[2] * x0[2] + q4[3] * x0[3]); s1 += (q4[0] * x1[0] + q4[1] * x1[1]) + (q4[2] * x1[2] + q4[3] * x1[3]); } }
        const float sink2 = a.in[9][hq] * LOG2E;
        const float mref = fmaxf(fmaxf(wave_max(fmaxf(s0, s1)), s_new), sink2);
        const float p0 = __builtin_amdgcn_exp2f(s0 - mref), p1 = __builtin_amdgcn_exp2f(s1 - mref), pn = __builtin_amdgcn_exp2f(s_new - mref);
        const float l = wave_sum(p0 + p1) + pn + __builtin_amdgcn_exp2f(sink2 - mref);
        ps[lane] = p0; ps[lane + 64] = p1; LDS_WAIT();
        const int kg = lane >> 4, dc = lane & 15;
        f32x4 o = (f32x4){0.f, 0.f, 0.f, 0.f};
#pragma unroll 16
        for (int j = 0; j < 32; ++j) { const int key = 4 * j + kg; const f32x4 v = *(const f32x4*)(cv + (size_t)(key * 2 + kh) * 64 + 4 * dc); o += v * ps[key]; }
#pragma unroll
        for (int e = 0; e < 4; ++e) { o[e] += __shfl_xor(o[e], 16); o[e] += __shfl_xor(o[e], 32); }
        if (kg == 0) { const f32x4 vn4 = (f32x4){bf1(zrow[ZC_V + kh * 64 + 4 * dc]), bf1(zrow[ZC_V + kh * 64 + 4 * dc + 1]), bf1(zrow[ZC_V + kh * 64 + 4 * dc + 2]), bf1(zrow[ZC_V + kh * 64 + 4 * dc + 3])};
            const float il = 1.0f / l; const f32x4 r = (o + vn4 * pn) * il;
            u32x2 w; w.x = cvt_pk_bf16(r[0], r[1]); w.y = cvt_pk_bf16(r[2], r[3]);
            *(u32x2*)(YY + (size_t)(MP + n) * D + 512 + hq * 64 + 4 * dc) = w; }
    }
}

constexpr int PL_STRIDE = 272;
template <int W>
__device__ __forceinline__ void pool_task(const Args& a, LAS unsigned char* wl, int blk, int g, int lane) {
    const bf16_t* Z = (const bf16_t*)(a.ws + WS_Z); bf16_t* YY = (bf16_t*)(a.ws + WS_RB); const bf16_t* WM = (const bf16_t*)(a.ws + WS_MIX);
    const int r0 = 32 * blk, row = lane & 31, h = lane >> 5;
    f32x16 acc[4];
#pragma unroll
    for (int nt = 0; nt < 4; ++nt) acc[nt] = (f32x16){};
    if (r0 < MP) {
        const int t0 = r0 & (SEQ - 1), b = r0 >> 11;
#pragma unroll
        for (int it = 0; it < 12; ++it) { const int rr = 4 * it + (lane >> 4);
            if (rr < 47) { u32x4 v = (u32x4){0u, 0u, 0u, 0u};
                if (t0 > 0 || rr >= 15) v = *(const u32x4*)(Z + (size_t)(r0 - 15 + rr) * INW + 128 * g + 8 * (lane & 15));
                *(LAS u32x4*)(wl + rr * PL_STRIDE + 16 * (lane & 15)) = v; } }
        LDS_WAIT();
        const int t = t0 + row; const float rc = 1.0f / (float)min(W, t + 1);
        const bf16_t* wmp = WM + (size_t)(128 * g + row) * 128 + 8 * h;
        bf16x8 bnx[4];
#pragma unroll
        for (int nt = 0; nt < 4; ++nt) bnx[nt] = *(const bf16x8*)(wmp + (size_t)(32 * nt) * 128);
#pragma unroll 1
        for (int ks = 0; ks < 8; ++ks) {
            bf16x8 bcur[4];
#pragma unroll
            for (int nt = 0; nt < 4; ++nt) bcur[nt] = bnx[nt];
            if (ks < 7) {
#pragma unroll
                for (int nt = 0; nt < 4; ++nt) bnx[nt] = *(const bf16x8*)(wmp + (size_t)(32 * nt) * 128 + 16 * (ks + 1)); }
            const LAS unsigned char* base = wl + (15 + row) * PL_STRIDE + (16 * ks + 8 * h) * 2;
            float s[8], u[8];
            { const u32x4 x = *(const LAS u32x4*)base;
#pragma unroll
                for (int e = 0; e < 4; ++e) { u[2 * e] = bflo(x[e]); u[2 * e + 1] = bfhi(x[e]); s[2 * e] = u[2 * e]; s[2 * e + 1] = u[2 * e + 1]; } }
#pragma unroll
            for (int i = 1; i < W; ++i) { const u32x4 x = *(const LAS u32x4*)(base - i * PL_STRIDE);
#pragma unroll
                for (int e = 0; e < 4; ++e) { s[2 * e] += bflo(x[e]); s[2 * e + 1] += bfhi(x[e]); } }
            u32x4 y;
#pragma unroll
            for (int e = 0; e < 4; ++e) y[e] = cvt_pk_bf16(s[2 * e] * rc - u[2 * e], s[2 * e + 1] * rc - u[2 * e + 1]);
            const bf16x8 af = __builtin_bit_cast(bf16x8, y);
            if (t >= SEQ - 15) { float* o = a.out + O_PP + ((size_t)b * 15 + (t - (SEQ - 15))) * PW + 128 * g + 16 * ks + 8 * h;
                *(f32x4*)o = (f32x4){u[0], u[1], u[2], u[3]}; *(f32x4*)(o + 4) = (f32x4){u[4], u[5], u[6], u[7]}; }
#pragma unroll
            for (int nt = 0; nt < 4; ++nt) acc[nt] = __builtin_amdgcn_mfma_f32_32x32x16_bf16(af, bcur[nt], acc[nt], 0, 0, 0);
        }
    } else {
        const int n = r0 - MP + row; const float* sp = (const float*)(a.ws + WS_SPOOL) + (size_t)n * PW; float* po = a.out + O_PS + (size_t)n * 15 * PW; const float rc = 1.0f / (float)W;
        const int cb = 128 * g + 8 * h;
        u32x4 xn = *(const u32x4*)(Z + (size_t)(MP + n) * INW + cb); f32x4 s0n = *(const f32x4*)(sp + cb), s1n = *(const f32x4*)(sp + cb + 4);
#pragma unroll 1
        for (int ks = 0; ks < 8; ++ks) {
            const int c0 = cb + 16 * ks;
            float s[8], u[8];
            { const u32x4 x = xn; const f32x4 s0 = s0n, s1 = s1n;
                if (ks < 7) { xn = *(const u32x4*)(Z + (size_t)(MP + n) * INW + c0 + 16); s0n = *(const f32x4*)(sp + c0 + 16); s1n = *(const f32x4*)(sp + c0 + 20); }
#pragma unroll
                for (int e = 0; e < 4; ++e) { u[2 * e] = bflo(x[e]); u[2 * e + 1] = bfhi(x[e]); }
#pragma unroll
                for (int e = 0; e < 4; ++e) { s[e] = u[e] + s0[e]; s[4 + e] = u[4 + e] + s1[e]; } }
            *(f32x4*)(po + 14 * PW + c0) = (f32x4){u[0], u[1], u[2], u[3]}; *(f32x4*)(po + 14 * PW + c0 + 4) = (f32x4){u[4], u[5], u[6], u[7]};
            u32x4 y;
#pragma unroll
            for (int e = 0; e < 4; ++e) y[e] = cvt_pk_bf16(s[2 * e] * rc - u[2 * e], s[2 * e + 1] * rc - u[2 * e + 1]);
            const bf16x8 af = __builtin_bit_cast(bf16x8, y);
#pragma unroll
            for (int nt = 0; nt < 4; ++nt) { const bf16x8 bfr = *(const bf16x8*)(WM + (size_t)(128 * g + 32 * nt + row) * 128 + 16 * ks + 8 * h);
                acc[nt] = __builtin_amdgcn_mfma_f32_32x32x16_bf16(af, bfr, acc[nt], 0, 0, 0); }
        }
    }
#pragma unroll
    for (int nt = 0; nt < 4; ++nt)
#pragma unroll
        for (int r = 0; r < 16; ++r) YY[(size_t)(r0 + crow(r, h)) * D + 128 * g + 32 * nt + row] = (bf16_t)(cvt_pk_bf16(acc[nt][r], 0.f) & 0xffffu);
    LDS_WAIT();
}
__device__ __forceinline__ void pool_one(const Args& a, LAS unsigned char* wl, int blk, int g, int lane) {
    if (g == 0) pool_task<2>(a, wl, blk, 0, lane); else if (g == 1) pool_task<4>(a, wl, blk, 1, lane); else if (g == 2) pool_task<8>(a, wl, blk, 2, lane); else pool_task<16>(a, wl, blk, 3, lane);
}
__device__ __forceinline__ void roll_copies(const Args& a, int gtid, int gthreads) {
    { const f32x4* src = (const f32x4*)a.in[4]; f32x4* dst = (f32x4*)(a.out + O_PS);
        for (int i0 = gtid; i0 < NS * 1792; i0 += 2 * gthreads) { const int i1 = i0 + gthreads; const bool two = i1 < NS * 1792;
            const int n0 = i0 / 1792, j0 = i0 - n0 * 1792, n1 = two ? i1 / 1792 : 0, j1 = two ? i1 - n1 * 1792 : 0;
            const f32x4 v0 = src[(size_t)n0 * 1920 + 128 + j0], v1 = src[(size_t)n1 * 1920 + 128 + j1];
            dst[(size_t)n0 * 1920 + j0] = v0; if (two) dst[(size_t)n1 * 1920 + j1] = v1; } }
    { const f32x4* src = (const f32x4*)a.in[4]; f32x4* S4 = (f32x4*)(a.ws + WS_SPOOL);
        for (int i = gtid; i < NS * 128; i += gthreads) { const int n = i >> 7, c4 = i & 127, W = 2 << (c4 >> 5); f32x4 acc = (f32x4){0.f, 0.f, 0.f, 0.f};
#pragma unroll
            for (int k = 1; k < 16; ++k) { if (k < W) acc += src[(size_t)(n * 15 + 15 - k) * 128 + c4]; }
            S4[(size_t)n * 128 + c4] = acc; } }
    { const f32x4* sk = (const f32x4*)a.in[2]; const f32x4* sv = (const f32x4*)a.in[3]; f32x4* dk = (f32x4*)(a.out + O_KS); f32x4* dv = (f32x4*)(a.out + O_VS);
        constexpr int PER = 127 * 32;
        for (int i0 = gtid; i0 < NS * PER; i0 += 2 * gthreads) { const int i1 = i0 + gthreads; const bool two = i1 < NS * PER;
            const int n0 = i0 / PER, j0 = i0 - n0 * PER, n1 = two ? i1 / PER : 0, j1 = two ? i1 - n1 * PER : 0;
            const f32x4 k0 = sk[(size_t)n0 * 4096 + 32 + j0], k1 = sk[(size_t)n1 * 4096 + 32 + j1], v0 = sv[(size_t)n0 * 4096 + 32 + j0], v1 = sv[(size_t)n1 * 4096 + 32 + j1];
            dk[(size_t)n0 * 4096 + j0] = k0; dv[(size_t)n0 * 4096 + j0] = v0; if (two) { dk[(size_t)n1 * 4096 + j1] = k1; dv[(size_t)n1 * 4096 + j1] = v1; } } }
}

#define XB_TMO      128
#define XB_XCNT(j)  (256  + 64 * (j))
#define XB_XSUB(j)  (1280 + 64 * (j))
#define XB_XGEN(j)  (2304 + 64 * (j))
#define XB_TOP      3328
#define XB_TOPGEN   3392
#define XCD_BAR_WORDS 3456
#define XB_SPIN_CAP (1u << 18)
__device__ __forceinline__ unsigned xb_ld(unsigned* p)              { return __hip_atomic_load(p, __ATOMIC_RELAXED, __HIP_MEMORY_SCOPE_AGENT); }
__device__ __forceinline__ unsigned xb_add(unsigned* p, unsigned v) { return __hip_atomic_fetch_add(p, v, __ATOMIC_RELAXED, __HIP_MEMORY_SCOPE_AGENT); }
__device__ __forceinline__ unsigned xb_xcc_id() { return (unsigned)__builtin_amdgcn_s_getreg((3 << 11) | 20) & 0xFu; }
#define XB_SPIN(cond, bar) do { unsigned _sp = 0; while (cond) { __builtin_amdgcn_s_sleep(1); \
    if ((++_sp & 255u) == 0u) { if (xb_ld(&(bar)[XB_TMO])) break; if (_sp > XB_SPIN_CAP) { atomicAdd(&(bar)[XB_TMO], 1u); break; } } } } while (0)
struct XcdBarrier { unsigned* bar; unsigned x; volatile LAS unsigned* st; };
__device__ __forceinline__ XcdBarrier xcd_barrier_post(unsigned* bar, volatile LAS unsigned* st) {
    XcdBarrier b; b.bar = bar; b.x = xb_xcc_id(); b.st = st;
    if (threadIdx.x == 0) (void)xb_add(&bar[XB_XCNT(b.x)], 1u);
    return b;
}
__device__ __forceinline__ void xcd_barrier_complete(unsigned* bar, unsigned x, unsigned& nloc, unsigned& nx) {
    const unsigned G = gridDim.x * gridDim.y * gridDim.z;
    unsigned sum, cnt, mine, sp = 0u;
    for (;;) {
        sum = 0u; cnt = 0u; mine = 0u;
#pragma unroll
        for (unsigned j = 0; j < 16; ++j) { const unsigned c = xb_ld(&bar[XB_XCNT(j)]); sum += c; cnt += (c > 0u) ? 1u : 0u; mine = (j == x) ? c : mine; }
        if (sum == G) break;
        __builtin_amdgcn_s_sleep(1);
        if ((++sp & 255u) == 0u) { if (xb_ld(&bar[XB_TMO])) break; if (sp > XB_SPIN_CAP) { atomicAdd(&bar[XB_TMO], 1u); break; } }
    }
    nloc = mine > 0u ? mine : 1u; nx = cnt > 0u ? cnt : 1u;
}
__device__ __forceinline__ void xcd_barrier(const XcdBarrier& b) {
    asm volatile("s_waitcnt vmcnt(0)" ::: "memory");
    __syncthreads();
    if (threadIdx.x == 0) {
        unsigned* bar = b.bar;
        __builtin_amdgcn_s_waitcnt(0);
        unsigned nloc = b.st[0], nx = b.st[1];
        if (nloc == 0u) { xcd_barrier_complete(bar, b.x, nloc, nx); b.st[0] = nloc; b.st[1] = nx; }
        const unsigned old = xb_add(&bar[XB_XSUB(b.x)], 1u);
        const unsigned gen = old / nloc;
        if (old + 1u == (gen + 1u) * nloc) {
            __builtin_amdgcn_fence(__ATOMIC_RELEASE, "agent");
            asm volatile("s_waitcnt vmcnt(0)" ::: "memory");
            const unsigned og = xb_add(&bar[XB_TOP], 1u);
            const unsigned tg = og / nx;
            if (og + 1u == (tg + 1u) * nx) xb_add(&bar[XB_TOPGEN], 1u);
            else XB_SPIN(xb_ld(&bar[XB_TOPGEN]) == tg, bar);
            __builtin_amdgcn_fence(__ATOMIC_ACQUIRE, "agent");
            xb_add(&bar[XB_XGEN(b.x)], 1u);
            asm volatile("s_waitcnt vmcnt(0)" ::: "memory");
        } else {
            XB_SPIN(xb_ld(&bar[XB_XGEN(b.x)]) == gen, bar);
            __builtin_amdgcn_fence(__ATOMIC_ACQUIRE, "agent");
            asm volatile("s_waitcnt vmcnt(0)" ::: "memory");
        }
    }
    __syncthreads();
}

__global__ void __launch_bounds__(512, 2) fwd_megakernel(Args a) {
    extern __shared__ __attribute__((aligned(16))) unsigned char lds_raw[];
    LAS unsigned char* lds = (LAS unsigned char*)lds_raw;
    const int tid = threadIdx.x, lane = tid & 63, wave = __builtin_amdgcn_readfirstlane(tid >> 6);
    const int G = gridDim.x, bx = blockIdx.x;
    const int vcu = (G % 8 == 0) ? (bx % 8) * (G / 8) + bx / 8 : bx;
    unsigned char* ws = a.ws;
    bf16_t* WIN = (bf16_t*)(ws + WS_WIN); bf16_t* WMIX = (bf16_t*)(ws + WS_MIX); bf16_t* WCAT = (bf16_t*)(ws + WS_WCAT); bf16_t* WOUT = (bf16_t*)(ws + WS_WOUT);
    bf16_t* WGU = (bf16_t*)(ws + WS_WGU); bf16_t* WDN = (bf16_t*)(ws + WS_WDN);
    bf16_t* RA = (bf16_t*)(ws + WS_RA); bf16_t* RB = (bf16_t*)(ws + WS_RB); bf16_t* Z = (bf16_t*)(ws + WS_Z);
    float* SUMSQ = (float*)(ws + WS_SUMSQ);
    const int lo = a.ph_lo, hi = a.ph_hi;
    if (tid < 2) ((volatile LAS unsigned*)(lds + LDS_MISC))[tid] = 0u;
    __syncthreads();
    if (AMP_PHASE >= 0 && tid == 0) *(volatile LAS unsigned long long*)(lds + LDS_MISC + 16) = __builtin_amdgcn_s_memrealtime();
    XcdBarrier xbar = xcd_barrier_post((unsigned*)(ws + WS_BAR), (volatile LAS unsigned*)(lds + LDS_MISC));
#ifndef PH_MASK
#define PH_MASK 255
#endif
#define IN(k) (((PH_MASK >> (k)) & 1) && lo <= (k) && (k) < hi)
#ifndef DUP_MASK
#define DUP_MASK 0
#endif
#ifndef SMALL_REP
#define SMALL_REP 0
#endif
#ifndef EXTRA_SYNCS
#define EXTRA_SYNCS 0
#endif
#define REP(k) for (int rep_ = 0; rep_ < 1 + ((DUP_MASK >> (k)) & 1); ++rep_)
#define LASTREP(k) (rep_ == ((DUP_MASK >> (k)) & 1))
#define AMP(k) do { if (AMP_PHASE >= 0 && bx == 0) { volatile LAS unsigned long long* tp_ = (volatile LAS unsigned long long*)(lds + LDS_MISC + 16); const unsigned long long now_ = __builtin_amdgcn_s_memrealtime(); \
        if ((k) == AMP_PHASE || AMP_PHASE == 99) { const unsigned long long dt_ = now_ - tp_[0]; while (__builtin_amdgcn_s_memrealtime() - now_ < dt_) __builtin_amdgcn_s_sleep(8); } \
        __syncthreads(); if (tid == 0) tp_[0] = __builtin_amdgcn_s_memrealtime(); __syncthreads(); } } while (0)
#define SEAM(k) do { if (IN(k) && IN((k) + 1)) { xcd_barrier(xbar); for (int xs_ = 0; xs_ < EXTRA_SYNCS; ++xs_) xcd_barrier(xbar); AMP(k); } } while (0)

    if (IN(0)) REP(0) {
        LAS float* scr = (LAS float*)(lds + wave * 16384);
        const int gw = vcu * 8 + wave, NGW = G * 8;
        constexpr int I_IN = 16 * 104, I_MIX = 2 * 16;
        const float* g1 = a.in[5];
        constexpr int RPI = 4;
        for (int m0 = gw; m0 < MPAD; m0 += RPI * NGW) {
            f32x4 v[RPI][4];
#pragma unroll
            for (int q = 0; q < RPI; ++q) { const int m = m0 + q * NGW;
                if (m < MV) { const f32x4* xr = (const f32x4*)(m < MP ? a.in[0] + (size_t)m * D : a.in[1] + (size_t)(m - MP) * D) + lane;
#pragma unroll
                    for (int j = 0; j < 4; ++j) v[q][j] = __builtin_nontemporal_load(xr + 64 * j); }
                else {
#pragma unroll
                    for (int j = 0; j < 4; ++j) v[q][j] = (f32x4){0.f, 0.f, 0.f, 0.f}; } }
            if (m0 == gw) {
                for (int it = gw; it < I_IN + I_MIX; it += NGW) {
                    if (it < I_IN) transpose_item(SrcWin{a.in[6]}, WIN, D, 104, it, scr, lane);
                    else transpose_item(SrcMix{a.in[10], a.in[11]}, WMIX, 128, 16, it - I_IN, scr, lane);
                } }
            f32x4 gg[4];
#pragma unroll
            for (int j = 0; j < 4; ++j) gg[j] = ((const f32x4*)g1)[lane + 64 * j];
#pragma unroll
            for (int q = 0; q < RPI; ++q) { const int m = m0 + q * NGW;
                if (m < MPAD) { float sq = 0.f;
#pragma unroll
                    for (int j = 0; j < 4; ++j) sq += (v[q][j].x * v[q][j].x + v[q][j].y * v[q][j].y) + (v[q][j].z * v[q][j].z + v[q][j].w * v[q][j].w);
                    const float rstd = __builtin_amdgcn_rsqf(wave_sum(sq) * (1.f / D) + EPS);
                    unsigned long long* o8 = (unsigned long long*)(RA + (size_t)m * D) + lane;
#pragma unroll
                    for (int j = 0; j < 4; ++j)
                        o8[64 * j] = (unsigned long long)cvt_pk_bf16(v[q][j].x * rstd * gg[j].x, v[q][j].y * rstd * gg[j].y) | ((unsigned long long)cvt_pk_bf16(v[q][j].z * rstd * gg[j].z, v[q][j].w * rstd * gg[j].w) << 32);
                    if (m >= MV) { unsigned long long* y8 = (unsigned long long*)(RB + (size_t)m * D) + lane;
#pragma unroll
                        for (int j = 0; j < 4; ++j) y8[64 * j] = 0ull; } } }
        }
        for (int i = vcu * 512 + tid; i < MPAD; i += G * 512) SUMSQ[i] = 0.f;
    }
    SEAM(0);
    if (IN(1)) {
        pg8::Gemm g{RA, WIN, D, D, D, 0, -1}; pg8::StaticOrder S; S.init(MPAD, INW, G, bx, 1 + ((DUP_MASK >> 1) & 1));
        pg8::gemm_phase(lds, g, S, pg8::EpiZ{Z});
        { const int maxper = (S.nwg + G - 1) / G, rem = S.nwg - (maxper - 1) * G; const bool all = rem >= G; const int nid = all ? G : G - rem, rk = all ? bx : bx - rem;
            if (rk >= 0) { LAS float* scr = (LAS float*)(lds + wave * 16384);
                constexpr int I_CAT = 16 * 32, I_OUT = 16 * 32, I_GU = 16 * 176, I_DN = 44 * 32;
                for (int it = rk * 8 + wave; it < I_CAT + I_OUT + I_GU + I_DN; it += nid * 8) {
                    int r = it;
                    if (r < I_CAT) { transpose_item(SrcCat{a.in[12], a.in[13]}, WCAT, D, 32, r, scr, lane); continue; } r -= I_CAT;
                    if (r < I_OUT) { transpose_item(SrcPlain{a.in[14], D}, WOUT, D, 32, r, scr, lane); continue; } r -= I_OUT;
                    if (r < I_GU) { transpose_item(SrcGU{a.in[16], a.in[17], a.in[15]}, WGU, D, 176, r, scr, lane); continue; } r -= I_GU;
                    transpose_item(SrcPlain{a.in[18], D}, WDN, FF, 32, r, scr, lane);
                }
                roll_copies(a, rk * 512 + tid, nid * 512); } }
    }
    SEAM(1);
    if (IN(2)) REP(2) {
        for (int u = vcu; u < 256; u += G) attn_prompt_unit(a, lds, u);
        if (wave < 4) { for (int su = vcu; su < 2 * NS; su += G) attn_sample_unit(a, lds, su); }
        for (int bb = 2 * vcu; bb < MP / 32; bb += 2 * G) {
            const int blk = bb + (wave & 1), g = wave < 4 ? (wave >> 1) : 2 + ((wave - 4) >> 1);
            pool_one(a, lds + wave * 16384, blk, g, lane);
        }
        if (wave == 4) { for (int lt = vcu; lt < (NS / 32) * 4; lt += G) pool_one(a, lds + wave * 16384, MP / 32 + (lt >> 2), lt & 3, lane); }
    }
    SEAM(2);
    if (IN(4)) {
        pg8::Gemm g{RB, WCAT, D, D, D, 0, 8}; pg8::StaticOrder S; S.init(MP, D, G, bx, 1 + ((DUP_MASK >> 4) & 1));
        pg8::gemm_phase(lds, g, S, pg8::EpiMerge{Z, RA});

        for (int sr_ = 0; sr_ < 1 + SMALL_REP; ++sr_) small_gemm<8>(lds, RB + (size_t)MP * D, D, WCAT, D, D, vcu, G, SEpiMerge{Z, RA});    }
    SEAM(4);
    if (IN(5)) {
        pg8::Gemm g{RA, WOUT, D, D, D, 0, -1}; pg8::StaticOrder S; S.init(MP, D, G, bx, 1 + ((DUP_MASK >> 5) & 1));
        pg8::gemm_phase(lds, g, S, pg8::EpiX1{a.in[0], a.in[1], a.out + O_Y, RB, SUMSQ});

        small_gemm<8>(lds, RA + (size_t)MP * D, D, WOUT, D, D, vcu, G, SEpiX1{a.in[1], a.out + O_Y, RB, SUMSQ});    }
    SEAM(5);
    if (IN(6)) {
        pg8::Gemm g{RB, WGU, D, D, D, 0, -1}; pg8::StaticOrder S; S.init(MPAD, 2 * FF, G, bx, 1 + ((DUP_MASK >> 6) & 1));
        pg8::gemm_phase(lds, g, S, pg8::EpiAct{SUMSQ, Z});
    }
    SEAM(6);
    if (IN(7)) {
        pg8::Gemm g{Z, WDN, FF, FF, FF, 0, -1}; pg8::StaticOrder S; S.init(MP, D, G, bx, 1 + ((DUP_MASK >> 7) & 1));
        pg8::gemm_phase(lds, g, S, pg8::EpiY{RB, a.out + O_Y});

        small_gemm<22>(lds, Z + (size_t)MP * FF, FF, WDN, FF, FF, vcu, G, SEpiY{RB, a.out + O_Y});    }
    if (AMP_PHASE == 7 || AMP_PHASE == 99) { asm volatile("s_waitcnt vmcnt(0)" ::: "memory"); __syncthreads(); AMP(7); }
#undef IN
#undef SEAM
}

#ifndef MK_N_LAUNCHES
#define MK_N_LAUNCHES 1
#endif
extern "C" void kernel_launch(void* const* d_in, const int* in_sizes, int n_in, void* d_out, int out_size, void* d_ws, size_t ws_size, hipStream_t stream) {
    static int grid = 0;
    if (grid == 0) {
        int dev = 0, cus = 0, per_cu = 0;
        if (n_in != 19 || ws_size < WS_END) { fprintf(stderr, "kernel_launch: unexpected inputs (n_in %d, ws %zu)\n", n_in, ws_size); grid = -1; return; }
        hipGetDevice(&dev); hipDeviceGetAttribute(&cus, hipDeviceAttributeMultiprocessorCount, dev);
        if (hipFuncSetAttribute((const void*)fwd_megakernel, hipFuncAttributeMaxDynamicSharedMemorySize, LDS_BYTES) != hipSuccess) { fprintf(stderr, "kernel_launch: hipFuncSetAttribute failed\n"); grid = -1; return; }
        if (hipOccupancyMaxActiveBlocksPerMultiprocessor(&per_cu, (const void*)fwd_megakernel, 512, LDS_BYTES) != hipSuccess || per_cu < 1) { fprintf(stderr, "kernel_launch: occupancy query says %d\n", per_cu); per_cu = 1; }
        (void)hipGetLastError();
        grid = cus * 1;
        if (per_cu < 1) grid = -1;
    }
    if (grid < 0) return;
    if (hipMemsetAsync((char*)d_ws + WS_BAR, 0, WS_BAR_BYTES, stream) != hipSuccess) { fprintf(stderr, "kernel_launch: memset failed\n"); return; }
    Args a{};
    for (int i = 0; i < 19; ++i) a.in[i] = (const float*)d_in[i];
    a.out = (float*)d_out; a.ws = (unsigned char*)d_ws;
#if MK_N_LAUNCHES == 1
    a.ph_lo = 0; a.ph_hi = 8;
    hipLaunchKernelGGL(fwd_megakernel, dim3(grid), dim3(512), LDS_BYTES, stream, a);
    if (hipPeekAtLastError() != hipSuccess) fprintf(stderr, "kernel_launch: launch failed (grid %d)\n", grid);
#else
    for (int p = 0; p < 8; ++p) { a.ph_lo = p; a.ph_hi = p + 1; hipLaunchKernelGGL(fwd_megakernel, dim3(grid), dim3(512), LDS_BYTES, stream, a); }
#endif
}
```

```cpp
#include <hip/hip_runtime.h>
#include <hip/hip_cooperative_groups.h>
#include <cstdio>
#include <cstdint>
namespace cg = cooperative_groups;

#define LAS __attribute__((address_space(3)))
#ifndef AMP_PHASE
#define AMP_PHASE -1
#endif
typedef unsigned short bf16_t;
typedef short bf16x8 __attribute__((ext_vector_type(8)));
typedef short s16x4 __attribute__((ext_vector_type(4)));
typedef float f32x4 __attribute__((ext_vector_type(4)));
typedef float f32x16 __attribute__((ext_vector_type(16)));
typedef unsigned u32x4 __attribute__((ext_vector_type(4)));
typedef unsigned u32x2 __attribute__((ext_vector_type(2)));

constexpr int D = 1024, SEQ = 2048, NB = 8, MP = NB * SEQ, NS = 128, MV = MP + NS, MPAD = 16640;
constexpr int INW = 3328, FF = 2816, PW = 512;
constexpr int ZC_Q = 512, ZC_K = 1024, ZC_V = 1152, ZC_GA = 1280, ZC_GB = 2304;
constexpr float EPS = 1e-6f;
constexpr float LOG2E = 1.4426950408889634f;
constexpr float C2 = 0.125f * LOG2E;
constexpr size_t O_Y = 0, O_KP = 16908288, O_VP = 17039360, O_PP = 17170432, O_KS = 17231872, O_VS = 19329024, O_PS = 21426176;
constexpr size_t MiB = 1u << 20;
constexpr size_t WS_SUMSQ = 0;
constexpr size_t WS_SPOOL = 1 * MiB + 65536;
constexpr size_t WS_BAR = 1 * MiB, WS_BAR_BYTES = 16384;
constexpr size_t WS_WIN = 2 * MiB, WS_MIX = 9 * MiB, WS_WCAT = 10 * MiB, WS_WOUT = 12 * MiB, WS_WGU = 14 * MiB, WS_WDN = 25 * MiB;
constexpr size_t WS_RA = 32 * MiB;
constexpr size_t WS_RB = 65 * MiB;
constexpr size_t WS_YPRE = 98 * MiB;
constexpr size_t WS_Z = 115 * MiB;
constexpr size_t WS_END = 222 * MiB;
constexpr int LDS_BYTES = 147456;
constexpr int LDS_MISC = 135168;

__device__ __forceinline__ unsigned cvt_pk_bf16(float lo, float hi) { unsigned r; asm("v_cvt_pk_bf16_f32 %0, %1, %2" : "=v"(r) : "v"(lo), "v"(hi)); return r; }
__device__ __forceinline__ float bflo(unsigned u) { return __uint_as_float(u << 16); }
__device__ __forceinline__ float bfhi(unsigned u) { return __uint_as_float(u & 0xffff0000u); }
__device__ __forceinline__ float bf1(bf16_t u) { return __uint_as_float(((unsigned)u) << 16); }
__device__ __forceinline__ float fsigmoid(float x) { return __builtin_amdgcn_rcpf(1.0f + __builtin_amdgcn_exp2f(-x * LOG2E)); }
__device__ __forceinline__ float wave_sum(float v) {
#pragma unroll
    for (int o = 1; o < 64; o <<= 1) v += __shfl_xor(v, o);
    return v;
}
__device__ __forceinline__ float wave_max(float v) {
#pragma unroll
    for (int o = 1; o < 64; o <<= 1) v = fmaxf(v, __shfl_xor(v, o));
    return v;
}
#define LDS_WAIT() asm volatile("s_waitcnt lgkmcnt(0)" ::: "memory")

namespace pg8 {
constexpr int BM = 256, BK = 64, HALF = 128, HTB = HALF * BK * 2, STAGE_BYTES = 8 * HTB, NXCD = 8, WGM = 8;
__host__ __device__ __forceinline__ int lds_byte(int r, int c) { const int st = (r >> 4) * 2 + (c >> 5), rr = r & 15, cc = c & 31, ob = rr * 64 + cc * 2; return st * 1024 + (ob ^ (((ob >> 9) & 1) << 5)); }
__host__ __device__ __forceinline__ void stage_rc(int b, int& R, int& C) { const int st = b / 1024, sb = b % 1024, swz = sb ^ (((sb >> 9) & 1) << 5); R = (st >> 1) * 16 + swz / 64; C = (st & 1) * 32 + (swz % 64) / 2; }
__host__ __device__ __forceinline__ int perm32(int rho) { const int n = rho >> 4, i = rho & 15; return 8 * (i >> 2) + 4 * n + (i & 3); }

struct Unit { int pm, pn, last; };
struct Gemm { const bf16_t* A; const bf16_t* Bt; int lda, ldb, K, a_pn_bytes, midt; };

struct StaticOrder {
    int nM, nN, nwg, G, c, per, reps;
    __device__ void init(int M, int N, int G_, int c_, int reps_ = 1) { nM = M / BM; nN = N / BM; nwg = nM * nN; G = G_; c = c_; per = c < nwg ? (nwg - c + G - 1) / G : 0; reps = reps_; }
    __device__ bool next(int i, Unit& u) const {
        if (i >= per * reps) return false;
        const int pass = i / per; u.last = (pass == reps - 1);
        const long L = (long)(i - pass * per) * G + c;
        int wgid = (int)L; { const int q = nwg / NXCD, r = nwg % NXCD, xcd = wgid % NXCD, off = wgid / NXCD; wgid = (xcd < r ? xcd * (q + 1) : r * (q + 1) + (xcd - r) * q) + off; }
        const int nig = WGM * nN, gid = wgid / nig, fm = gid * WGM, gsz = (nM - fm) < WGM ? (nM - fm) : WGM;
        u.pm = fm + ((wgid % nig) % gsz); u.pn = (wgid % nig) / gsz; return true;
    }
};

template <class Epi>
__device__ __forceinline__ void gemm_phase(LAS unsigned char* lds, const Gemm g, const StaticOrder& S, const Epi& E) {
    const int tid = threadIdx.x, wid = __builtin_amdgcn_readfirstlane(tid >> 6), lane = tid & 63, wr = wid >> 2, wc = wid & 3, fr = lane & 15, fq = lane >> 4;
    const int K = g.K, nt = K / BK;
    unsigned voffA[2], voffB[2];
#pragma unroll
    for (int i = 0; i < 2; ++i) { int R, C; stage_rc(tid * 16 + i * 8192, R, C); const int Rb = (R & ~31) + perm32(R & 31);
        voffA[i] = (unsigned)(R * g.lda + C) * 2u; voffB[i] = (unsigned)(Rb * g.ldb + C) * 2u; }
    const size_t kstep = (size_t)(BK * 2);
    const size_t hstepA = (size_t)HALF * g.lda * 2, hstepB = (size_t)HALF * g.ldb * 2;
    const size_t tstepA = 2 * hstepA, tstepB = 2 * hstepB;
    const unsigned ldsw = (unsigned)wid * 1024u;
    const int aoff = lds_byte(wr * 64 + fr, fq * 8), boff = lds_byte(wc * 32 + fr, fq * 8);
#define PG8_SA(b, h) (((b) * 2 + (h)) * HTB)
#define PG8_SB(b, h) ((4 + (b) * 2 + (h)) * HTB)
#define PG8_STAGE(bufoff, gbase, voff) do { _Pragma("unroll") for (int _i = 0; _i < 2; ++_i) \
        __builtin_amdgcn_global_load_lds((const unsigned*)((const char*)(gbase) + (voff)[_i]), (LAS unsigned*)(lds + (bufoff) + ldsw + _i * 8192), 16, 0, 0); } while (0)
#define PG8_LDA(dst, b, h) do { _Pragma("unroll") for (int m = 0; m < 4; ++m) _Pragma("unroll") for (int k = 0; k < 2; ++k) dst[m][k] = *(const LAS bf16x8*)(lds + PG8_SA(b, h) + aoff + m * 2048 + k * 1024); } while (0)
#define PG8_LDB(dst, b, h) do { _Pragma("unroll") for (int n = 0; n < 2; ++n) _Pragma("unroll") for (int k = 0; k < 2; ++k) dst[n][k] = *(const LAS bf16x8*)(lds + PG8_SB(b, h) + boff + n * 2048 + k * 1024); } while (0)
#define PG8_MMA(ai, bj, At, Bt) do { __builtin_amdgcn_s_setprio(1); _Pragma("unroll") for (int m = 0; m < 4; ++m) _Pragma("unroll") for (int n = 0; n < 2; ++n) _Pragma("unroll") for (int k = 0; k < 2; ++k) \
        acc[ai][bj][m][n] = __builtin_amdgcn_mfma_f32_16x16x32_bf16(Bt[n][k], At[m][k], acc[ai][bj][m][n], 0, 0, 0); __builtin_amdgcn_s_setprio(0); } while (0)
#define PG8_WAIT_V(n) asm volatile("s_waitcnt vmcnt(" #n ")" ::: "memory")
#define PG8_WAIT_L(n) asm volatile("s_waitcnt lgkmcnt(" #n ")" ::: "memory")
#define PG8_BAR __builtin_amdgcn_s_barrier()
#define PG8_SCHED __builtin_amdgcn_sched_barrier(0)
    Unit cur, nxt; int ui = 0;
    if (!S.next(0, cur)) return;
    f32x4 acc[2][2][4][2];
#pragma unroll
    for (int a = 0; a < 2; ++a)
#pragma unroll
        for (int b = 0; b < 2; ++b)
#pragma unroll
            for (int m = 0; m < 4; ++m)
#pragma unroll
                for (int n = 0; n < 2; ++n) acc[a][b][m][n] = (f32x4){0.f, 0.f, 0.f, 0.f};
    bf16x8 At[4][2], B0[2][2], B1[2][2];
    const char* cA = (const char*)g.A + (size_t)cur.pm * tstepA + (size_t)cur.pn * g.a_pn_bytes; const char* cB = (const char*)g.Bt + (size_t)cur.pn * tstepB;
    PG8_STAGE(PG8_SB(0, 0), cB, voffB); PG8_STAGE(PG8_SB(0, 1), cB + hstepB, voffB); PG8_STAGE(PG8_SA(0, 0), cA, voffA); PG8_STAGE(PG8_SA(0, 1), cA + hstepA, voffA);
    if (wr == 1) PG8_BAR;
    PG8_WAIT_V(2); PG8_BAR;
    PG8_STAGE(PG8_SB(1, 0), cB + kstep, voffB); PG8_STAGE(PG8_SA(1, 0), cA + kstep, voffA); PG8_STAGE(PG8_SB(1, 1), cB + hstepB + kstep, voffB);
    PG8_WAIT_V(6); PG8_BAR;
    for (;;) {
        const bool has_next = S.next(ui + 1, nxt);
        const char* nA = has_next ? (const char*)g.A + (size_t)nxt.pm * tstepA + (size_t)nxt.pn * g.a_pn_bytes : cA; const char* nB = has_next ? (const char*)g.Bt + (size_t)nxt.pn * tstepB : cB;
#pragma unroll 1
        for (int t = 0; t < nt; t += 2) {
            const bool last = (t == nt - 2);
            if constexpr (Epi::HAS_MID) { if (t == g.midt) { E.mid(acc, cur, wr, wc, fr, fq); } PG8_SCHED; }
            const char* a1 = cA + (size_t)(t + 1) * kstep;
            const char* a2 = last ? nA : cA + (size_t)(t + 2) * kstep; const char* b2 = last ? nB : cB + (size_t)(t + 2) * kstep;
            const char* a3 = a2 + kstep; const char* b3 = b2 + kstep;
            PG8_LDB(B0, 0, 0); PG8_LDB(B1, 0, 1); PG8_SCHED; PG8_LDA(At, 0, 0); PG8_STAGE(PG8_SA(1, 1), a1 + hstepA, voffA);
            PG8_WAIT_V(8); PG8_WAIT_L(0); PG8_BAR; PG8_MMA(0, 0, At, B0); PG8_MMA(0, 1, At, B1); PG8_BAR; PG8_SCHED;
            PG8_LDA(At, 0, 1); PG8_STAGE(PG8_SB(0, 0), b2, voffB); PG8_STAGE(PG8_SB(0, 1), b2 + hstepB, voffB); PG8_STAGE(PG8_SA(0, 0), a2, voffA);
            PG8_WAIT_V(8); PG8_WAIT_L(0); PG8_BAR; PG8_MMA(1, 0, At, B0); PG8_MMA(1, 1, At, B1); PG8_BAR; PG8_SCHED;
            PG8_LDB(B0, 1, 0); PG8_LDB(B1, 1, 1); PG8_SCHED; PG8_LDA(At, 1, 0); PG8_STAGE(PG8_SA(0, 1), a2 + hstepA, voffA);
            PG8_WAIT_V(8); PG8_WAIT_L(0); PG8_BAR; PG8_MMA(0, 0, At, B0); PG8_MMA(0, 1, At, B1); PG8_BAR; PG8_SCHED;
            PG8_LDA(At, 1, 1); PG8_STAGE(PG8_SB(1, 0), b3, voffB); PG8_STAGE(PG8_SB(1, 1), b3 + hstepB, voffB); PG8_STAGE(PG8_SA(1, 0), a3, voffA);
            PG8_WAIT_V(8); PG8_WAIT_L(0); PG8_BAR; PG8_MMA(1, 0, At, B0); PG8_MMA(1, 1, At, B1); PG8_BAR; PG8_SCHED;
        }
        if (wr == 0) PG8_BAR;
        E(acc, cur, wr, wc, fr, fq);
        if (!has_next) break;
#pragma unroll
        for (int a = 0; a < 2; ++a)
#pragma unroll
            for (int b = 0; b < 2; ++b)
#pragma unroll
                for (int m = 0; m < 4; ++m)
#pragma unroll
                    for (int n = 0; n < 2; ++n) acc[a][b][m][n] = (f32x4){0.f, 0.f, 0.f, 0.f};
        cur = nxt; cA = nA; cB = nB; ++ui;
        if (wr == 1) PG8_BAR;
    }
    PG8_WAIT_V(0);
    PG8_BAR;
#undef PG8_SA
#undef PG8_SB
#undef PG8_STAGE
#undef PG8_LDA
#undef PG8_LDB
#undef PG8_MMA
#undef PG8_WAIT_V
#undef PG8_WAIT_L
#undef PG8_BAR
#undef PG8_SCHED
}

typedef f32x4 Acc[2][2][4][2];
__device__ __forceinline__ u32x4 pack8(const f32x4 v0, const f32x4 v1) { u32x4 w; w.x = cvt_pk_bf16(v0[0], v0[1]); w.y = cvt_pk_bf16(v0[2], v0[3]); w.z = cvt_pk_bf16(v1[0], v1[1]); w.w = cvt_pk_bf16(v1[2], v1[3]); return w; }

struct EpiZ {
    static constexpr bool HAS_MID = false;
    bf16_t* Z;
    __device__ __forceinline__ void operator()(Acc& acc, const Unit& u, int wr, int wc, int fr, int fq) const {
        int row0 = u.pm * BM + wr * 64 + fr; asm volatile("" : "+v"(row0)); const int col0 = u.pn * BM + wc * 32 + 8 * fq; const bool sig = u.pn >= 5;
#pragma unroll
        for (int ai = 0; ai < 2; ++ai)
#pragma unroll
            for (int m = 0; m < 4; ++m) { bf16_t* rowp = Z + (size_t)(row0 + ai * HALF + m * 16) * INW + col0;
                f32x4 a0 = acc[ai][0][m][0], a1 = acc[ai][0][m][1], b0 = acc[ai][1][m][0], b1 = acc[ai][1][m][1];
                if (sig) {
#pragma unroll
                    for (int e = 0; e < 4; ++e) { const float ea0 = __builtin_amdgcn_exp2f(-a0[e] * LOG2E), eb0 = __builtin_amdgcn_exp2f(-b0[e] * LOG2E), ea1 = __builtin_amdgcn_exp2f(-a1[e] * LOG2E), eb1 = __builtin_amdgcn_exp2f(-b1[e] * LOG2E);
                        a0[e] = (1.0f + eb0) * __builtin_amdgcn_rcpf(1.0f + ea0); b0[e] = __builtin_amdgcn_rcpf(1.0f + eb0);
                        a1[e] = (1.0f + eb1) * __builtin_amdgcn_rcpf(1.0f + ea1); b1[e] = __builtin_amdgcn_rcpf(1.0f + eb1); } }
                *(u32x4*)(rowp) = pack8(a0, a1); *(u32x4*)(rowp + HALF) = pack8(b0, b1); }
    }
};
struct EpiBf {
    static constexpr bool HAS_MID = false;
    bf16_t* O; int ldc;
    __device__ __forceinline__ void operator()(Acc& acc, const Unit& u, int wr, int wc, int fr, int fq) const {
        int row0 = u.pm * BM + wr * 64 + fr; asm volatile("" : "+v"(row0)); const int col0 = u.pn * BM + wc * 32 + 8 * fq;
#pragma unroll
        for (int ai = 0; ai < 2; ++ai)
#pragma unroll
            for (int m = 0; m < 4; ++m) { bf16_t* rowp = O + (size_t)(row0 + ai * HALF + m * 16) * ldc + col0;
#pragma unroll
                for (int bj = 0; bj < 2; ++bj) *(u32x4*)(rowp + bj * HALF) = pack8(acc[ai][bj][m][0], acc[ai][bj][m][1]); }
    }
};
struct EpiMerge {
    static constexpr bool HAS_MID = true;
    const bf16_t* Z; bf16_t* O;
    __device__ __forceinline__ void mid(Acc& acc, const Unit& u, int wr, int wc, int fr, int fq) const {
        int row0 = u.pm * BM + wr * 64 + fr; asm volatile("" : "+v"(row0)); const int zc0 = ZC_GA + 512 * u.pn + wc * 32 + 8 * fq;
        u32x4 gw[2][4][2];
#pragma unroll
        for (int ai = 0; ai < 2; ++ai)
#pragma unroll
            for (int m = 0; m < 4; ++m) { const bf16_t* zr = Z + (size_t)(row0 + ai * HALF + m * 16) * INW + zc0;
#pragma unroll
                for (int bj = 0; bj < 2; ++bj) gw[ai][m][bj] = *(const u32x4*)(zr + 256 * bj); }
#pragma unroll
        for (int ai = 0; ai < 2; ++ai)
#pragma unroll
            for (int m = 0; m < 4; ++m)
#pragma unroll
                for (int bj = 0; bj < 2; ++bj) { const u32x4 a = gw[ai][m][bj];
#pragma unroll
                    for (int e = 0; e < 4; ++e) { acc[ai][bj][m][e >> 1][(e & 1) * 2] *= bflo(a[e]); acc[ai][bj][m][e >> 1][(e & 1) * 2 + 1] *= bfhi(a[e]); } }
    }
    __device__ __forceinline__ void operator()(Acc& acc, const Unit& u, int wr, int wc, int fr, int fq) const {
        int row0 = u.pm * BM + wr * 64 + fr; asm volatile("" : "+v"(row0)); const int col0 = u.pn * BM + wc * 32 + 8 * fq, zc0 = ZC_GA + 512 * u.pn + wc * 32 + 8 * fq + 128;
        u32x4 gw[2][4][2];
#pragma unroll
        for (int ai = 0; ai < 2; ++ai)
#pragma unroll
            for (int m = 0; m < 4; ++m) { const bf16_t* zr = Z + (size_t)(row0 + ai * HALF + m * 16) * INW + zc0;
#pragma unroll
                for (int bj = 0; bj < 2; ++bj) gw[ai][m][bj] = *(const u32x4*)(zr + 256 * bj); }
#pragma unroll
        for (int ai = 0; ai < 2; ++ai)
#pragma unroll
            for (int m = 0; m < 4; ++m) { bf16_t* rowp = O + (size_t)(row0 + ai * HALF + m * 16) * D + col0;
#pragma unroll
                for (int bj = 0; bj < 2; ++bj) { const u32x4 b = gw[ai][m][bj]; f32x4 v0 = acc[ai][bj][m][0], v1 = acc[ai][bj][m][1];
                    v0[0] *= bflo(b[0]); v0[1] *= bfhi(b[0]); v0[2] *= bflo(b[1]); v0[3] *= bfhi(b[1]); v1[0] *= bflo(b[2]); v1[1] *= bfhi(b[2]); v1[2] *= bflo(b[3]); v1[3] *= bfhi(b[3]);
                    *(u32x4*)(rowp + bj * HALF) = pack8(v0, v1); } }
    }
};
struct EpiX1 {
    static constexpr bool HAS_MID = false;
    const float* xp; const float* xs; float* out; bf16_t* X1B; float* sumsq;
    __device__ __forceinline__ void operator()(Acc& acc, const Unit& u, int wr, int wc, int fr, int fq) const {
        if (!u.last) return;
        int row0 = u.pm * BM + wr * 64 + fr; asm volatile("" : "+v"(row0)); const int col0 = u.pn * BM + wc * 32 + 8 * fq;
#pragma unroll
        for (int ai = 0; ai < 2; ++ai) {
            f32x4 xv[4][2][2];
#pragma unroll
            for (int m = 0; m < 4; ++m) { const int row = row0 + ai * HALF + m * 16; const bool valid = row < MV;
                const float* xr = (row < MP ? xp + (size_t)row * D : xs + (size_t)(valid ? row - MP : 0) * D) + col0;
#pragma unroll
                for (int bj = 0; bj < 2; ++bj) { xv[m][bj][0] = valid ? *(const f32x4*)(xr + bj * HALF) : (f32x4){0.f, 0.f, 0.f, 0.f}; xv[m][bj][1] = valid ? *(const f32x4*)(xr + bj * HALF + 4) : (f32x4){0.f, 0.f, 0.f, 0.f}; } }
#pragma unroll
            for (int m = 0; m < 4; ++m) { const int row = row0 + ai * HALF + m * 16; float ss = 0.f;
#pragma unroll
                for (int bj = 0; bj < 2; ++bj) { const f32x4 v0 = acc[ai][bj][m][0] + xv[m][bj][0], v1 = acc[ai][bj][m][1] + xv[m][bj][1];
                    ss += (v0[0] * v0[0] + v0[1] * v0[1]) + (v0[2] * v0[2] + v0[3] * v0[3]) + (v1[0] * v1[0] + v1[1] * v1[1]) + (v1[2] * v1[2] + v1[3] * v1[3]);
                    *(u32x4*)(X1B + (size_t)row * D + col0 + bj * HALF) = pack8(v0, v1); }
                ss += __shfl_xor(ss, 16); ss += __shfl_xor(ss, 32);
                if (fq == 0) atomicAdd(sumsq + row, ss); }
            asm volatile("" ::: "memory"); }
    }
};
struct EpiAct {
    static constexpr bool HAS_MID = false;
    const float* sumsq; bf16_t* ACT;
    __device__ __forceinline__ void operator()(Acc& acc, const Unit& u, int wr, int wc, int fr, int fq) const {
        int row0 = u.pm * BM + wr * 64 + fr; asm volatile("" : "+v"(row0)); const int col0 = u.pn * HALF + wc * 32 + 8 * fq;
        float rs[2][4];
#pragma unroll
        for (int ai = 0; ai < 2; ++ai)
#pragma unroll
            for (int m = 0; m < 4; ++m) rs[ai][m] = sumsq[row0 + ai * HALF + m * 16];
#pragma unroll
        for (int ai = 0; ai < 2; ++ai)
#pragma unroll
            for (int m = 0; m < 4; ++m) { const int row = row0 + ai * HALF + m * 16; const float rstd = __builtin_amdgcn_rsqf(rs[ai][m] * (1.0f / D) + EPS);
                f32x4 o[2];
#pragma unroll
                for (int n = 0; n < 2; ++n)
#pragma unroll
                    for (int e = 0; e < 4; ++e) { const float gt = acc[ai][0][m][n][e] * rstd, up = acc[ai][1][m][n][e] * rstd; o[n][e] = gt * up * fsigmoid(gt); }
                *(u32x4*)(ACT + (size_t)row * FF + col0) = pack8(o[0], o[1]); }
    }
};
struct EpiY {
    static constexpr bool HAS_MID = false;
    const bf16_t* X1B; float* out;
    __device__ __forceinline__ void operator()(Acc& acc, const Unit& u, int wr, int wc, int fr, int fq) const {
        if (!u.last) return;
        int row0 = u.pm * BM + wr * 64 + fr; asm volatile("" : "+v"(row0)); const int col0 = u.pn * BM + wc * 32 + 8 * fq;
        u32x4 xw[2][4][2];
#pragma unroll
        for (int ai = 0; ai < 2; ++ai)
#pragma unroll
            for (int m = 0; m < 4; ++m) { const int row = row0 + ai * HALF + m * 16; const bf16_t* xr = X1B + (size_t)row * D + col0;
#pragma unroll
                for (int bj = 0; bj < 2; ++bj) xw[ai][m][bj] = *(const u32x4*)(xr + bj * HALF); }
#pragma unroll
        for (int ai = 0; ai < 2; ++ai)
#pragma unroll
            for (int m = 0; m < 4; ++m) { const int row = row0 + ai * HALF + m * 16;
                if (row < MV) { float* orow = out + (size_t)row * D + col0;
#pragma unroll
                    for (int bj = 0; bj < 2; ++bj) { const u32x4 x = xw[ai][m][bj];
                        *(f32x4*)(orow + bj * HALF) = (f32x4){bflo(x[0]), bfhi(x[0]), bflo(x[1]), bfhi(x[1])} + acc[ai][bj][m][0];
                        *(f32x4*)(orow + bj * HALF + 4) = (f32x4){bflo(x[2]), bfhi(x[2]), bflo(x[3]), bfhi(x[3])} + acc[ai][bj][m][1]; } } }
    }
};
}

struct SrcPlain { const float* W; int N; __device__ __forceinline__ float operator()(int k, int n) const { return __builtin_nontemporal_load(W + (size_t)k * N + n); } };
struct SrcWin { const float* W;
    __device__ __forceinline__ float operator()(int k, int n) const { int c = n; if (n >= ZC_GA) { const int t = (n - ZC_GA) >> 8, j = (n - ZC_GA) & 255; c = (j < 128 ? ZC_GA : ZC_GB) + 128 * t + (j & 127); } return __builtin_nontemporal_load(W + (size_t)k * INW + c); } };
struct SrcMix { const float* mix; const float* scale;
    __device__ __forceinline__ float operator()(int k, int n) const { return mix[((size_t)(n >> 7) * 128 + k) * 128 + (n & 127)] * scale[n]; } };
struct SrcCat { const float* wp; const float* wa;
    __device__ __forceinline__ float operator()(int k, int n) const { return k < 512 ? wp[(size_t)k * D + n] : wa[(size_t)(k - 512) * D + n]; } };
struct SrcGU { const float* wg; const float* wu; const float* nrm;
    __device__ __forceinline__ float operator()(int k, int n) const { const int t = n >> 8, j = n & 255, col = 128 * t + (j & 127); const float* w = (const float*)((uintptr_t)wg + (uintptr_t)(j >> 7) * ((uintptr_t)wu - (uintptr_t)wg)); return w[(size_t)k * FF + col] * nrm[k]; } };

template <class Src>
__device__ __forceinline__ void transpose_item(const Src src, bf16_t* WT, int ldk, int nblk, int item, LAS float* scr, int lane) {
    const int kb = item / nblk, nb = item % nblk, k0 = 64 * kb, n0 = 32 * nb;
    float tv[32];
#pragma unroll
    for (int i = 0; i < 32; ++i) tv[i] = src(k0 + 2 * i + (lane >> 5), n0 + (lane & 31));
#pragma unroll
    for (int i = 0; i < 32; ++i) scr[(2 * i + (lane >> 5)) * 33 + (lane & 31)] = tv[i];
    LDS_WAIT();
    const int c = lane & 7;
#pragma unroll
    for (int j = 0; j < 4; ++j) { const int n = (lane >> 3) + 8 * j; const LAS float* s = scr + (8 * c) * 33 + n;
        u32x4 o; o.x = cvt_pk_bf16(s[0 * 33], s[1 * 33]); o.y = cvt_pk_bf16(s[2 * 33], s[3 * 33]); o.z = cvt_pk_bf16(s[4 * 33], s[5 * 33]); o.w = cvt_pk_bf16(s[6 * 33], s[7 * 33]);
        *(u32x4*)(WT + (size_t)(n0 + n) * ldk + k0 + 8 * c) = o; }
    LDS_WAIT();
}

struct Args { const float* in[19]; float* out; unsigned char* ws; int ph_lo, ph_hi; };

template <int NSTEPS, class Epi>
__device__ __forceinline__ void small_gemm(LAS unsigned char* lds, const bf16_t* A, int lda, const bf16_t* Bt, int ldb, int K, int vcu, int G, const Epi& E) {
    const int tid = threadIdx.x, lane = tid & 63, wave = __builtin_amdgcn_readfirstlane(tid >> 6), fr = lane & 15, fq = lane >> 4, rh = wave & 1, ks = wave >> 1;
    const int kq = K >> 2;
    for (int u = vcu; u < 256; u += G) {
        const int r0 = 32 * (u & 3) + 16 * rh, n0 = 16 * (u >> 2);
        const bf16_t* ap = A + (size_t)(r0 + fr) * lda + ks * kq + 8 * fq; const bf16_t* bp = Bt + (size_t)(n0 + fr) * ldb + ks * kq + 8 * fq;
        f32x4 acc = (f32x4){0.f, 0.f, 0.f, 0.f};
        bf16x8 af[NSTEPS], bf[NSTEPS];
#pragma unroll
        for (int s = 0; s < NSTEPS; ++s) { af[s] = *(const bf16x8*)(ap + 32 * s); bf[s] = *(const bf16x8*)(bp + 32 * s); }
#pragma unroll
        for (int s = 0; s < NSTEPS; ++s) acc = __builtin_amdgcn_mfma_f32_16x16x32_bf16(bf[s], af[s], acc, 0, 0, 0);
        LAS f32x4* red = (LAS f32x4*)lds;
        red[(ks * 2 + rh) * 64 + lane] = acc;
        __syncthreads();
        if (ks == 0) { const f32x4 p0 = red[(0 * 2 + rh) * 64 + lane], p1 = red[(1 * 2 + rh) * 64 + lane], p2 = red[(2 * 2 + rh) * 64 + lane], p3 = red[(3 * 2 + rh) * 64 + lane];
            E(p0, p1, p2, p3, r0 + fr, n0 + 4 * fq, fq); }
        __syncthreads();
    }
}
struct SEpiMerge { const bf16_t* Z; bf16_t* O;
    __device__ __forceinline__ void operator()(f32x4 p0, f32x4 p1, f32x4 p2, f32x4 p3, int n, int c, int fq) const {
        const bf16_t* zr = Z + (size_t)(MP + n) * INW + ZC_GA + 256 * (c >> 7) + (c & 127); const u32x2 r = *(const u32x2*)zr, b = *(const u32x2*)(zr + 128);
        const f32x4 pool = p0 + p1, attn = p2 + p3;
        u32x2 w; w.x = cvt_pk_bf16(bflo(b.x) * (bflo(r.x) * pool[0] + attn[0]), bfhi(b.x) * (bfhi(r.x) * pool[1] + attn[1]));
        w.y = cvt_pk_bf16(bflo(b.y) * (bflo(r.y) * pool[2] + attn[2]), bfhi(b.y) * (bfhi(r.y) * pool[3] + attn[3]));
        *(u32x2*)(O + (size_t)(MP + n) * D + c) = w; } };
struct SEpiX1 { const float* xs; float* out; bf16_t* X1B; float* sumsq;
    __device__ __forceinline__ void operator()(f32x4 p0, f32x4 p1, f32x4 p2, f32x4 p3, int n, int c, int fq) const {
        const f32x4 v = *(const f32x4*)(xs + (size_t)n * D + c) + ((p0 + p1) + (p2 + p3));
        u32x2 w; w.x = cvt_pk_bf16(v[0], v[1]); w.y = cvt_pk_bf16(v[2], v[3]); *(u32x2*)(X1B + (size_t)(MP + n) * D + c) = w;
        float ss = (v[0] * v[0] + v[1] * v[1]) + (v[2] * v[2] + v[3] * v[3]); ss += __shfl_xor(ss, 16); ss += __shfl_xor(ss, 32);
        if (fq == 0) atomicAdd(sumsq + MP + n, ss); } };
struct SEpiY { const bf16_t* X1B; float* out;
    __device__ __forceinline__ void operator()(f32x4 p0, f32x4 p1, f32x4 p2, f32x4 p3, int n, int c, int fq) const {
        const u32x2 x = *(const u32x2*)(X1B + (size_t)(MP + n) * D + c);
        *(f32x4*)(out + (size_t)(MP + n) * D + c) = (f32x4){bflo(x.x), bfhi(x.x), bflo(x.y), bfhi(x.y)} + ((p0 + p1) + (p2 + p3)); } };

__device__ __forceinline__ int crow(int r, int hi) { return (r & 3) + 8 * (r >> 2) + 4 * hi; }
constexpr int KS_STRIDE = 144, VT_STRIDE = 520, LDS_VT = 256 * KS_STRIDE  , LDS_SMP = 131072;

__device__ __forceinline__ void attn_prompt_unit(const Args& a, LAS unsigned char* lds, int unit) {
    const int tid = threadIdx.x, lane = tid & 63, wave = __builtin_amdgcn_readfirstlane(tid >> 6);
    const int kh = unit & 1, qb = (unit >> 1) & 15, b = unit >> 5;
    const bf16_t* Z = (const bf16_t*)(a.ws + WS_Z); bf16_t* YY = (bf16_t*)(a.ws + WS_RB);
    const float* qnw = a.in[7]; const float* knw = a.in[8]; const float* sinks = a.in[9];
    const size_t rowbase = (size_t)b * SEQ; const int key0 = (qb - 1) * 128;
    const int hq = 4 * kh + (wave >> 1), ql = lane & 31, h = lane >> 5;
    u32x4 qraw[2][4];
#pragma unroll
    for (int gi = 0; gi < 2; ++gi) { const bf16_t* qp = Z + (rowbase + (size_t)qb * 128 + 32 * (2 * (wave & 1) + gi) + ql) * INW + ZC_Q + hq * 64 + 8 * h;
#pragma unroll
        for (int ds = 0; ds < 4; ++ds) qraw[gi][ds] = *(const u32x4*)(qp + 16 * ds); }
    u32x4 vraw[4];
#pragma unroll
    for (int i = 0; i < 4; ++i) { const int c = tid + 512 * i, key = c & 255, dch = c >> 8, pos = key0 + key;
        vraw[i] = (u32x4){0u, 0u, 0u, 0u};
        if (pos >= 0) vraw[i] = *(const u32x4*)(Z + (rowbase + pos) * INW + ZC_V + kh * 64 + 8 * dch); }
    {
        const int j = tid >> 1, half = tid & 1, pos = key0 + j; float v[32];
        if (pos >= 0) { const u32x4* src = (const u32x4*)(Z + (rowbase + pos) * INW + ZC_K + kh * 64 + 32 * half);
#pragma unroll
            for (int c = 0; c < 4; ++c) { const u32x4 w = src[c];
#pragma unroll
                for (int e = 0; e < 4; ++e) { v[c * 8 + 2 * e] = bflo(w[e]); v[c * 8 + 2 * e + 1] = bfhi(w[e]); } } }
        else {
#pragma unroll
            for (int i = 0; i < 32; ++i) v[i] = 0.f; }
        float ss = 0.f;
#pragma unroll
        for (int i = 0; i < 32; ++i) ss += v[i] * v[i];
        ss += __shfl_xor(ss, 1);
        const float rstd = __builtin_amdgcn_rsqf(ss * (1.0f / 64) + EPS);
#pragma unroll
        for (int c = 0; c < 8; ++c) { const f32x4 w = *(const f32x4*)(knw + 32 * half + 4 * c);
#pragma unroll
            for (int e = 0; e < 4; ++e) v[4 * c + e] = v[4 * c + e] * rstd * w[e]; }
        LAS u32x4* dst = (LAS u32x4*)(lds + j * KS_STRIDE + 64 * half);
#pragma unroll
        for (int c = 0; c < 4; ++c) { u32x4 w;
#pragma unroll
            for (int e = 0; e < 4; ++e) w[e] = cvt_pk_bf16(v[c * 8 + 2 * e], v[c * 8 + 2 * e + 1]);
            dst[c] = w; }
        if (qb == 15 && j >= 128) { float* o = a.out + O_KP + ((size_t)(b * 128 + (j - 128)) * 2 + kh) * 64 + 32 * half;
#pragma unroll
            for (int c = 0; c < 8; ++c) *(f32x4*)(o + 4 * c) = (f32x4){v[4 * c], v[4 * c + 1], v[4 * c + 2], v[4 * c + 3]}; }
    }
#pragma unroll
    for (int i = 0; i < 4; ++i) { const int c = tid + 512 * i, key = c & 255, dch = c >> 8, pos = key0 + key;
        const u32x4 w = vraw[i];
        LAS bf16_t* vt = (LAS bf16_t*)(lds + LDS_VT) + key;
#pragma unroll
        for (int e = 0; e < 4; ++e) { vt[(8 * dch + 2 * e) * (VT_STRIDE / 2)] = (bf16_t)(w[e] & 0xffffu); vt[(8 * dch + 2 * e + 1) * (VT_STRIDE / 2)] = (bf16_t)(w[e] >> 16); }
        if (qb == 15 && key >= 128) { float* o = a.out + O_VP + ((size_t)(b * 128 + (key - 128)) * 2 + kh) * 64 + 8 * dch;
            *(f32x4*)o = (f32x4){bflo(w[0]), bfhi(w[0]), bflo(w[1]), bfhi(w[1])}; *(f32x4*)(o + 4) = (f32x4){bflo(w[2]), bfhi(w[2]), bflo(w[3]), bfhi(w[3])}; } }
    __syncthreads();
    const float sink2 = sinks[hq] * LOG2E;
    f32x16 scs[2][5];
#pragma unroll
    for (int gi = 0; gi < 2; ++gi) {
        const int g = 2 * (wave & 1) + gi;
        bf16x8 qf[4];
        { float v[32];
#pragma unroll
            for (int ds = 0; ds < 4; ++ds) { const u32x4 w = qraw[gi][ds];
#pragma unroll
                for (int e = 0; e < 4; ++e) { v[ds * 8 + 2 * e] = bflo(w[e]); v[ds * 8 + 2 * e + 1] = bfhi(w[e]); } }
            float ss = 0.f;
#pragma unroll
            for (int i = 0; i < 32; ++i) ss += v[i] * v[i];
            ss += __shfl_xor(ss, 32);
            const float sc = __builtin_amdgcn_rsqf(ss * (1.0f / 64) + EPS) * C2;
#pragma unroll
            for (int ds = 0; ds < 4; ++ds) { const f32x4 w0 = *(const f32x4*)(qnw + 16 * ds + 8 * h), w1 = *(const f32x4*)(qnw + 16 * ds + 8 * h + 4); u32x4 p;
                p.x = cvt_pk_bf16(v[ds * 8 + 0] * sc * w0[0], v[ds * 8 + 1] * sc * w0[1]); p.y = cvt_pk_bf16(v[ds * 8 + 2] * sc * w0[2], v[ds * 8 + 3] * sc * w0[3]);
                p.z = cvt_pk_bf16(v[ds * 8 + 4] * sc * w1[0], v[ds * 8 + 5] * sc * w1[1]); p.w = cvt_pk_bf16(v[ds * 8 + 6] * sc * w1[2], v[ds * 8 + 7] * sc * w1[3]);
                qf[ds] = __builtin_bit_cast(bf16x8, p); } }
        __builtin_amdgcn_s_setprio(1);
#pragma unroll
        for (int i = 0; i < 5; ++i) { f32x16 acc = {};
#pragma unroll
            for (int ds = 0; ds < 4; ++ds) { const bf16x8 kf = *(const LAS bf16x8*)(lds + (32 * (g + i) + ql) * KS_STRIDE + 32 * ds + 16 * h);
                acc = __builtin_amdgcn_mfma_f32_32x32x16_bf16(kf, qf[ds], acc, 0, 0, 0); }
            scs[gi][i] = acc; }
        __builtin_amdgcn_s_setprio(0);
    }
    __builtin_amdgcn_sched_barrier(0);
#pragma unroll
    for (int gi = 0; gi < 2; ++gi) {
        const int g = 2 * (wave & 1) + gi; const size_t qrow = rowbase + (size_t)qb * 128 + 32 * g + ql;
        f32x16 (&sc)[5] = scs[gi];
        const int dsel = ql - 4 * h; float mx = -1e30f;
#pragma unroll
        for (int i = 0; i < 5; ++i) {
            if (qb == 0 && g + i < 4) {
#pragma unroll
                for (int r = 0; r < 16; ++r) sc[i][r] = -1e30f;
            } else {
#pragma unroll
                for (int r = 0; r < 16; ++r) { float s = sc[i][r];
                    if (i == 0) s = (crow(r, 0) >= dsel) ? s : -1e30f;
                    if (i == 4) s = (crow(r, 0) <= dsel) ? s : -1e30f;
                    sc[i][r] = s; mx = fmaxf(mx, s); } } }
        mx = fmaxf(mx, __shfl_xor(mx, 32));
        const float mref = fmaxf(mx, sink2); float lsum = 0.f;
#pragma unroll
        for (int i = 0; i < 5; ++i)
#pragma unroll
            for (int r = 0; r < 16; ++r) { const float p = __builtin_amdgcn_exp2f(sc[i][r] - mref); sc[i][r] = p; lsum += p; }
        lsum += __shfl_xor(lsum, 32);
        const float inv = 1.0f / (lsum + __builtin_amdgcn_exp2f(sink2 - mref));
        f32x16 o[2]; o[0] = (f32x16){}; o[1] = (f32x16){};
        __builtin_amdgcn_s_setprio(1);
#pragma unroll
        for (int i = 0; i < 5; ++i)
#pragma unroll
            for (int s2 = 0; s2 < 2; ++s2) { u32x4 pw;
#pragma unroll
                for (int e = 0; e < 4; ++e) pw[e] = cvt_pk_bf16(sc[i][8 * s2 + 2 * e], sc[i][8 * s2 + 2 * e + 1]);
                const bf16x8 pf = __builtin_bit_cast(bf16x8, pw);
#pragma unroll
                for (int dt = 0; dt < 2; ++dt) { const LAS unsigned char* vp = lds + LDS_VT + (32 * dt + ql) * VT_STRIDE + 2 * (32 * (g + i) + 16 * s2 + 4 * h);
                    const u32x2 lo = *(const LAS u32x2*)vp, hi2 = *(const LAS u32x2*)(vp + 16);
                    const u32x4 vw = (u32x4){lo.x, lo.y, hi2.x, hi2.y};
                    o[dt] = __builtin_amdgcn_mfma_f32_32x32x16_bf16(__builtin_bit_cast(bf16x8, vw), pf, o[dt], 0, 0, 0); } }
        __builtin_amdgcn_s_setprio(0);
        bf16_t* yp = YY + qrow * D + 512 + hq * 64 + 4 * h;
#pragma unroll
        for (int dt = 0; dt < 2; ++dt)
#pragma unroll
            for (int rq = 0; rq < 4; ++rq) { u32x2 w; w.x = cvt_pk_bf16(o[dt][4 * rq] * inv, o[dt][4 * rq + 1] * inv); w.y = cvt_pk_bf16(o[dt][4 * rq + 2] * inv, o[dt][4 * rq + 3] * inv);
                *(u32x2*)(yp + 32 * dt + 8 * rq) = w; }
        __builtin_amdgcn_sched_barrier(0);
    }
    __syncthreads();
}

__device__ __forceinline__ void attn_sample_unit(const Args& a, LAS unsigned char* lds, int su) {
    const int tid = threadIdx.x, lane = tid & 63, wave = __builtin_amdgcn_readfirstlane(tid >> 6);
    const int n = su >> 1, kh = su & 1;
    const float* ck = a.in[2] + (size_t)n * 16384; const float* cv = a.in[3] + (size_t)n * 16384;
    if (wave < 4) {
        const int hq = 4 * kh + wave;
        const bf16_t* zrow = (const bf16_t*)(a.ws + WS_Z) + (size_t)(MP + n) * INW; bf16_t* YY = (bf16_t*)(a.ws + WS_RB);
        LAS float* qs = (LAS float*)(lds + LDS_SMP + wave * 1024); LAS float* ps = qs + 64;
        const float xq = bf1(zrow[ZC_Q + hq * 64 + lane]); const float ssq = wave_sum(xq * xq);
        const float qn = xq * __builtin_amdgcn_rsqf(ssq * (1.0f / 64) + EPS) * a.in[7][lane] * C2;
        const float xk = bf1(zrow[ZC_K + kh * 64 + lane]); const float ssk = wave_sum(xk * xk);
        const float kn = xk * __builtin_amdgcn_rsqf(ssk * (1.0f / 64) + EPS) * a.in[8][lane];
        const float vn = bf1(zrow[ZC_V + kh * 64 + lane]);
        const float s_new = wave_sum(qn * kn);
        if (wave == 0) { a.out[O_KS + (size_t)n * 16384 + (127 * 2 + kh) * 64 + lane] = kn; a.out[O_VS + (size_t)n * 16384 + (127 * 2 + kh) * 64 + lane] = vn; }
        qs[lane] = qn; LDS_WAIT();
        float s0 = 0.f, s1 = 0.f;
        { const f32x4* k0 = (const f32x4*)(ck + (size_t)(lane * 2 + kh) * 64); const f32x4* k1 = (const f32x4*)(ck + (size_t)((lane + 64) * 2 + kh) * 64);
#pragma unroll
            for (int c = 0; c < 16; ++c) { const f32x4 q4 = *(const LAS f32x4*)(qs + 4 * c), x0 = k0[c], x1 = k1[c];
                s0 += (q4[0] * x0[0] + q4[1] * x0[1]) + (q4[2] * x0[2] + q4[3] * x0[3]); s1 += (q4[0] * x1[0] + q4[1] * x1[1]) + (q4[2] * x1[2] + q4[3] * x1[3]); } }
        const float sink2 = a.in[9][hq] * LOG2E;
        const float mref = fmaxf(fmaxf(wave_max(fmaxf(s0, s1)), s_new), sink2);
        const float p0 = __builtin_amdgcn_exp2f(s0 - mref), p1 = __builtin_amdgcn_exp2f(s1 - mref), pn = __builtin_amdgcn_exp2f(s_new - mref);
        const float l = wave_sum(p0 + p1) + pn + __builtin_amdgcn_exp2f(sink2 - mref);
        ps[lane] = p0; ps[lane + 64] = p1; LDS_WAIT();
        const int kg = lane >> 4, dc = lane & 15;
        f32x4 o = (f32x4){0.f, 0.f, 0.f, 0.f};
#pragma unroll 16
        for (int j = 0; j < 32; ++j) { const int key = 4 * j + kg; const f32x4 v = *(const f32x4*)(cv + (size_t)(key * 2 + kh) * 64 + 4 * dc); o += v * ps[key]; }
#pragma unroll
        for (int e = 0; e < 4; ++e) { o[e] += __shfl_xor(o[e], 16); o[e] += __shfl_xor(o[e], 32); }
        if (kg == 0) { const f32x4 vn4 = (f32x4){bf1(zrow[ZC_V + kh * 64 + 4 * dc]), bf1(zrow[ZC_V + kh * 64 + 4 * dc + 1]), bf1(zrow[ZC_V + kh * 64 + 4 * dc + 2]), bf1(zrow[ZC_V + kh * 64 + 4 * dc + 3])};
            const float il = 1.0f / l; const f32x4 r = (o + vn4 * pn) * il;
            u32x2 w; w.x = cvt_pk_bf16(r[0], r[1]); w.y = cvt_pk_bf16(r[2], r[3]);
            *(u32x2*)(YY + (size_t)(MP + n) * D + 512 + hq * 64 + 4 * dc) = w; }
    }
}

constexpr int PL_STRIDE = 272;
template <int W>
__device__ __forceinline__ void pool_task(const Args& a, LAS unsigned char* wl, int blk, int g, int lane) {
    const bf16_t* Z = (const bf16_t*)(a.ws + WS_Z); bf16_t* YY = (bf16_t*)(a.ws + WS_RB); const bf16_t* WM = (const bf16_t*)(a.ws + WS_MIX);
    const int r0 = 32 * blk, row = lane & 31, h = lane >> 5;
    f32x16 acc[4];
#pragma unroll
    for (int nt = 0; nt < 4; ++nt) acc[nt] = (f32x16){};
    if (r0 < MP) {
        const int t0 = r0 & (SEQ - 1), b = r0 >> 11;
#pragma unroll
        for (int it = 0; it < 12; ++it) { const int rr = 4 * it + (lane >> 4);
            if (rr < 47) { u32x4 v = (u32x4){0u, 0u, 0u, 0u};
                if (t0 > 0 || rr >= 15) v = *(const u32x4*)(Z + (size_t)(r0 - 15 + rr) * INW + 128 * g + 8 * (lane & 15));
                *(LAS u32x4*)(wl + rr * PL_STRIDE + 16 * (lane & 15)) = v; } }
        LDS_WAIT();
        const int t = t0 + row; const float rc = 1.0f / (float)min(W, t + 1);
        const bf16_t* wmp = WM + (size_t)(128 * g + row) * 128 + 8 * h;
        bf16x8 bnx[4];
#pragma unroll
        for (int nt = 0; nt < 4; ++nt) bnx[nt] = *(const bf16x8*)(wmp + (size_t)(32 * nt) * 128);
#pragma unroll 1
        for (int ks = 0; ks < 8; ++ks) {
            bf16x8 bcur[4];
#pragma unroll
            for (int nt = 0; nt < 4; ++nt) bcur[nt] = bnx[nt];
            if (ks < 7) {
#pragma unroll
                for (int nt = 0; nt < 4; ++nt) bnx[nt] = *(const bf16x8*)(wmp + (size_t)(32 * nt) * 128 + 16 * (ks + 1)); }
            const LAS unsigned char* base = wl + (15 + row) * PL_STRIDE + (16 * ks + 8 * h) * 2;
            float s[8], u[8];
            { const u32x4 x = *(const LAS u32x4*)base;
#pragma unroll
                for (int e = 0; e < 4; ++e) { u[2 * e] = bflo(x[e]); u[2 * e + 1] = bfhi(x[e]); s[2 * e] = u[2 * e]; s[2 * e + 1] = u[2 * e + 1]; } }
#pragma unroll
            for (int i = 1; i < W; ++i) { const u32x4 x = *(const LAS u32x4*)(base - i * PL_STRIDE);
#pragma unroll
                for (int e = 0; e < 4; ++e) { s[2 * e] += bflo(x[e]); s[2 * e + 1] += bfhi(x[e]); } }
            u32x4 y;
#pragma unroll
            for (int e = 0; e < 4; ++e) y[e] = cvt_pk_bf16(s[2 * e] * rc - u[2 * e], s[2 * e + 1] * rc - u[2 * e + 1]);
            const bf16x8 af = __builtin_bit_cast(bf16x8, y);
            if (t >= SEQ - 15) { float* o = a.out + O_PP + ((size_t)b * 15 + (t - (SEQ - 15))) * PW + 128 * g + 16 * ks + 8 * h;
                *(f32x4*)o = (f32x4){u[0], u[1], u[2], u[3]}; *(f32x4*)(o + 4) = (f32x4){u[4], u[5], u[6], u[7]}; }
#pragma unroll
            for (int nt = 0; nt < 4; ++nt) acc[nt] = __builtin_amdgcn_mfma_f32_32x32x16_bf16(af, bcur[nt], acc[nt], 0, 0, 0);
        }
    } else {
        const int n = r0 - MP + row; const float* sp = (const float*)(a.ws + WS_SPOOL) + (size_t)n * PW; float* po = a.out + O_PS + (size_t)n * 15 * PW; const float rc = 1.0f / (float)W;
        const int cb = 128 * g + 8 * h;
        u32x4 xn = *(const u32x4*)(Z + (size_t)(MP + n) * INW + cb); f32x4 s0n = *(const f32x4*)(sp + cb), s1n = *(const f32x4*)(sp + cb + 4);
#pragma unroll 1
        for (int ks = 0; ks < 8; ++ks) {
            const int c0 = cb + 16 * ks;
            float s[8], u[8];
            { const u32x4 x = xn; const f32x4 s0 = s0n, s1 = s1n;
                if (ks < 7) { xn = *(const u32x4*)(Z + (size_t)(MP + n) * INW + c0 + 16); s0n = *(const f32x4*)(sp + c0 + 16); s1n = *(const f32x4*)(sp + c0 + 20); }
#pragma unroll
                for (int e = 0; e < 4; ++e) { u[2 * e] = bflo(x[e]); u[2 * e + 1] = bfhi(x[e]); }
#pragma unroll
                for (int e = 0; e < 4; ++e) { s[e] = u[e] + s0[e]; s[4 + e] = u[4 + e] + s1[e]; } }
            *(f32x4*)(po + 14 * PW + c0) = (f32x4){u[0], u[1], u[2], u[3]}; *(f32x4*)(po + 14 * PW + c0 + 4) = (f32x4){u[4], u[5], u[6], u[7]};
            u32x4 y;
#pragma unroll
            for (int e = 0; e < 4; ++e) y[e] = cvt_pk_bf16(s[2 * e] * rc - u[2 * e], s[2 * e + 1] * rc - u[2 * e + 1]);
            const bf16x8 af = __builtin_bit_cast(bf16x8, y);
#pragma unroll
            for (int nt = 0; nt < 4; ++nt) { const bf16x8 bfr = *(const bf16x8*)(WM + (size_t)(128 * g + 32 * nt + row) * 128 + 16 * ks + 8 * h);
                acc[nt] = __builtin_amdgcn_mfma_f32_32x32x16_bf16(af, bfr, acc[nt], 0, 0, 0); }
        }
    }
#pragma unroll
    for (int nt = 0; nt < 4; ++nt)
#pragma unroll
        for (int r = 0; r < 16; ++r) YY[(size_t)(r0 + crow(r, h)) * D + 128 * g + 32 * nt + row] = (bf16_t)(cvt_pk_bf16(acc[nt][r], 0.f) & 0xffffu);
    LDS_WAIT();
}
__device__ __forceinline__ void pool_one(const Args& a, LAS unsigned char* wl, int blk, int g, int lane) {
    if (g == 0) pool_task<2>(a, wl, blk, 0, lane); else if (g == 1) pool_task<4>(a, wl, blk, 1, lane); else if (g == 2) pool_task<8>(a, wl, blk, 2, lane); else pool_task<16>(a, wl, blk, 3, lane);
}
__device__ __forceinline__ void roll_copies(const Args& a, int gtid, int gthreads) {
    { const f32x4* src = (const f32x4*)a.in[4]; f32x4* dst = (f32x4*)(a.out + O_PS);
        for (int i0 = gtid; i0 < NS * 1792; i0 += 2 * gthreads) { const int i1 = i0 + gthreads; const bool two = i1 < NS * 1792;
            const int n0 = i0 / 1792, j0 = i0 - n0 * 1792, n1 = two ? i1 / 1792 : 0, j1 = two ? i1 - n1 * 1792 : 0;
            const f32x4 v0 = src[(size_t)n0 * 1920 + 128 + j0], v1 = src[(size_t)n1 * 1920 + 128 + j1];
            dst[(size_t)n0 * 1920 + j0] = v0; if (two) dst[(size_t)n1 * 1920 + j1] = v1; } }
    { const f32x4* src = (const f32x4*)a.in[4]; f32x4* S4 = (f32x4*)(a.ws + WS_SPOOL);
        for (int i = gtid; i < NS * 128; i += gthreads) { const int n = i >> 7, c4 = i & 127, W = 2 << (c4 >> 5); f32x4 acc = (f32x4){0.f, 0.f, 0.f, 0.f};
#pragma unroll
            for (int k = 1; k < 16; ++k) { if (k < W) acc += src[(size_t)(n * 15 + 15 - k) * 128 + c4]; }
            S4[(size_t)n * 128 + c4] = acc; } }
    { const f32x4* sk = (const f32x4*)a.in[2]; const f32x4* sv = (const f32x4*)a.in[3]; f32x4* dk = (f32x4*)(a.out + O_KS); f32x4* dv = (f32x4*)(a.out + O_VS);
        constexpr int PER = 127 * 32;
        for (int i0 = gtid; i0 < NS * PER; i0 += 2 * gthreads) { const int i1 = i0 + gthreads; const bool two = i1 < NS * PER;
            const int n0 = i0 / PER, j0 = i0 - n0 * PER, n1 = two ? i1 / PER : 0, j1 = two ? i1 - n1 * PER : 0;
            const f32x4 k0 = sk[(size_t)n0 * 4096 + 32 + j0], k1 = sk[(size_t)n1 * 4096 + 32 + j1], v0 = sv[(size_t)n0 * 4096 + 32 + j0], v1 = sv[(size_t)n1 * 4096 + 32 + j1];
            dk[(size_t)n0 * 4096 + j0] = k0; dv[(size_t)n0 * 4096 + j0] = v0; if (two) { dk[(size_t)n1 * 4096 + j1] = k1; dv[(size_t)n1 * 4096 + j1] = v1; } } }
}

#define XB_TMO      128
#define XB_XCNT(j)  (256  + 64 * (j))
#define XB_XSUB(j)  (1280 + 64 * (j))
#define XB_XGEN(j)  (2304 + 64 * (j))
#define XB_TOP      3328
#define XB_TOPGEN   3392
#define XCD_BAR_WORDS 3456
#define XB_SPIN_CAP (1u << 18)
__device__ __forceinline__ unsigned xb_ld(unsigned* p)              { return __hip_atomic_load(p, __ATOMIC_RELAXED, __HIP_MEMORY_SCOPE_AGENT); }
__device__ __forceinline__ unsigned xb_add(unsigned* p, unsigned v) { return __hip_atomic_fetch_add(p, v, __ATOMIC_RELAXED, __HIP_MEMORY_SCOPE_AGENT); }
__device__ __forceinline__ unsigned xb_xcc_id() { return (unsigned)__builtin_amdgcn_s_getreg((3 << 11) | 20) & 0xFu; }
#define XB_SPIN(cond, bar) do { unsigned _sp = 0; while (cond) { __builtin_amdgcn_s_sleep(1); \
    if ((++_sp & 255u) == 0u) { if (xb_ld(&(bar)[XB_TMO])) break; if (_sp > XB_SPIN_CAP) { atomicAdd(&(bar)[XB_TMO], 1u); break; } } } } while (0)
struct XcdBarrier { unsigned* bar; unsigned x; volatile LAS unsigned* st; };
__device__ __forceinline__ XcdBarrier xcd_barrier_post(unsigned* bar, volatile LAS unsigned* st) {
    XcdBarrier b; b.bar = bar; b.x = xb_xcc_id(); b.st = st;
    if (threadIdx.x == 0) (void)xb_add(&bar[XB_XCNT(b.x)], 1u);
    return b;
}
__device__ __forceinline__ void xcd_barrier_complete(unsigned* bar, unsigned x, unsigned& nloc, unsigned& nx) {
    const unsigned G = gridDim.x * gridDim.y * gridDim.z;
    unsigned sum, cnt, mine, sp = 0u;
    for (;;) {
        sum = 0u; cnt = 0u; mine = 0u;
#pragma unroll
        for (unsigned j = 0; j < 16; ++j) { const unsigned c = xb_ld(&bar[XB_XCNT(j)]); sum += c; cnt += (c > 0u) ? 1u : 0u; mine = (j == x) ? c : mine; }
        if (sum == G) break;
        __builtin_amdgcn_s_sleep(1);
        if ((++sp & 255u) == 0u) { if (xb_ld(&bar[XB_TMO])) break; if (sp > XB_SPIN_CAP) { atomicAdd(&bar[XB_TMO], 1u); break; } }
    }
    nloc = mine > 0u ? mine : 1u; nx = cnt > 0u ? cnt : 1u;
}
__device__ __forceinline__ void xcd_barrier(const XcdBarrier& b) {
    asm volatile("s_waitcnt vmcnt(0)" ::: "memory");
    __syncthreads();
    if (threadIdx.x == 0) {
        unsigned* bar = b.bar;
        __builtin_amdgcn_s_waitcnt(0);
        unsigned nloc = b.st[0], nx = b.st[1];
        if (nloc == 0u) { xcd_barrier_complete(bar, b.x, nloc, nx); b.st[0] = nloc; b.st[1] = nx; }
        const unsigned old = xb_add(&bar[XB_XSUB(b.x)], 1u);
        const unsigned gen = old / nloc;
        if (old + 1u == (gen + 1u) * nloc) {
            __builtin_amdgcn_fence(__ATOMIC_RELEASE, "agent");
            asm volatile("s_waitcnt vmcnt(0)" ::: "memory");
            const unsigned og = xb_add(&bar[XB_TOP], 1u);
            const unsigned tg = og / nx;
            if (og + 1u == (tg + 1u) * nx) xb_add(&bar[XB_TOPGEN], 1u);
            else XB_SPIN(xb_ld(&bar[XB_TOPGEN]) == tg, bar);
            __builtin_amdgcn_fence(__ATOMIC_ACQUIRE, "agent");
            xb_add(&bar[XB_XGEN(b.x)], 1u);
            asm volatile("s_waitcnt vmcnt(0)" ::: "memory");
        } else {
            XB_SPIN(xb_ld(&bar[XB_XGEN(b.x)]) == gen, bar);
            __builtin_amdgcn_fence(__ATOMIC_ACQUIRE, "agent");
            asm volatile("s_waitcnt vmcnt(0)" ::: "memory");
        }
    }
    __syncthreads();
}

__global__ void __launch_bounds__(512, 2) fwd_megakernel(Args a) {
    extern __shared__ __attribute__((aligned(16))) unsigned char lds_raw[];
    LAS unsigned char* lds = (LAS unsigned char*)lds_raw;
    const int tid = threadIdx.x, lane = tid & 63, wave = __builtin_amdgcn_readfirstlane(tid >> 6);
    const int G = gridDim.x, bx = blockIdx.x;
    const int vcu = (G % 8 == 0) ? (bx % 8) * (G / 8) + bx / 8 : bx;
    unsigned char* ws = a.ws;
    bf16_t* WIN = (bf16_t*)(ws + WS_WIN); bf16_t* WMIX = (bf16_t*)(ws + WS_MIX); bf16_t* WCAT = (bf16_t*)(ws + WS_WCAT); bf16_t* WOUT = (bf16_t*)(ws + WS_WOUT);
    bf16_t* WGU = (bf16_t*)(ws + WS_WGU); bf16_t* WDN = (bf16_t*)(ws + WS_WDN);
    bf16_t* RA = (bf16_t*)(ws + WS_RA); bf16_t* RB = (bf16_t*)(ws + WS_RB); bf16_t* Z = (bf16_t*)(ws + WS_Z);
    float* SUMSQ = (float*)(ws + WS_SUMSQ);
    const int lo = a.ph_lo, hi = a.ph_hi;
    if (tid < 2) ((volatile LAS unsigned*)(lds + LDS_MISC))[tid] = 0u;
    __syncthreads();
    if (AMP_PHASE >= 0 && tid == 0) *(volatile LAS unsigned long long*)(lds + LDS_MISC + 16) = __builtin_amdgcn_s_memrealtime();
    XcdBarrier xbar = xcd_barrier_post((unsigned*)(ws + WS_BAR), (volatile LAS unsigned*)(lds + LDS_MISC));
#ifndef PH_MASK
#define PH_MASK 255
#endif
#define IN(k) (((PH_MASK >> (k)) & 1) && lo <= (k) && (k) < hi)
#ifndef DUP_MASK
#define DUP_MASK 0
#endif
#ifndef SMALL_REP
#define SMALL_REP 0
#endif
#ifndef EXTRA_SYNCS
#define EXTRA_SYNCS 0
#endif
#define REP(k) for (int rep_ = 0; rep_ < 1 + ((DUP_MASK >> (k)) & 1); ++rep_)
#define LASTREP(k) (rep_ == ((DUP_MASK >> (k)) & 1))
#define AMP(k) do { if (AMP_PHASE >= 0 && bx == 0) { volatile LAS unsigned long long* tp_ = (volatile LAS unsigned long long*)(lds + LDS_MISC + 16); const unsigned long long now_ = __builtin_amdgcn_s_memrealtime(); \
        if ((k) == AMP_PHASE || AMP_PHASE == 99) { const unsigned long long dt_ = now_ - tp_[0]; while (__builtin_amdgcn_s_memrealtime() - now_ < dt_) __builtin_amdgcn_s_sleep(8); } \
        __syncthreads(); if (tid == 0) tp_[0] = __builtin_amdgcn_s_memrealtime(); __syncthreads(); } } while (0)
#define SEAM(k) do { if (IN(k) && IN((k) + 1)) { xcd_barrier(xbar); for (int xs_ = 0; xs_ < EXTRA_SYNCS; ++xs_) xcd_barrier(xbar); AMP(k); } } while (0)

    if (IN(0)) REP(0) {
        LAS float* scr = (LAS float*)(lds + wave * 16384);
        const int gw = vcu * 8 + wave, NGW = G * 8;
        constexpr int I_IN = 16 * 104, I_MIX = 2 * 16;
        for (int it = gw; it < I_IN + I_MIX; it += NGW) {
            if (it < I_IN) transpose_item(SrcWin{a.in[6]}, WIN, D, 104, it, scr, lane);
            else transpose_item(SrcMix{a.in[10], a.in[11]}, WMIX, 128, 16, it - I_IN, scr, lane);
        }
        const float* g1 = a.in[5];
        constexpr int RPI = 4;
        for (int m0 = gw; m0 < MPAD; m0 += RPI * NGW) {
            f32x4 v[RPI][4];
#pragma unroll
            for (int q = 0; q < RPI; ++q) { const int m = m0 + q * NGW;
                if (m < MV) { const f32x4* xr = (const f32x4*)(m < MP ? a.in[0] + (size_t)m * D : a.in[1] + (size_t)(m - MP) * D) + lane;
#pragma unroll
                    for (int j = 0; j < 4; ++j) v[q][j] = __builtin_nontemporal_load(xr + 64 * j); }
                else {
#pragma unroll
                    for (int j = 0; j < 4; ++j) v[q][j] = (f32x4){0.f, 0.f, 0.f, 0.f}; } }
            f32x4 gg[4];
#pragma unroll
            for (int j = 0; j < 4; ++j) gg[j] = ((const f32x4*)g1)[lane + 64 * j];
#pragma unroll
            for (int q = 0; q < RPI; ++q) { const int m = m0 + q * NGW;
                if (m < MPAD) { float sq = 0.f;
#pragma unroll
                    for (int j = 0; j < 4; ++j) sq += (v[q][j].x * v[q][j].x + v[q][j].y * v[q][j].y) + (v[q][j].z * v[q][j].z + v[q][j].w * v[q][j].w);
                    const float rstd = __builtin_amdgcn_rsqf(wave_sum(sq) * (1.f / D) + EPS);
                    unsigned long long* o8 = (unsigned long long*)(RA + (size_t)m * D) + lane;
#pragma unroll
                    for (int j = 0; j < 4; ++j)
                        o8[64 * j] = (unsigned long long)cvt_pk_bf16(v[q][j].x * rstd * gg[j].x, v[q][j].y * rstd * gg[j].y) | ((unsigned long long)cvt_pk_bf16(v[q][j].z * rstd * gg[j].z, v[q][j].w * rstd * gg[j].w) << 32);
                    if (m >= MV) { unsigned long long* y8 = (unsigned long long*)(RB + (size_t)m * D) + lane;
#pragma unroll
                        for (int j = 0; j < 4; ++j) y8[64 * j] = 0ull; } } }
        }
        for (int i = vcu * 512 + tid; i < MPAD; i += G * 512) SUMSQ[i] = 0.f;
    }
    SEAM(0);
    if (IN(1)) {
        pg8::Gemm g{RA, WIN, D, D, D, 0, -1}; pg8::StaticOrder S; S.init(MPAD, INW, G, bx, 1 + ((DUP_MASK >> 1) & 1));
        pg8::gemm_phase(lds, g, S, pg8::EpiZ{Z});
        { const int maxper = (S.nwg + G - 1) / G, rem = S.nwg - (maxper - 1) * G; const bool all = rem >= G; const int nid = all ? G : G - rem, rk = all ? bx : bx - rem;
            if (rk >= 0) { LAS float* scr = (LAS float*)(lds + wave * 16384);
                constexpr int I_CAT = 16 * 32, I_OUT = 16 * 32, I_GU = 16 * 176, I_DN = 44 * 32;
                for (int it = rk * 8 + wave; it < I_CAT + I_OUT + I_GU + I_DN; it += nid * 8) {
                    int r = it;
                    if (r < I_CAT) { transpose_item(SrcCat{a.in[12], a.in[13]}, WCAT, D, 32, r, scr, lane); continue; } r -= I_CAT;
                    if (r < I_OUT) { transpose_item(SrcPlain{a.in[14], D}, WOUT, D, 32, r, scr, lane); continue; } r -= I_OUT;
                    if (r < I_GU) { transpose_item(SrcGU{a.in[16], a.in[17], a.in[15]}, WGU, D, 176, r, scr, lane); continue; } r -= I_GU;
                    transpose_item(SrcPlain{a.in[18], D}, WDN, FF, 32, r, scr, lane);
                }
                roll_copies(a, rk * 512 + tid, nid * 512); } }
    }
    SEAM(1);
    if (IN(2)) REP(2) {
        for (int u = vcu; u < 256; u += G) attn_prompt_unit(a, lds, u);
        if (wave < 4) { for (int su = vcu; su < 2 * NS; su += G) attn_sample_unit(a, lds, su); }
        for (int bb = 2 * vcu; bb < MP / 32; bb += 2 * G) {
            const int blk = bb + (wave & 1), g = wave < 4 ? (wave >> 1) : 2 + ((wave - 4) >> 1);
            pool_one(a, lds + wave * 16384, blk, g, lane);
        }
        if (wave == 4) { for (int lt = vcu; lt < (NS / 32) * 4; lt += G) pool_one(a, lds + wave * 16384, MP / 32 + (lt >> 2), lt & 3, lane); }
    }
    SEAM(2);
    if (IN(4)) {
        pg8::Gemm g{RB, WCAT, D, D, D, 0, 8}; pg8::StaticOrder S; S.init(MP, D, G, bx, 1 + ((DUP_MASK >> 4) & 1));
        pg8::gemm_phase(lds, g, S, pg8::EpiMerge{Z, RA});

        for (int sr_ = 0; sr_ < 1 + SMALL_REP; ++sr_) small_gemm<8>(lds, RB + (size_t)MP * D, D, WCAT, D, D, vcu, G, SEpiMerge{Z, RA});    }
    SEAM(4);
    if (IN(5)) {
        pg8::Gemm g{RA, WOUT, D, D, D, 0, -1}; pg8::StaticOrder S; S.init(MP, D, G, bx, 1 + ((DUP_MASK >> 5) & 1));
        pg8::gemm_phase(lds, g, S, pg8::EpiX1{a.in[0], a.in[1], a.out + O_Y, RB, SUMSQ});

        small_gemm<8>(lds, RA + (size_t)MP * D, D, WOUT, D, D, vcu, G, SEpiX1{a.in[1], a.out + O_Y, RB, SUMSQ});    }
    SEAM(5);
    if (IN(6)) {
        pg8::Gemm g{RB, WGU, D, D, D, 0, -1}; pg8::StaticOrder S; S.init(MPAD, 2 * FF, G, bx, 1 + ((DUP_MASK >> 6) & 1));
        pg8::gemm_phase(lds, g, S, pg8::EpiAct{SUMSQ, Z});
    }
    SEAM(6);
    if (IN(7)) {
        pg8::Gemm g{Z, WDN, FF, FF, FF, 0, -1}; pg8::StaticOrder S; S.init(MP, D, G, bx, 1 + ((DUP_MASK >> 7) & 1));
        pg8::gemm_phase(lds, g, S, pg8::EpiY{RB, a.out + O_Y});

        small_gemm<22>(lds, Z + (size_t)MP * FF, FF, WDN, FF, FF, vcu, G, SEpiY{RB, a.out + O_Y});    }
    if (AMP_PHASE == 7 || AMP_PHASE == 99) { asm volatile("s_waitcnt vmcnt(0)" ::: "memory"); __syncthreads(); AMP(7); }
#undef IN
#undef SEAM
}

#ifndef MK_N_LAUNCHES
#define MK_N_LAUNCHES 1
#endif
extern "C" void kernel_launch(void* const* d_in, const int* in_sizes, int n_in, void* d_out, int out_size, void* d_ws, size_t ws_size, hipStream_t stream) {
    static int grid = 0;
    if (grid == 0) {
        int dev = 0, cus = 0, per_cu = 0;
        if (n_in != 19 || ws_size < WS_END) { fprintf(stderr, "kernel_launch: unexpected inputs (n_in %d, ws %zu)\n", n_in, ws_size); grid = -1; return; }
        hipGetDevice(&dev); hipDeviceGetAttribute(&cus, hipDeviceAttributeMultiprocessorCount, dev);
        if (hipFuncSetAttribute((const void*)fwd_megakernel, hipFuncAttributeMaxDynamicSharedMemorySize, LDS_BYTES) != hipSuccess) { fprintf(stderr, "kernel_launch: hipFuncSetAttribute failed\n"); grid = -1; return; }
        if (hipOccupancyMaxActiveBlocksPerMultiprocessor(&per_cu, (const void*)fwd_megakernel, 512, LDS_BYTES) != hipSuccess || per_cu < 1) { fprintf(stderr, "kernel_launch: occupancy query says %d\n", per_cu); per_cu = 1; }
        (void)hipGetLastError();
        grid = cus * 1;
        if (per_cu < 1) grid = -1;
    }
    if (grid < 0) return;
    if (hipMemsetAsync((char*)d_ws + WS_BAR, 0, WS_BAR_BYTES, stream) != hipSuccess) { fprintf(stderr, "kernel_launch: memset failed\n"); return; }
    Args a{};
    for (int i = 0; i < 19; ++i) a.in[i] = (const float*)d_in[i];
    a.out = (float*)d_out; a.ws = (unsigned char*)d_ws;
#if MK_N_LAUNCHES == 1
    a.ph_lo = 0; a.ph_hi = 8;
    hipLaunchKernelGGL(fwd_megakernel, dim3(grid), dim3(512), LDS_BYTES, stream, a);
    if (hipPeekAtLastError() != hipSuccess) fprintf(stderr, "kernel_launch: launch failed (grid %d)\n", grid);
#else
    for (int p = 0; p < 8; ++p) { a.ph_lo = p; a.ph_hi = p + 1; hipLaunchKernelGGL(fwd_megakernel, dim3(grid), dim3(512), LDS_BYTES, stream, a); }
#endif
}
```

```cpp
#include <hip/hip_runtime.h>
#include <hip/hip_cooperative_groups.h>
#include <cstdio>
#include <cstdint>
namespace cg = cooperative_groups;

#define LAS __attribute__((address_space(3)))
#ifndef AMP_PHASE
#define AMP_PHASE -1
#endif
typedef unsigned short bf16_t;
typedef short bf16x8 __attribute__((ext_vector_type(8)));
typedef short s16x4 __attribute__((ext_vector_type(4)));
typedef float f32x4 __attribute__((ext_vector_type(4)));
typedef float f32x16 __attribute__((ext_vector_type(16)));
typedef unsigned u32x4 __attribute__((ext_vector_type(4)));
typedef unsigned u32x2 __attribute__((ext_vector_type(2)));

constexpr int D = 1024, SEQ = 2048, NB = 8, MP = NB * SEQ, NS = 128, MV = MP + NS, MPAD = 16640;
constexpr int INW = 3328, FF = 2816, PW = 512;
constexpr int ZC_Q = 512, ZC_K = 1024, ZC_V = 1152, ZC_GA = 1280, ZC_GB = 2304;
constexpr float EPS = 1e-6f;
constexpr float LOG2E = 1.4426950408889634f;
constexpr float C2 = 0.125f * LOG2E;
constexpr size_t O_Y = 0, O_KP = 16908288, O_VP = 17039360, O_PP = 17170432, O_KS = 17231872, O_VS = 19329024, O_PS = 21426176;
constexpr size_t MiB = 1u << 20;
constexpr size_t WS_SUMSQ = 0;
constexpr size_t WS_SPOOL = 1 * MiB + 65536;
constexpr size_t WS_BAR = 1 * MiB, WS_BAR_BYTES = 16384;
constexpr size_t WS_WIN = 2 * MiB, WS_MIX = 9 * MiB, WS_WCAT = 10 * MiB, WS_WOUT = 12 * MiB, WS_WGU = 14 * MiB, WS_WDN = 25 * MiB;
constexpr size_t WS_RA = 32 * MiB;
constexpr size_t WS_RB = 65 * MiB;
constexpr size_t WS_YPRE = 98 * MiB;
constexpr size_t WS_Z = 115 * MiB;
constexpr size_t WS_END = 222 * MiB;
constexpr int LDS_BYTES = 147456;
constexpr int LDS_MISC = 135168;

__device__ __forceinline__ unsigned cvt_pk_bf16(float lo, float hi) { unsigned r; asm("v_cvt_pk_bf16_f32 %0, %1, %2" : "=v"(r) : "v"(lo), "v"(hi)); return r; }
__device__ __forceinline__ float bflo(unsigned u) { return __uint_as_float(u << 16); }
__device__ __forceinline__ float bfhi(unsigned u) { return __uint_as_float(u & 0xffff0000u); }
__device__ __forceinline__ float bf1(bf16_t u) { return __uint_as_float(((unsigned)u) << 16); }
__device__ __forceinline__ float fsigmoid(float x) { return __builtin_amdgcn_rcpf(1.0f + __builtin_amdgcn_exp2f(-x * LOG2E)); }
__device__ __forceinline__ float wave_sum(float v) {
#pragma unroll
    for (int o = 1; o < 64; o <<= 1) v += __shfl_xor(v, o);
    return v;
}
__device__ __forceinline__ float wave_max(float v) {
#pragma unroll
    for (int o = 1; o < 64; o <<= 1) v = fmaxf(v, __shfl_xor(v, o));
    return v;
}
#define LDS_WAIT() asm volatile("s_waitcnt lgkmcnt(0)" ::: "memory")

namespace pg8 {
constexpr int BM = 256, BK = 64, HALF = 128, HTB = HALF * BK * 2, STAGE_BYTES = 8 * HTB, NXCD = 8, WGM = 8;
__host__ __device__ __forceinline__ int lds_byte(int r, int c) { const int st = (r >> 4) * 2 + (c >> 5), rr = r & 15, cc = c & 31, ob = rr * 64 + cc * 2; return st * 1024 + (ob ^ (((ob >> 9) & 1) << 5)); }
__host__ __device__ __forceinline__ void stage_rc(int b, int& R, int& C) { const int st = b / 1024, sb = b % 1024, swz = sb ^ (((sb >> 9) & 1) << 5); R = (st >> 1) * 16 + swz / 64; C = (st & 1) * 32 + (swz % 64) / 2; }
__host__ __device__ __forceinline__ int perm32(int rho) { const int n = rho >> 4, i = rho & 15; return 8 * (i >> 2) + 4 * n + (i & 3); }

struct Unit { int pm, pn, last; };
struct Gemm { const bf16_t* A; const bf16_t* Bt; int lda, ldb, K, a_pn_bytes, midt; };

struct StaticOrder {
    int nM, nN, nwg, G, c, per, reps;
    __device__ void init(int M, int N, int G_, int c_, int reps_ = 1) { nM = M / BM; nN = N / BM; nwg = nM * nN; G = G_; c = c_; per = c < nwg ? (nwg - c + G - 1) / G : 0; reps = reps_; }
    __device__ bool next(int i, Unit& u) const {
        if (i >= per * reps) return false;
        const int pass = i / per; u.last = (pass == reps - 1);
        const long L = (long)(i - pass * per) * G + c;
        int wgid = (int)L; { const int q = nwg / NXCD, r = nwg % NXCD, xcd = wgid % NXCD, off = wgid / NXCD; wgid = (xcd < r ? xcd * (q + 1) : r * (q + 1) + (xcd - r) * q) + off; }
        const int nig = WGM * nN, gid = wgid / nig, fm = gid * WGM, gsz = (nM - fm) < WGM ? (nM - fm) : WGM;
        u.pm = fm + ((wgid % nig) % gsz); u.pn = (wgid % nig) / gsz; return true;
    }
};

template <class Epi>
__device__ __forceinline__ void gemm_phase(LAS unsigned char* lds, const Gemm g, const StaticOrder& S, const Epi& E) {
    const int tid = threadIdx.x, wid = __builtin_amdgcn_readfirstlane(tid >> 6), lane = tid & 63, wr = wid >> 2, wc = wid & 3, fr = lane & 15, fq = lane >> 4;
    const int K = g.K, nt = K / BK;
    unsigned voffA[2], voffB[2];
#pragma unroll
    for (int i = 0; i < 2; ++i) { int R, C; stage_rc(tid * 16 + i * 8192, R, C); const int Rb = (R & ~31) + perm32(R & 31);
        voffA[i] = (unsigned)(R * g.lda + C) * 2u; voffB[i] = (unsigned)(Rb * g.ldb + C) * 2u; }
    const size_t kstep = (size_t)(BK * 2);
    const size_t hstepA = (size_t)HALF * g.lda * 2, hstepB = (size_t)HALF * g.ldb * 2;
    const size_t tstepA = 2 * hstepA, tstepB = 2 * hstepB;
    const unsigned ldsw = (unsigned)wid * 1024u;
    const int aoff = lds_byte(wr * 64 + fr, fq * 8), boff = lds_byte(wc * 32 + fr, fq * 8);
#define PG8_SA(b, h) (((b) * 2 + (h)) * HTB)
#define PG8_SB(b, h) ((4 + (b) * 2 + (h)) * HTB)
#define PG8_STAGE(bufoff, gbase, voff) do { _Pragma("unroll") for (int _i = 0; _i < 2; ++_i) \
        __builtin_amdgcn_global_load_lds((const unsigned*)((const char*)(gbase) + (voff)[_i]), (LAS unsigned*)(lds + (bufoff) + ldsw + _i * 8192), 16, 0, 0); } while (0)
#define PG8_LDA(dst, b, h) do { _Pragma("unroll") for (int m = 0; m < 4; ++m) _Pragma("unroll") for (int k = 0; k < 2; ++k) dst[m][k] = *(const LAS bf16x8*)(lds + PG8_SA(b, h) + aoff + m * 2048 + k * 1024); } while (0)
#define PG8_LDB(dst, b, h) do { _Pragma("unroll") for (int n = 0; n < 2; ++n) _Pragma("unroll") for (int k = 0; k < 2; ++k) dst[n][k] = *(const LAS bf16x8*)(lds + PG8_SB(b, h) + boff + n * 2048 + k * 1024); } while (0)
#define PG8_MMA(ai, bj, At, Bt) do { __builtin_amdgcn_s_setprio(1); _Pragma("unroll") for (int m = 0; m < 4; ++m) _Pragma("unroll") for (int n = 0; n < 2; ++n) _Pragma("unroll") for (int k = 0; k < 2; ++k) \
        acc[ai][bj][m][n] = __builtin_amdgcn_mfma_f32_16x16x32_bf16(Bt[n][k], At[m][k], acc[ai][bj][m][n], 0, 0, 0); __builtin_amdgcn_s_setprio(0); } while (0)
#define PG8_WAIT_V(n) asm volatile("s_waitcnt vmcnt(" #n ")" ::: "memory")
#define PG8_WAIT_L(n) asm volatile("s_waitcnt lgkmcnt(" #n ")" ::: "memory")
#define PG8_BAR __builtin_amdgcn_s_barrier()
#define PG8_SCHED __builtin_amdgcn_sched_barrier(0)
    Unit cur, nxt; int ui = 0;
    if (!S.next(0, cur)) return;
    f32x4 acc[2][2][4][2];
#pragma unroll
    for (int a = 0; a < 2; ++a)
#pragma unroll
        for (int b = 0; b < 2; ++b)
#pragma unroll
            for (int m = 0; m < 4; ++m)
#pragma unroll
                for (int n = 0; n < 2; ++n) acc[a][b][m][n] = (f32x4){0.f, 0.f, 0.f, 0.f};
    bf16x8 At[4][2], B0[2][2], B1[2][2];
    const char* cA = (const char*)g.A + (size_t)cur.pm * tstepA + (size_t)cur.pn * g.a_pn_bytes; const char* cB = (const char*)g.Bt + (size_t)cur.pn * tstepB;
    PG8_STAGE(PG8_SB(0, 0), cB, voffB); PG8_STAGE(PG8_SB(0, 1), cB + hstepB, voffB); PG8_STAGE(PG8_SA(0, 0), cA, voffA); PG8_STAGE(PG8_SA(0, 1), cA + hstepA, voffA);
    if (wr == 1) PG8_BAR;
    PG8_WAIT_V(2); PG8_BAR;
    PG8_STAGE(PG8_SB(1, 0), cB + kstep, voffB); PG8_STAGE(PG8_SA(1, 0), cA + kstep, voffA); PG8_STAGE(PG8_SB(1, 1), cB + hstepB + kstep, voffB);
    PG8_WAIT_V(6); PG8_BAR;
    for (;;) {
        const bool has_next = S.next(ui + 1, nxt);
        const char* nA = has_next ? (const char*)g.A + (size_t)nxt.pm * tstepA + (size_t)nxt.pn * g.a_pn_bytes : cA; const char* nB = has_next ? (const char*)g.Bt + (size_t)nxt.pn * tstepB : cB;
#pragma unroll 1
        for (int t = 0; t < nt; t += 2) {
            const bool last = (t == nt - 2);
            if constexpr (Epi::HAS_MID) { if (t == g.midt) { E.mid(acc, cur, wr, wc, fr, fq); } PG8_SCHED; }
            const char* a1 = cA + (size_t)(t + 1) * kstep;
            const char* a2 = last ? nA : cA + (size_t)(t + 2) * kstep; const char* b2 = last ? nB : cB + (size_t)(t + 2) * kstep;
            const char* a3 = a2 + kstep; const char* b3 = b2 + kstep;
            PG8_LDB(B0, 0, 0); PG8_LDB(B1, 0, 1); PG8_SCHED; PG8_LDA(At, 0, 0); PG8_STAGE(PG8_SA(1, 1), a1 + hstepA, voffA);
            PG8_WAIT_V(8); PG8_WAIT_L(0); PG8_BAR; PG8_MMA(0, 0, At, B0); PG8_MMA(0, 1, At, B1); PG8_BAR; PG8_SCHED;
            PG8_LDA(At, 0, 1); PG8_STAGE(PG8_SB(0, 0), b2, voffB); PG8_STAGE(PG8_SB(0, 1), b2 + hstepB, voffB); PG8_STAGE(PG8_SA(0, 0), a2, voffA);
            PG8_WAIT_V(8); PG8_WAIT_L(0); PG8_BAR; PG8_MMA(1, 0, At, B0); PG8_MMA(1, 1, At, B1); PG8_BAR; PG8_SCHED;
            PG8_LDB(B0, 1, 0); PG8_LDB(B1, 1, 1); PG8_SCHED; PG8_LDA(At, 1, 0); PG8_STAGE(PG8_SA(0, 1), a2 + hstepA, voffA);
            PG8_WAIT_V(8); PG8_WAIT_L(0); PG8_BAR; PG8_MMA(0, 0, At, B0); PG8_MMA(0, 1, At, B1); PG8_BAR; PG8_SCHED;
            PG8_LDA(At, 1, 1); PG8_STAGE(PG8_SB(1, 0), b3, voffB); PG8_STAGE(PG8_SB(1, 1), b3 + hstepB, voffB); PG8_STAGE(PG8_SA(1, 0), a3, voffA);
            PG8_WAIT_V(8); PG8_WAIT_L(0); PG8_BAR; PG8_MMA(1, 0, At, B0); PG8_MMA(1, 1, At, B1); PG8_BAR; PG8_SCHED;
        }
        if (wr == 0) PG8_BAR;
        E(acc, cur, wr, wc, fr, fq);
        if (!has_next) break;
#pragma unroll
        for (int a = 0; a < 2; ++a)
#pragma unroll
            for (int b = 0; b < 2; ++b)
#pragma unroll
                for (int m = 0; m < 4; ++m)
#pragma unroll
                    for (int n = 0; n < 2; ++n) acc[a][b][m][n] = (f32x4){0.f, 0.f, 0.f, 0.f};
        cur = nxt; cA = nA; cB = nB; ++ui;
        if (wr == 1) PG8_BAR;
    }
    PG8_WAIT_V(0);
    PG8_BAR;
#undef PG8_SA
#undef PG8_SB
#undef PG8_STAGE
#undef PG8_LDA
#undef PG8_LDB
#undef PG8_MMA
#undef PG8_WAIT_V
#undef PG8_WAIT_L
#undef PG8_BAR
#undef PG8_SCHED
}

typedef f32x4 Acc[2][2][4][2];
__device__ __forceinline__ u32x4 pack8(const f32x4 v0, const f32x4 v1) { u32x4 w; w.x = cvt_pk_bf16(v0[0], v0[1]); w.y = cvt_pk_bf16(v0[2], v0[3]); w.z = cvt_pk_bf16(v1[0], v1[1]); w.w = cvt_pk_bf16(v1[2], v1[3]); return w; }

struct EpiZ {
    static constexpr bool HAS_MID = false;
    bf16_t* Z;
    __device__ __forceinline__ void operator()(Acc& acc, const Unit& u, int wr, int wc, int fr, int fq) const {
        int row0 = u.pm * BM + wr * 64 + fr; asm volatile("" : "+v"(row0)); const int col0 = u.pn * BM + wc * 32 + 8 * fq; const bool sig = u.pn >= 5;
#pragma unroll
        for (int ai = 0; ai < 2; ++ai)
#pragma unroll
            for (int m = 0; m < 4; ++m) { bf16_t* rowp = Z + (size_t)(row0 + ai * HALF + m * 16) * INW + col0;
                f32x4 a0 = acc[ai][0][m][0], a1 = acc[ai][0][m][1], b0 = acc[ai][1][m][0], b1 = acc[ai][1][m][1];
                if (sig) {
#pragma unroll
                    for (int e = 0; e < 4; ++e) { const float ea0 = __builtin_amdgcn_exp2f(-a0[e] * LOG2E), eb0 = __builtin_amdgcn_exp2f(-b0[e] * LOG2E), ea1 = __builtin_amdgcn_exp2f(-a1[e] * LOG2E), eb1 = __builtin_amdgcn_exp2f(-b1[e] * LOG2E);
                        a0[e] = (1.0f + eb0) * __builtin_amdgcn_rcpf(1.0f + ea0); b0[e] = __builtin_amdgcn_rcpf(1.0f + eb0);
                        a1[e] = (1.0f + eb1) * __builtin_amdgcn_rcpf(1.0f + ea1); b1[e] = __builtin_amdgcn_rcpf(1.0f + eb1); } }
                *(u32x4*)(rowp) = pack8(a0, a1); *(u32x4*)(rowp + HALF) = pack8(b0, b1); }
    }
};
struct EpiBf {
    static constexpr bool HAS_MID = false;
    bf16_t* O; int ldc;
    __device__ __forceinline__ void operator()(Acc& acc, const Unit& u, int wr, int wc, int fr, int fq) const {
        int row0 = u.pm * BM + wr * 64 + fr; asm volatile("" : "+v"(row0)); const int col0 = u.pn * BM + wc * 32 + 8 * fq;
#pragma unroll
        for (int ai = 0; ai < 2; ++ai)
#pragma unroll
            for (int m = 0; m < 4; ++m) { bf16_t* rowp = O + (size_t)(row0 + ai * HALF + m * 16) * ldc + col0;
#pragma unroll
                for (int bj = 0; bj < 2; ++bj) *(u32x4*)(rowp + bj * HALF) = pack8(acc[ai][bj][m][0], acc[ai][bj][m][1]); }
    }
};
struct EpiMerge {
    static constexpr bool HAS_MID = true;
    const bf16_t* Z; bf16_t* O;
    __device__ __forceinline__ void mid(Acc& acc, const Unit& u, int wr, int wc, int fr, int fq) const {
        int row0 = u.pm * BM + wr * 64 + fr; asm volatile("" : "+v"(row0)); const int zc0 = ZC_GA + 512 * u.pn + wc * 32 + 8 * fq;
        u32x4 gw[2][4][2];
#pragma unroll
        for (int ai = 0; ai < 2; ++ai)
#pragma unroll
            for (int m = 0; m < 4; ++m) { const bf16_t* zr = Z + (size_t)(row0 + ai * HALF + m * 16) * INW + zc0;
#pragma unroll
                for (int bj = 0; bj < 2; ++bj) gw[ai][m][bj] = *(const u32x4*)(zr + 256 * bj); }
#pragma unroll
        for (int ai = 0; ai < 2; ++ai)
#pragma unroll
            for (int m = 0; m < 4; ++m)
#pragma unroll
                for (int bj = 0; bj < 2; ++bj) { const u32x4 a = gw[ai][m][bj];
#pragma unroll
                    for (int e = 0; e < 4; ++e) { acc[ai][bj][m][e >> 1][(e & 1) * 2] *= bflo(a[e]); acc[ai][bj][m][e >> 1][(e & 1) * 2 + 1] *= bfhi(a[e]); } }
    }
    __device__ __forceinline__ void operator()(Acc& acc, const Unit& u, int wr, int wc, int fr, int fq) const {
        int row0 = u.pm * BM + wr * 64 + fr; asm volatile("" : "+v"(row0)); const int col0 = u.pn * BM + wc * 32 + 8 * fq, zc0 = ZC_GA + 512 * u.pn + wc * 32 + 8 * fq + 128;
        u32x4 gw[2][4][2];
#pragma unroll
        for (int ai = 0; ai < 2; ++ai)
#pragma unroll
            for (int m = 0; m < 4; ++m) { const bf16_t* zr = Z + (size_t)(row0 + ai * HALF + m * 16) * INW + zc0;
#pragma unroll
                for (int bj = 0; bj < 2; ++bj) gw[ai][m][bj] = *(const u32x4*)(zr + 256 * bj); }
#pragma unroll
        for (int ai = 0; ai < 2; ++ai)
#pragma unroll
            for (int m = 0; m < 4; ++m) { bf16_t* rowp = O + (size_t)(row0 + ai * HALF + m * 16) * D + col0;
#pragma unroll
                for (int bj = 0; bj < 2; ++bj) { const u32x4 b = gw[ai][m][bj]; f32x4 v0 = acc[ai][bj][m][0], v1 = acc[ai][bj][m][1];
                    v0[0] *= bflo(b[0]); v0[1] *= bfhi(b[0]); v0[2] *= bflo(b[1]); v0[3] *= bfhi(b[1]); v1[0] *= bflo(b[2]); v1[1] *= bfhi(b[2]); v1[2] *= bflo(b[3]); v1[3] *= bfhi(b[3]);
                    *(u32x4*)(rowp + bj * HALF) = pack8(v0, v1); } }
    }
};
struct EpiX1 {
    static constexpr bool HAS_MID = false;
    const float* xp; const float* xs; float* out; bf16_t* X1B; float* sumsq;
    __device__ __forceinline__ void operator()(Acc& acc, const Unit& u, int wr, int wc, int fr, int fq) const {
        if (!u.last) return;
        int row0 = u.pm * BM + wr * 64 + fr; asm volatile("" : "+v"(row0)); const int col0 = u.pn * BM + wc * 32 + 8 * fq;
#pragma unroll
        for (int ai = 0; ai < 2; ++ai) {
            f32x4 xv[4][2][2];
#pragma unroll
            for (int m = 0; m < 4; ++m) { const int row = row0 + ai * HALF + m * 16; const bool valid = row < MV;
                const float* xr = (row < MP ? xp + (size_t)row * D : xs + (size_t)(valid ? row - MP : 0) * D) + col0;
#pragma unroll
                for (int bj = 0; bj < 2; ++bj) { xv[m][bj][0] = valid ? *(const f32x4*)(xr + bj * HALF) : (f32x4){0.f, 0.f, 0.f, 0.f}; xv[m][bj][1] = valid ? *(const f32x4*)(xr + bj * HALF + 4) : (f32x4){0.f, 0.f, 0.f, 0.f}; } }
#pragma unroll
            for (int m = 0; m < 4; ++m) { const int row = row0 + ai * HALF + m * 16; float ss = 0.f;
#pragma unroll
                for (int bj = 0; bj < 2; ++bj) { const f32x4 v0 = acc[ai][bj][m][0] + xv[m][bj][0], v1 = acc[ai][bj][m][1] + xv[m][bj][1];
                    ss += (v0[0] * v0[0] + v0[1] * v0[1]) + (v0[2] * v0[2] + v0[3] * v0[3]) + (v1[0] * v1[0] + v1[1] * v1[1]) + (v1[2] * v1[2] + v1[3] * v1[3]);
                    *(u32x4*)(X1B + (size_t)row * D + col0 + bj * HALF) = pack8(v0, v1); }
                ss += __shfl_xor(ss, 16); ss += __shfl_xor(ss, 32);
                if (fq == 0) atomicAdd(sumsq + row, ss); }
            asm volatile("" ::: "memory"); }
    }
};
struct EpiAct {
    static constexpr bool HAS_MID = false;
    const float* sumsq; bf16_t* ACT;
    __device__ __forceinline__ void operator()(Acc& acc, const Unit& u, int wr, int wc, int fr, int fq) const {
        int row0 = u.pm * BM + wr * 64 + fr; asm volatile("" : "+v"(row0)); const int col0 = u.pn * HALF + wc * 32 + 8 * fq;
        float rs[2][4];
#pragma unroll
        for (int ai = 0; ai < 2; ++ai)
#pragma unroll
            for (int m = 0; m < 4; ++m) rs[ai][m] = sumsq[row0 + ai * HALF + m * 16];
#pragma unroll
        for (int ai = 0; ai < 2; ++ai)
#pragma unroll
            for (int m = 0; m < 4; ++m) { const int row = row0 + ai * HALF + m * 16; const float rstd = __builtin_amdgcn_rsqf(rs[ai][m] * (1.0f / D) + EPS);
                f32x4 o[2];
#pragma unroll
                for (int n = 0; n < 2; ++n)
#pragma unroll
                    for (int e = 0; e < 4; ++e) { const float gt = acc[ai][0][m][n][e] * rstd, up = acc[ai][1][m][n][e] * rstd; o[n][e] = gt * up * fsigmoid(gt); }
                *(u32x4*)(ACT + (size_t)row * FF + col0) = pack8(o[0], o[1]); }
    }
};
struct EpiY {
    static constexpr bool HAS_MID = false;
    const bf16_t* X1B; float* out;
    __device__ __forceinline__ void operator()(Acc& acc, const Unit& u, int wr, int wc, int fr, int fq) const {
        if (!u.last) return;
        int row0 = u.pm * BM + wr * 64 + fr; asm volatile("" : "+v"(row0)); const int col0 = u.pn * BM + wc * 32 + 8 * fq;
        u32x4 xw[2][4][2];
#pragma unroll
        for (int ai = 0; ai < 2; ++ai)
#pragma unroll
            for (int m = 0; m < 4; ++m) { const int row = row0 + ai * HALF + m * 16; const bf16_t* xr = X1B + (size_t)row * D + col0;
#pragma unroll
                for (int bj = 0; bj < 2; ++bj) xw[ai][m][bj] = *(const u32x4*)(xr + bj * HALF); }
#pragma unroll
        for (int ai = 0; ai < 2; ++ai)
#pragma unroll
            for (int m = 0; m < 4; ++m) { const int row = row0 + ai * HALF + m * 16;
                if (row < MV) { float* orow = out + (size_t)row * D + col0;
#pragma unroll
                    for (int bj = 0; bj < 2; ++bj) { const u32x4 x = xw[ai][m][bj];
                        *(f32x4*)(orow + bj * HALF) = (f32x4){bflo(x[0]), bfhi(x[0]), bflo(x[1]), bfhi(x[1])} + acc[ai][bj][m][0];
                        *(f32x4*)(orow + bj * HALF + 4) = (f32x4){bflo(x[2]), bfhi(x[2]), bflo(x[3]), bfhi(x[3])} + acc[ai][bj][m][1]; } } }
    }
};
}

struct SrcPlain { const float* W; int N; __device__ __forceinline__ float operator()(int k, int n) const { return __builtin_nontemporal_load(W + (size_t)k * N + n); } };
struct SrcWin { const float* W;
    __device__ __forceinline__ float operator()(int k, int n) const { int c = n; if (n >= ZC_GA) { const int t = (n - ZC_GA) >> 8, j = (n - ZC_GA) & 255; c = (j < 128 ? ZC_GA : ZC_GB) + 128 * t + (j & 127); } return __builtin_nontemporal_load(W + (size_t)k * INW + c); } };
struct SrcMix { const float* mix; const float* scale;
    __device__ __forceinline__ float operator()(int k, int n) const { return mix[((size_t)(n >> 7) * 128 + k) * 128 + (n & 127)] * scale[n]; } };
struct SrcCat { const float* wp; const float* wa;
    __device__ __forceinline__ float operator()(int k, int n) const { return __builtin_nontemporal_load(k < 512 ? wp + (size_t)k * D + n : wa + (size_t)(k - 512) * D + n); } };
struct SrcGU { const float* wg; const float* wu; const float* nrm;
    __device__ __forceinline__ float operator()(int k, int n) const { const int t = n >> 8, j = n & 255, col = 128 * t + (j & 127); const float* w = (const float*)((uintptr_t)wg + (uintptr_t)(j >> 7) * ((uintptr_t)wu - (uintptr_t)wg)); return __builtin_nontemporal_load(w + (size_t)k * FF + col) * nrm[k]; } };

template <class Src>
__device__ __forceinline__ void transpose_item(const Src src, bf16_t* WT, int ldk, int nblk, int item, LAS float* scr, int lane) {
    const int kb = item / nblk, nb = item % nblk, k0 = 64 * kb, n0 = 32 * nb;
    float tv[32];
#pragma unroll
    for (int i = 0; i < 32; ++i) tv[i] = src(k0 + 2 * i + (lane >> 5), n0 + (lane & 31));
#pragma unroll
    for (int i = 0; i < 32; ++i) scr[(2 * i + (lane >> 5)) * 33 + (lane & 31)] = tv[i];
    LDS_WAIT();
    const int c = lane & 7;
#pragma unroll
    for (int j = 0; j < 4; ++j) { const int n = (lane >> 3) + 8 * j; const LAS float* s = scr + (8 * c) * 33 + n;
        u32x4 o; o.x = cvt_pk_bf16(s[0 * 33], s[1 * 33]); o.y = cvt_pk_bf16(s[2 * 33], s[3 * 33]); o.z = cvt_pk_bf16(s[4 * 33], s[5 * 33]); o.w = cvt_pk_bf16(s[6 * 33], s[7 * 33]);
        *(u32x4*)(WT + (size_t)(n0 + n) * ldk + k0 + 8 * c) = o; }
    LDS_WAIT();
}

struct Args { const float* in[19]; float* out; unsigned char* ws; int ph_lo, ph_hi; };

template <int NSTEPS, class Epi>
__device__ __forceinline__ void small_gemm(LAS unsigned char* lds, const bf16_t* A, int lda, const bf16_t* Bt, int ldb, int K, int vcu, int G, const Epi& E) {
    const int tid = threadIdx.x, lane = tid & 63, wave = __builtin_amdgcn_readfirstlane(tid >> 6), fr = lane & 15, fq = lane >> 4, rh = wave & 1, ks = wave >> 1;
    const int kq = K >> 2;
    for (int u = vcu; u < 256; u += G) {
        const int r0 = 32 * (u & 3) + 16 * rh, n0 = 16 * (u >> 2);
        const bf16_t* ap = A + (size_t)(r0 + fr) * lda + ks * kq + 8 * fq; const bf16_t* bp = Bt + (size_t)(n0 + fr) * ldb + ks * kq + 8 * fq;
        f32x4 acc = (f32x4){0.f, 0.f, 0.f, 0.f};
        bf16x8 af[NSTEPS], bf[NSTEPS];
#pragma unroll
        for (int s = 0; s < NSTEPS; ++s) { af[s] = *(const bf16x8*)(ap + 32 * s); bf[s] = *(const bf16x8*)(bp + 32 * s); }
#pragma unroll
        for (int s = 0; s < NSTEPS; ++s) acc = __builtin_amdgcn_mfma_f32_16x16x32_bf16(bf[s], af[s], acc, 0, 0, 0);
        LAS f32x4* red = (LAS f32x4*)lds;
        red[(ks * 2 + rh) * 64 + lane] = acc;
        __syncthreads();
        if (ks == 0) { const f32x4 p0 = red[(0 * 2 + rh) * 64 + lane], p1 = red[(1 * 2 + rh) * 64 + lane], p2 = red[(2 * 2 + rh) * 64 + lane], p3 = red[(3 * 2 + rh) * 64 + lane];
            E(p0, p1, p2, p3, r0 + fr, n0 + 4 * fq, fq); }
        __syncthreads();
    }
}
struct SEpiMerge { const bf16_t* Z; bf16_t* O;
    __device__ __forceinline__ void operator()(f32x4 p0, f32x4 p1, f32x4 p2, f32x4 p3, int n, int c, int fq) const {
        const bf16_t* zr = Z + (size_t)(MP + n) * INW + ZC_GA + 256 * (c >> 7) + (c & 127); const u32x2 r = *(const u32x2*)zr, b = *(const u32x2*)(zr + 128);
        const f32x4 pool = p0 + p1, attn = p2 + p3;
        u32x2 w; w.x = cvt_pk_bf16(bflo(b.x) * (bflo(r.x) * pool[0] + attn[0]), bfhi(b.x) * (bfhi(r.x) * pool[1] + attn[1]));
        w.y = cvt_pk_bf16(bflo(b.y) * (bflo(r.y) * pool[2] + attn[2]), bfhi(b.y) * (bfhi(r.y) * pool[3] + attn[3]));
        *(u32x2*)(O + (size_t)(MP + n) * D + c) = w; } };
struct SEpiX1 { const float* xs; float* out; bf16_t* X1B; float* sumsq;
    __device__ __forceinline__ void operator()(f32x4 p0, f32x4 p1, f32x4 p2, f32x4 p3, int n, int c, int fq) const {
        const f32x4 v = *(const f32x4*)(xs + (size_t)n * D + c) + ((p0 + p1) + (p2 + p3));
        u32x2 w; w.x = cvt_pk_bf16(v[0], v[1]); w.y = cvt_pk_bf16(v[2], v[3]); *(u32x2*)(X1B + (size_t)(MP + n) * D + c) = w;
        float ss = (v[0] * v[0] + v[1] * v[1]) + (v[2] * v[2] + v[3] * v[3]); ss += __shfl_xor(ss, 16); ss += __shfl_xor(ss, 32);
        if (fq == 0) atomicAdd(sumsq + MP + n, ss); } };
struct SEpiY { const bf16_t* X1B; float* out;
    __device__ __forceinline__ void operator()(f32x4 p0, f32x4 p1, f32x4 p2, f32x4 p3, int n, int c, int fq) const {
        const u32x2 x = *(const u32x2*)(X1B + (size_t)(MP + n) * D + c);
        *(f32x4*)(out + (size_t)(MP + n) * D + c) = (f32x4){bflo(x.x), bfhi(x.x), bflo(x.y), bfhi(x.y)} + ((p0 + p1) + (p2 + p3)); } };

__device__ __forceinline__ int crow(int r, int hi) { return (r & 3) + 8 * (r >> 2) + 4 * hi; }
constexpr int KS_STRIDE = 144, VT_STRIDE = 520, LDS_VT = 256 * KS_STRIDE  , LDS_SMP = 131072;

__device__ __forceinline__ void attn_prompt_unit(const Args& a, LAS unsigned char* lds, int unit) {
    const int tid = threadIdx.x, lane = tid & 63, wave = __builtin_amdgcn_readfirstlane(tid >> 6);
    const int kh = unit & 1, qb = (unit >> 1) & 15, b = unit >> 5;
    const bf16_t* Z = (const bf16_t*)(a.ws + WS_Z); bf16_t* YY = (bf16_t*)(a.ws + WS_RB);
    const float* qnw = a.in[7]; const float* knw = a.in[8]; const float* sinks = a.in[9];
    const size_t rowbase = (size_t)b * SEQ; const int key0 = (qb - 1) * 128;
    const int hq = 4 * kh + (wave >> 1), ql = lane & 31, h = lane >> 5;
    u32x4 qraw[2][4];
#pragma unroll
    for (int gi = 0; gi < 2; ++gi) { const bf16_t* qp = Z + (rowbase + (size_t)qb * 128 + 32 * (2 * (wave & 1) + gi) + ql) * INW + ZC_Q + hq * 64 + 8 * h;
#pragma unroll
        for (int ds = 0; ds < 4; ++ds) qraw[gi][ds] = *(const u32x4*)(qp + 16 * ds); }
    u32x4 vraw[4];
#pragma unroll
    for (int i = 0; i < 4; ++i) { const int c = tid + 512 * i, key = c & 255, dch = c >> 8, pos = key0 + key;
        vraw[i] = (u32x4){0u, 0u, 0u, 0u};
        if (pos >= 0) vraw[i] = *(const u32x4*)(Z + (rowbase + pos) * INW + ZC_V + kh * 64 + 8 * dch); }
    {
        const int j = tid >> 1, half = tid & 1, pos = key0 + j; float v[32];
        if (pos >= 0) { const u32x4* src = (const u32x4*)(Z + (rowbase + pos) * INW + ZC_K + kh * 64 + 32 * half);
#pragma unroll
            for (int c = 0; c < 4; ++c) { const u32x4 w = src[c];
#pragma unroll
                for (int e = 0; e < 4; ++e) { v[c * 8 + 2 * e] = bflo(w[e]); v[c * 8 + 2 * e + 1] = bfhi(w[e]); } } }
        else {
#pragma unroll
            for (int i = 0; i < 32; ++i) v[i] = 0.f; }
        float ss = 0.f;
#pragma unroll
        for (int i = 0; i < 32; ++i) ss += v[i] * v[i];
        ss += __shfl_xor(ss, 1);
        const float rstd = __builtin_amdgcn_rsqf(ss * (1.0f / 64) + EPS);
#pragma unroll
        for (int c = 0; c < 8; ++c) { const f32x4 w = *(const f32x4*)(knw + 32 * half + 4 * c);
#pragma unroll
            for (int e = 0; e < 4; ++e) v[4 * c + e] = v[4 * c + e] * rstd * w[e]; }
        LAS u32x4* dst = (LAS u32x4*)(lds + j * KS_STRIDE + 64 * half);
#pragma unroll
        for (int c = 0; c < 4; ++c) { u32x4 w;
#pragma unroll
            for (int e = 0; e < 4; ++e) w[e] = cvt_pk_bf16(v[c * 8 + 2 * e], v[c * 8 + 2 * e + 1]);
            dst[c] = w; }
        if (qb == 15 && j >= 128) { float* o = a.out + O_KP + ((size_t)(b * 128 + (j - 128)) * 2 + kh) * 64 + 32 * half;
#pragma unroll
            for (int c = 0; c < 8; ++c) *(f32x4*)(o + 4 * c) = (f32x4){v[4 * c], v[4 * c + 1], v[4 * c + 2], v[4 * c + 3]}; }
    }
#pragma unroll
    for (int i = 0; i < 4; ++i) { const int c = tid + 512 * i, key = c & 255, dch = c >> 8, pos = key0 + key;
        const u32x4 w = vraw[i];
        LAS bf16_t* vt = (LAS bf16_t*)(lds + LDS_VT) + key;
#pragma unroll
        for (int e = 0; e < 4; ++e) { vt[(8 * dch + 2 * e) * (VT_STRIDE / 2)] = (bf16_t)(w[e] & 0xffffu); vt[(8 * dch + 2 * e + 1) * (VT_STRIDE / 2)] = (bf16_t)(w[e] >> 16); }
        if (qb == 15 && key >= 128) { float* o = a.out + O_VP + ((size_t)(b * 128 + (key - 128)) * 2 + kh) * 64 + 8 * dch;
            *(f32x4*)o = (f32x4){bflo(w[0]), bfhi(w[0]), bflo(w[1]), bfhi(w[1])}; *(f32x4*)(o + 4) = (f32x4){bflo(w[2]), bfhi(w[2]), bflo(w[3]), bfhi(w[3])}; } }
    __syncthreads();
    const float sink2 = sinks[hq] * LOG2E;
    f32x16 scs[2][5];
#pragma unroll
    for (int gi = 0; gi < 2; ++gi) {
        const int g = 2 * (wave & 1) + gi;
        bf16x8 qf[4];
        { float v[32];
#pragma unroll
            for (int ds = 0; ds < 4; ++ds) { const u32x4 w = qraw[gi][ds];
#pragma unroll
                for (int e = 0; e < 4; ++e) { v[ds * 8 + 2 * e] = bflo(w[e]); v[ds * 8 + 2 * e + 1] = bfhi(w[e]); } }
            float ss = 0.f;
#pragma unroll
            for (int i = 0; i < 32; ++i) ss += v[i] * v[i];
            ss += __shfl_xor(ss, 32);
            const float sc = __builtin_amdgcn_rsqf(ss * (1.0f / 64) + EPS) * C2;
#pragma unroll
            for (int ds = 0; ds < 4; ++ds) { const f32x4 w0 = *(const f32x4*)(qnw + 16 * ds + 8 * h), w1 = *(const f32x4*)(qnw + 16 * ds + 8 * h + 4); u32x4 p;
                p.x = cvt_pk_bf16(v[ds * 8 + 0] * sc * w0[0], v[ds * 8 + 1] * sc * w0[1]); p.y = cvt_pk_bf16(v[ds * 8 + 2] * sc * w0[2], v[ds * 8 + 3] * sc * w0[3]);
                p.z = cvt_pk_bf16(v[ds * 8 + 4] * sc * w1[0], v[ds * 8 + 5] * sc * w1[1]); p.w = cvt_pk_bf16(v[ds * 8 + 6] * sc * w1[2], v[ds * 8 + 7] * sc * w1[3]);
                qf[ds] = __builtin_bit_cast(bf16x8, p); } }
        __builtin_amdgcn_s_setprio(1);
#pragma unroll
        for (int i = 0; i < 5; ++i) { f32x16 acc = {};
#pragma unroll
            for (int ds = 0; ds < 4; ++ds) { const bf16x8 kf = *(const LAS bf16x8*)(lds + (32 * (g + i) + ql) * KS_STRIDE + 32 * ds + 16 * h);
                acc = __builtin_amdgcn_mfma_f32_32x32x16_bf16(kf, qf[ds], acc, 0, 0, 0); }
            scs[gi][i] = acc; }
        __builtin_amdgcn_s_setprio(0);
    }
    __builtin_amdgcn_sched_barrier(0);
#pragma unroll
    for (int gi = 0; gi < 2; ++gi) {
        const int g = 2 * (wave & 1) + gi; const size_t qrow = rowbase + (size_t)qb * 128 + 32 * g + ql;
        f32x16 (&sc)[5] = scs[gi];
        const int dsel = ql - 4 * h; float mx = -1e30f;
#pragma unroll
        for (int i = 0; i < 5; ++i) {
            if (qb == 0 && g + i < 4) {
#pragma unroll
                for (int r = 0; r < 16; ++r) sc[i][r] = -1e30f;
            } else {
#pragma unroll
                for (int r = 0; r < 16; ++r) { float s = sc[i][r];
                    if (i == 0) s = (crow(r, 0) >= dsel) ? s : -1e30f;
                    if (i == 4) s = (crow(r, 0) <= dsel) ? s : -1e30f;
                    sc[i][r] = s; mx = fmaxf(mx, s); } } }
        mx = fmaxf(mx, __shfl_xor(mx, 32));
        const float mref = fmaxf(mx, sink2); float lsum = 0.f;
#pragma unroll
        for (int i = 0; i < 5; ++i)
#pragma unroll
            for (int r = 0; r < 16; ++r) { const float p = __builtin_amdgcn_exp2f(sc[i][r] - mref); sc[i][r] = p; lsum += p; }
        lsum += __shfl_xor(lsum, 32);
        const float inv = 1.0f / (lsum + __builtin_amdgcn_exp2f(sink2 - mref));
        f32x16 o[2]; o[0] = (f32x16){}; o[1] = (f32x16){};
        __builtin_amdgcn_s_setprio(1);
#pragma unroll
        for (int i = 0; i < 5; ++i)
#pragma unroll
            for (int s2 = 0; s2 < 2; ++s2) { u32x4 pw;
#pragma unroll
                for (int e = 0; e < 4; ++e) pw[e] = cvt_pk_bf16(sc[i][8 * s2 + 2 * e], sc[i][8 * s2 + 2 * e + 1]);
                const bf16x8 pf = __builtin_bit_cast(bf16x8, pw);
#pragma unroll
                for (int dt = 0; dt < 2; ++dt) { const LAS unsigned char* vp = lds + LDS_VT + (32 * dt + ql) * VT_STRIDE + 2 * (32 * (g + i) + 16 * s2 + 4 * h);
                    const u32x2 lo = *(const LAS u32x2*)vp, hi2 = *(const LAS u32x2*)(vp + 16);
                    const u32x4 vw = (u32x4){lo.x, lo.y, hi2.x, hi2.y};
                    o[dt] = __builtin_amdgcn_mfma_f32_32x32x16_bf16(__builtin_bit_cast(bf16x8, vw), pf, o[dt], 0, 0, 0); } }
        __builtin_amdgcn_s_setprio(0);
        bf16_t* yp = YY + qrow * D + 512 + hq * 64 + 4 * h;
#pragma unroll
        for (int dt = 0; dt < 2; ++dt)
#pragma unroll
            for (int rq = 0; rq < 4; ++rq) { u32x2 w; w.x = cvt_pk_bf16(o[dt][4 * rq] * inv, o[dt][4 * rq + 1] * inv); w.y = cvt_pk_bf16(o[dt][4 * rq + 2] * inv, o[dt][4 * rq + 3] * inv);
                *(u32x2*)(yp + 32 * dt + 8 * rq) = w; }
        __builtin_amdgcn_sched_barrier(0);
    }
    __syncthreads();
}

__device__ __forceinline__ void attn_sample_unit(const Args& a, LAS unsigned char* lds, int su) {
    const int tid = threadIdx.x, lane = tid & 63, wave = __builtin_amdgcn_readfirstlane(tid >> 6);
    const int n = su >> 1, kh = su & 1;
    const float* ck = a.in[2] + (size_t)n * 16384; const float* cv = a.in[3] + (size_t)n * 16384;
    if (wave < 4) {
        const int hq = 4 * kh + wave;
        const bf16_t* zrow = (const bf16_t*)(a.ws + WS_Z) + (size_t)(MP + n) * INW; bf16_t* YY = (bf16_t*)(a.ws + WS_RB);
        LAS float* qs = (LAS float*)(lds + LDS_SMP + wave * 1024); LAS float* ps = qs + 64;
        const float xq = bf1(zrow[ZC_Q + hq * 64 + lane]); const float ssq = wave_sum(xq * xq);
        const float qn = xq * __builtin_amdgcn_rsqf(ssq * (1.0f / 64) + EPS) * a.in[7][lane] * C2;
        const float xk = bf1(zrow[ZC_K + kh * 64 + lane]); const float ssk = wave_sum(xk * xk);
        const float kn = xk * __builtin_amdgcn_rsqf(ssk * (1.0f / 64) + EPS) * a.in[8][lane];
        const float vn = bf1(zrow[ZC_V + kh * 64 + lane]);
        const float s_new = wave_sum(qn * kn);
        if (wave == 0) { a.out[O_KS + (size_t)n * 16384 + (127 * 2 + kh) * 64 + lane] = kn; a.out[O_VS + (size_t)n * 16384 + (127 * 2 + kh) * 64 + lane] = vn; }
        qs[lane] = qn; LDS_WAIT();
        float s0 = 0.f, s1 = 0.f;
        { const f32x4* k0 = (const f32x4*)(ck + (size_t)(lane * 2 + kh) * 64); const f32x4* k1 = (const f32x4*)(ck + (size_t)((lane + 64) * 2 + kh) * 64);
#pragma unroll
            for (int c = 0; c < 16; ++c) { const f32x4 q4 = *(const LAS f32x4*)(qs + 4 * c), x0 = k0[c], x1 = k1[c];
                s0 += (q4[0] * x0[0] + q4[1] * x0[1]) + (q4[2] * x0[2] + q4[3] * x0[3]); s1 += (q4[0] * x1[0] + q4[1] * x1[1]) + (q4[2] * x1[2] + q4[3] * x1[3]); } }
        const float sink2 = a.in[9][hq] * LOG2E;
        const float mref = fmaxf(fmaxf(wave_max(fmaxf(s0, s1)), s_new), sink2);
        const float p0 = __builtin_amdgcn_exp2f(s0 - mref), p1 = __builtin_amdgcn_exp2f(s1 - mref), pn = __builtin_amdgcn_exp2f(s_new - mref);
        const float l = wave_sum(p0 + p1) + pn + __builtin_amdgcn_exp2f(sink2 - mref);
        ps[lane] = p0; ps[lane + 64] = p1; LDS_WAIT();
        const int kg = lane >> 4, dc = lane & 15;
        f32x4 o = (f32x4){0.f, 0.f, 0.f, 0.f};
#pragma unroll 16
        for (int j = 0; j < 32; ++j) { const int key = 4 * j + kg; const f32x4 v = *(const f32x4*)(cv + (size_t)(key * 2 + kh) * 64 + 4 * dc); o += v * ps[key]; }
#pragma unroll
        for (int e = 0; e < 4; ++e) { o[e] += __shfl_xor(o[e], 16); o[e] += __shfl_xor(o[e], 32); }
        if (kg == 0) { const f32x4 vn4 = (f32x4){bf1(zrow[ZC_V + kh * 64 + 4 * dc]), bf1(zrow[ZC_V + kh * 64 + 4 * dc + 1]), bf1(zrow[ZC_V + kh * 64 + 4 * dc + 2]), bf1(zrow[ZC_V + kh * 64 + 4 * dc + 3])};
            const float il = 1.0f / l; const f32x4 r = (o + vn4 * pn) * il;
            u32x2 w; w.x = cvt_pk_bf16(r[0], r[1]); w.y = cvt_pk_bf16(r[2], r[3]);
            *(u32x2*)(YY + (size_t)(MP + n) * D + 512 + hq * 64 + 4 * dc) = w; }
    }
}

constexpr int PL_STRIDE = 272;
template <int W>
__device__ __forceinline__ void pool_task(const Args& a, LAS unsigned char* wl, int blk, int g, int lane) {
    const bf16_t* Z = (const bf16_t*)(a.ws + WS_Z); bf16_t* YY = (bf16_t*)(a.ws + WS_RB); const bf16_t* WM = (const bf16_t*)(a.ws + WS_MIX);
    const int r0 = 32 * blk, row = lane & 31, h = lane >> 5;
    f32x16 acc[4];
#pragma unroll
    for (int nt = 0; nt < 4; ++nt) acc[nt] = (f32x16){};
    if (r0 < MP) {
        const int t0 = r0 & (SEQ - 1), b = r0 >> 11;
#pragma unroll
        for (int it = 0; it < 12; ++it) { const int rr = 4 * it + (lane >> 4);
            if (rr < 47) { u32x4 v = (u32x4){0u, 0u, 0u, 0u};
                if (t0 > 0 || rr >= 15) v = *(const u32x4*)(Z + (size_t)(r0 - 15 + rr) * INW + 128 * g + 8 * (lane & 15));
                *(LAS u32x4*)(wl + rr * PL_STRIDE + 16 * (lane & 15)) = v; } }
        LDS_WAIT();
        const int t = t0 + row; const float rc = 1.0f / (float)min(W, t + 1);
        const bf16_t* wmp = WM + (size_t)(128 * g + row) * 128 + 8 * h;
        bf16x8 bnx[4];
#pragma unroll
        for (int nt = 0; nt < 4; ++nt) bnx[nt] = *(const bf16x8*)(wmp + (size_t)(32 * nt) * 128);
#pragma unroll 1
        for (int ks = 0; ks < 8; ++ks) {
            bf16x8 bcur[4];
#pragma unroll
            for (int nt = 0; nt < 4; ++nt) bcur[nt] = bnx[nt];
            if (ks < 7) {
#pragma unroll
                for (int nt = 0; nt < 4; ++nt) bnx[nt] = *(const bf16x8*)(wmp + (size_t)(32 * nt) * 128 + 16 * (ks + 1)); }
            const LAS unsigned char* base = wl + (15 + row) * PL_STRIDE + (16 * ks + 8 * h) * 2;
            float s[8], u[8];
            { const u32x4 x = *(const LAS u32x4*)base;
#pragma unroll
                for (int e = 0; e < 4; ++e) { u[2 * e] = bflo(x[e]); u[2 * e + 1] = bfhi(x[e]); s[2 * e] = u[2 * e]; s[2 * e + 1] = u[2 * e + 1]; } }
#pragma unroll
            for (int i = 1; i < W; ++i) { const u32x4 x = *(const LAS u32x4*)(base - i * PL_STRIDE);
#pragma unroll
                for (int e = 0; e < 4; ++e) { s[2 * e] += bflo(x[e]); s[2 * e + 1] += bfhi(x[e]); } }
            u32x4 y;
#pragma unroll
            for (int e = 0; e < 4; ++e) y[e] = cvt_pk_bf16(s[2 * e] * rc - u[2 * e], s[2 * e + 1] * rc - u[2 * e + 1]);
            const bf16x8 af = __builtin_bit_cast(bf16x8, y);
            if (t >= SEQ - 15) { float* o = a.out + O_PP + ((size_t)b * 15 + (t - (SEQ - 15))) * PW + 128 * g + 16 * ks + 8 * h;
                *(f32x4*)o = (f32x4){u[0], u[1], u[2], u[3]}; *(f32x4*)(o + 4) = (f32x4){u[4], u[5], u[6], u[7]}; }
#pragma unroll
            for (int nt = 0; nt < 4; ++nt) acc[nt] = __builtin_amdgcn_mfma_f32_32x32x16_bf16(af, bcur[nt], acc[nt], 0, 0, 0);
        }
    } else {
        const int n = r0 - MP + row; const float* sp = (const float*)(a.ws + WS_SPOOL) + (size_t)n * PW; float* po = a.out + O_PS + (size_t)n * 15 * PW; const float rc = 1.0f / (float)W;
        const int cb = 128 * g + 8 * h;
        u32x4 xn = *(const u32x4*)(Z + (size_t)(MP + n) * INW + cb); f32x4 s0n = *(const f32x4*)(sp + cb), s1n = *(const f32x4*)(sp + cb + 4);
#pragma unroll 1
        for (int ks = 0; ks < 8; ++ks) {
            const int c0 = cb + 16 * ks;
            float s[8], u[8];
            { const u32x4 x = xn; const f32x4 s0 = s0n, s1 = s1n;
                if (ks < 7) { xn = *(const u32x4*)(Z + (size_t)(MP + n) * INW + c0 + 16); s0n = *(const f32x4*)(sp + c0 + 16); s1n = *(const f32x4*)(sp + c0 + 20); }
#pragma unroll
                for (int e = 0; e < 4; ++e) { u[2 * e] = bflo(x[e]); u[2 * e + 1] = bfhi(x[e]); }
#pragma unroll
                for (int e = 0; e < 4; ++e) { s[e] = u[e] + s0[e]; s[4 + e] = u[4 + e] + s1[e]; } }
            *(f32x4*)(po + 14 * PW + c0) = (f32x4){u[0], u[1], u[2], u[3]}; *(f32x4*)(po + 14 * PW + c0 + 4) = (f32x4){u[4], u[5], u[6], u[7]};
            u32x4 y;
#pragma unroll
            for (int e = 0; e < 4; ++e) y[e] = cvt_pk_bf16(s[2 * e] * rc - u[2 * e], s[2 * e + 1] * rc - u[2 * e + 1]);
            const bf16x8 af = __builtin_bit_cast(bf16x8, y);
#pragma unroll
            for (int nt = 0; nt < 4; ++nt) { const bf16x8 bfr = *(const bf16x8*)(WM + (size_t)(128 * g + 32 * nt + row) * 128 + 16 * ks + 8 * h);
                acc[nt] = __builtin_amdgcn_mfma_f32_32x32x16_bf16(af, bfr, acc[nt], 0, 0, 0); }
        }
    }
#pragma unroll
    for (int nt = 0; nt < 4; ++nt)
#pragma unroll
        for (int r = 0; r < 16; ++r) YY[(size_t)(r0 + crow(r, h)) * D + 128 * g + 32 * nt + row] = (bf16_t)(cvt_pk_bf16(acc[nt][r], 0.f) & 0xffffu);
    LDS_WAIT();
}
__device__ __forceinline__ void pool_one(const Args& a, LAS unsigned char* wl, int blk, int g, int lane) {
    if (g == 0) pool_task<2>(a, wl, blk, 0, lane); else if (g == 1) pool_task<4>(a, wl, blk, 1, lane); else if (g == 2) pool_task<8>(a, wl, blk, 2, lane); else pool_task<16>(a, wl, blk, 3, lane);
}
__device__ __forceinline__ void roll_copies(const Args& a, int gtid, int gthreads) {
    { const f32x4* src = (const f32x4*)a.in[4]; f32x4* dst = (f32x4*)(a.out + O_PS);
        for (int i0 = gtid; i0 < NS * 1792; i0 += 2 * gthreads) { const int i1 = i0 + gthreads; const bool two = i1 < NS * 1792;
            const int n0 = i0 / 1792, j0 = i0 - n0 * 1792, n1 = two ? i1 / 1792 : 0, j1 = two ? i1 - n1 * 1792 : 0;
            const f32x4 v0 = src[(size_t)n0 * 1920 + 128 + j0], v1 = src[(size_t)n1 * 1920 + 128 + j1];
            dst[(size_t)n0 * 1920 + j0] = v0; if (two) dst[(size_t)n1 * 1920 + j1] = v1; } }
    { const f32x4* src = (const f32x4*)a.in[4]; f32x4* S4 = (f32x4*)(a.ws + WS_SPOOL);
        for (int i = gtid; i < NS * 128; i += gthreads) { const int n = i >> 7, c4 = i & 127, W = 2 << (c4 >> 5); f32x4 acc = (f32x4){0.f, 0.f, 0.f, 0.f};
#pragma unroll
            for (int k = 1; k < 16; ++k) { if (k < W) acc += src[(size_t)(n * 15 + 15 - k) * 128 + c4]; }
            S4[(size_t)n * 128 + c4] = acc; } }
    { const f32x4* sk = (const f32x4*)a.in[2]; const f32x4* sv = (const f32x4*)a.in[3]; f32x4* dk = (f32x4*)(a.out + O_KS); f32x4* dv = (f32x4*)(a.out + O_VS);
        constexpr int PER = 127 * 32;
        for (int i0 = gtid; i0 < NS * PER; i0 += 2 * gthreads) { const int i1 = i0 + gthreads; const bool two = i1 < NS * PER;
            const int n0 = i0 / PER, j0 = i0 - n0 * PER, n1 = two ? i1 / PER : 0, j1 = two ? i1 - n1 * PER : 0;
            const f32x4 k0 = sk[(size_t)n0 * 4096 + 32 + j0], k1 = sk[(size_t)n1 * 4096 + 32 + j1], v0 = sv[(size_t)n0 * 4096 + 32 + j0], v1 = sv[(size_t)n1 * 4096 + 32 + j1];
            dk[(size_t)n0 * 4096 + j0] = k0; dv[(size_t)n0 * 4096 + j0] = v0; if (two) { dk[(size_t)n1 * 4096 + j1] = k1; dv[(size_t)n1 * 4096 + j1] = v1; } } }
}

#define XB_TMO      128
#define XB_XCNT(j)  (256  + 64 * (j))
#define XB_XSUB(j)  (1280 + 64 * (j))
#define XB_XGEN(j)  (2304 + 64 * (j))
#define XB_TOP      3328
#define XB_TOPGEN   3392
#define XCD_BAR_WORDS 3456
#define XB_SPIN_CAP (1u << 18)
__device__ __forceinline__ unsigned xb_ld(unsigned* p)              { return __hip_atomic_load(p, __ATOMIC_RELAXED, __HIP_MEMORY_SCOPE_AGENT); }
__device__ __forceinline__ unsigned xb_add(unsigned* p, unsigned v) { return __hip_atomic_fetch_add(p, v, __ATOMIC_RELAXED, __HIP_MEMORY_SCOPE_AGENT); }
__device__ __forceinline__ unsigned xb_xcc_id() { return (unsigned)__builtin_amdgcn_s_getreg((3 << 11) | 20) & 0xFu; }
#define XB_SPIN(cond, bar) do { unsigned _sp = 0; while (cond) { __builtin_amdgcn_s_sleep(1); \
    if ((++_sp & 255u) == 0u) { if (xb_ld(&(bar)[XB_TMO])) break; if (_sp > XB_SPIN_CAP) { atomicAdd(&(bar)[XB_TMO], 1u); break; } } } } while (0)
struct XcdBarrier { unsigned* bar; unsigned x; volatile LAS unsigned* st; };
__device__ __forceinline__ XcdBarrier xcd_barrier_post(unsigned* bar, volatile LAS unsigned* st) {
    XcdBarrier b; b.bar = bar; b.x = xb_xcc_id(); b.st = st;
    if (threadIdx.x == 0) (void)xb_add(&bar[XB_XCNT(b.x)], 1u);
    return b;
}
__device__ __forceinline__ void xcd_barrier_complete(unsigned* bar, unsigned x, unsigned& nloc, unsigned& nx) {
    const unsigned G = gridDim.x * gridDim.y * gridDim.z;
    unsigned sum, cnt, mine, sp = 0u;
    for (;;) {
        sum = 0u; cnt = 0u; mine = 0u;
#pragma unroll
        for (unsigned j = 0; j < 16; ++j) { const unsigned c = xb_ld(&bar[XB_XCNT(j)]); sum += c; cnt += (c > 0u) ? 1u : 0u; mine = (j == x) ? c : mine; }
        if (sum == G) break;
        __builtin_amdgcn_s_sleep(1);
        if ((++sp & 255u) == 0u) { if (xb_ld(&bar[XB_TMO])) break; if (sp > XB_SPIN_CAP) { atomicAdd(&bar[XB_TMO], 1u); break; } }
    }
    nloc = mine > 0u ? mine : 1u; nx = cnt > 0u ? cnt : 1u;
}
__device__ __forceinline__ void xcd_barrier(const XcdBarrier& b) {
    asm volatile("s_waitcnt vmcnt(0)" ::: "memory");
    __syncthreads();
    if (threadIdx.x == 0) {
        unsigned* bar = b.bar;
        __builtin_amdgcn_s_waitcnt(0);
        unsigned nloc = b.st[0], nx = b.st[1];
        if (nloc == 0u) { xcd_barrier_complete(bar, b.x, nloc, nx); b.st[0] = nloc; b.st[1] = nx; }
        const unsigned old = xb_add(&bar[XB_XSUB(b.x)], 1u);
        const unsigned gen = old / nloc;
        if (old + 1u == (gen + 1u) * nloc) {
            __builtin_amdgcn_fence(__ATOMIC_RELEASE, "agent");
            asm volatile("s_waitcnt vmcnt(0)" ::: "memory");
            const unsigned og = xb_add(&bar[XB_TOP], 1u);
            const unsigned tg = og / nx;
            if (og + 1u == (tg + 1u) * nx) xb_add(&bar[XB_TOPGEN], 1u);
            else XB_SPIN(xb_ld(&bar[XB_TOPGEN]) == tg, bar);
            __builtin_amdgcn_fence(__ATOMIC_ACQUIRE, "agent");
            xb_add(&bar[XB_XGEN(b.x)], 1u);
            asm volatile("s_waitcnt vmcnt(0)" ::: "memory");
        } else {
            XB_SPIN(xb_ld(&bar[XB_XGEN(b.x)]) == gen, bar);
            __builtin_amdgcn_fence(__ATOMIC_ACQUIRE, "agent");
            asm volatile("s_waitcnt vmcnt(0)" ::: "memory");
        }
    }
    __syncthreads();
}

__global__ void __launch_bounds__(512, 2) fwd_megakernel(Args a) {
    extern __shared__ __attribute__((aligned(16))) unsigned char lds_raw[];
    LAS unsigned char* lds = (LAS unsigned char*)lds_raw;
    const int tid = threadIdx.x, lane = tid & 63, wave = __builtin_amdgcn_readfirstlane(tid >> 6);
    const int G = gridDim.x, bx = blockIdx.x;
    const int vcu = (G % 8 == 0) ? (bx % 8) * (G / 8) + bx / 8 : bx;
    unsigned char* ws = a.ws;
    bf16_t* WIN = (bf16_t*)(ws + WS_WIN); bf16_t* WMIX = (bf16_t*)(ws + WS_MIX); bf16_t* WCAT = (bf16_t*)(ws + WS_WCAT); bf16_t* WOUT = (bf16_t*)(ws + WS_WOUT);
    bf16_t* WGU = (bf16_t*)(ws + WS_WGU); bf16_t* WDN = (bf16_t*)(ws + WS_WDN);
    bf16_t* RA = (bf16_t*)(ws + WS_RA); bf16_t* RB = (bf16_t*)(ws + WS_RB); bf16_t* Z = (bf16_t*)(ws + WS_Z);
    float* SUMSQ = (float*)(ws + WS_SUMSQ);
    const int lo = a.ph_lo, hi = a.ph_hi;
    if (tid < 2) ((volatile LAS unsigned*)(lds + LDS_MISC))[tid] = 0u;
    __syncthreads();
    if (AMP_PHASE >= 0 && tid == 0) *(volatile LAS unsigned long long*)(lds + LDS_MISC + 16) = __builtin_amdgcn_s_memrealtime();
    XcdBarrier xbar = xcd_barrier_post((unsigned*)(ws + WS_BAR), (volatile LAS unsigned*)(lds + LDS_MISC));
#ifndef PH_MASK
#define PH_MASK 255
#endif
#define IN(k) (((PH_MASK >> (k)) & 1) && lo <= (k) && (k) < hi)
#ifndef DUP_MASK
#define DUP_MASK 0
#endif
#ifndef SMALL_REP
#define SMALL_REP 0
#endif
#ifndef EXTRA_SYNCS
#define EXTRA_SYNCS 0
#endif
#define REP(k) for (int rep_ = 0; rep_ < 1 + ((DUP_MASK >> (k)) & 1); ++rep_)
#define LASTREP(k) (rep_ == ((DUP_MASK >> (k)) & 1))
#define AMP(k) do { if (AMP_PHASE >= 0 && bx == 0) { volatile LAS unsigned long long* tp_ = (volatile LAS unsigned long long*)(lds + LDS_MISC + 16); const unsigned long long now_ = __builtin_amdgcn_s_memrealtime(); \
        if ((k) == AMP_PHASE || AMP_PHASE == 99) { const unsigned long long dt_ = now_ - tp_[0]; while (__builtin_amdgcn_s_memrealtime() - now_ < dt_) __builtin_amdgcn_s_sleep(8); } \
        __syncthreads(); if (tid == 0) tp_[0] = __builtin_amdgcn_s_memrealtime(); __syncthreads(); } } while (0)
#define SEAM(k) do { if (IN(k) && IN((k) + 1)) { xcd_barrier(xbar); for (int xs_ = 0; xs_ < EXTRA_SYNCS; ++xs_) xcd_barrier(xbar); AMP(k); } } while (0)

    if (IN(0)) REP(0) {
        LAS float* scr = (LAS float*)(lds + wave * 16384);
        const int gw = vcu * 8 + wave, NGW = G * 8;
        constexpr int I_IN = 16 * 104, I_MIX = 2 * 16;
        for (int it = gw; it < I_IN + I_MIX; it += NGW) {
            if (it < I_IN) transpose_item(SrcWin{a.in[6]}, WIN, D, 104, it, scr, lane);
            else transpose_item(SrcMix{a.in[10], a.in[11]}, WMIX, 128, 16, it - I_IN, scr, lane);
        }
        const float* g1 = a.in[5];
        constexpr int RPI = 4;
        for (int m0 = gw; m0 < MPAD; m0 += RPI * NGW) {
            f32x4 v[RPI][4];
#pragma unroll
            for (int q = 0; q < RPI; ++q) { const int m = m0 + q * NGW;
                if (m < MV) { const f32x4* xr = (const f32x4*)(m < MP ? a.in[0] + (size_t)m * D : a.in[1] + (size_t)(m - MP) * D) + lane;
#pragma unroll
                    for (int j = 0; j < 4; ++j) v[q][j] = __builtin_nontemporal_load(xr + 64 * j); }
                else {
#pragma unroll
                    for (int j = 0; j < 4; ++j) v[q][j] = (f32x4){0.f, 0.f, 0.f, 0.f}; } }
            f32x4 gg[4];
#pragma unroll
            for (int j = 0; j < 4; ++j) gg[j] = ((const f32x4*)g1)[lane + 64 * j];
#pragma unroll
            for (int q = 0; q < RPI; ++q) { const int m = m0 + q * NGW;
                if (m < MPAD) { float sq = 0.f;
#pragma unroll
                    for (int j = 0; j < 4; ++j) sq += (v[q][j].x * v[q][j].x + v[q][j].y * v[q][j].y) + (v[q][j].z * v[q][j].z + v[q][j].w * v[q][j].w);
                    const float rstd = __builtin_amdgcn_rsqf(wave_sum(sq) * (1.f / D) + EPS);
                    unsigned long long* o8 = (unsigned long long*)(RA + (size_t)m * D) + lane;
#pragma unroll
                    for (int j = 0; j < 4; ++j)
                        o8[64 * j] = (unsigned long long)cvt_pk_bf16(v[q][j].x * rstd * gg[j].x, v[q][j].y * rstd * gg[j].y) | ((unsigned long long)cvt_pk_bf16(v[q][j].z * rstd * gg[j].z, v[q][j].w * rstd * gg[j].w) << 32);
                    if (m >= MV) { unsigned long long* y8 = (unsigned long long*)(RB + (size_t)m * D) + lane;
#pragma unroll
                        for (int j = 0; j < 4; ++j) y8[64 * j] = 0ull; } } }
        }
        for (int i = vcu * 512 + tid; i < MPAD; i += G * 512) SUMSQ[i] = 0.f;
    }
    SEAM(0);
    if (IN(1)) {
        pg8::Gemm g{RA, WIN, D, D, D, 0, -1}; pg8::StaticOrder S; S.init(MPAD, INW, G, bx, 1 + ((DUP_MASK >> 1) & 1));
        pg8::gemm_phase(lds, g, S, pg8::EpiZ{Z});
        { const int maxper = (S.nwg + G - 1) / G, rem = S.nwg - (maxper - 1) * G; const bool all = rem >= G; const int nid = all ? G : G - rem, rk = all ? bx : bx - rem;
            if (rk >= 0) { LAS float* scr = (LAS float*)(lds + wave * 16384);
                constexpr int I_CAT = 16 * 32, I_OUT = 16 * 32, I_GU = 16 * 176, I_DN = 44 * 32;
                for (int it = rk * 8 + wave; it < I_CAT + I_OUT + I_GU + I_DN; it += nid * 8) {
                    int r = it;
                    if (r < I_CAT) { transpose_item(SrcCat{a.in[12], a.in[13]}, WCAT, D, 32, r, scr, lane); continue; } r -= I_CAT;
                    if (r < I_OUT) { transpose_item(SrcPlain{a.in[14], D}, WOUT, D, 32, r, scr, lane); continue; } r -= I_OUT;
                    if (r < I_GU) { transpose_item(SrcGU{a.in[16], a.in[17], a.in[15]}, WGU, D, 176, r, scr, lane); continue; } r -= I_GU;
                    transpose_item(SrcPlain{a.in[18], D}, WDN, FF, 32, r, scr, lane);
                }
                roll_copies(a, rk * 512 + tid, nid * 512); } }
    }
    SEAM(1);
    if (IN(2)) REP(2) {
        for (int u = vcu; u < 256; u += G) attn_prompt_unit(a, lds, u);
        if (wave < 4) { for (int su = vcu; su < 2 * NS; su += G) attn_sample_unit(a, lds, su); }
        for (int bb = 2 * vcu; bb < MP / 32; bb += 2 * G) {
            const int blk = bb + (wave & 1), g = wave < 4 ? (wave >> 1) : 2 + ((wave - 4) >> 1);
            pool_one(a, lds + wave * 16384, blk, g, lane);
        }
        if (wave == 4) { for (int lt = vcu; lt < (NS / 32) * 4; lt += G) pool_one(a, lds + wave * 16384, MP / 32 + (lt >> 2), lt & 3, lane); }
    }
    SEAM(2);
    if (IN(4)) {
        pg8::Gemm g{RB, WCAT, D, D, D, 0, 8}; pg8::StaticOrder S; S.init(MP, D, G, bx, 1 + ((DUP_MASK >> 4) & 1));
        pg8::gemm_phase(lds, g, S, pg8::EpiMerge{Z, RA});

        for (int sr_ = 0; sr_ < 1 + SMALL_REP; ++sr_) small_gemm<8>(lds, RB + (size_t)MP * D, D, WCAT, D, D, vcu, G, SEpiMerge{Z, RA});    }
    SEAM(4);
    if (IN(5)) {
        pg8::Gemm g{RA, WOUT, D, D, D, 0, -1}; pg8::StaticOrder S; S.init(MP, D, G, bx, 1 + ((DUP_MASK >> 5) & 1));
        pg8::gemm_phase(lds, g, S, pg8::EpiX1{a.in[0], a.in[1], a.out + O_Y, RB, SUMSQ});

        small_gemm<8>(lds, RA + (size_t)MP * D, D, WOUT, D, D, vcu, G, SEpiX1{a.in[1], a.out + O_Y, RB, SUMSQ});    }
    SEAM(5);
    if (IN(6)) {
        pg8::Gemm g{RB, WGU, D, D, D, 0, -1}; pg8::StaticOrder S; S.init(MPAD, 2 * FF, G, bx, 1 + ((DUP_MASK >> 6) & 1));
        pg8::gemm_phase(lds, g, S, pg8::EpiAct{SUMSQ, Z});
    }
    SEAM(6);
    if (IN(7)) {
        pg8::Gemm g{Z, WDN, FF, FF, FF, 0, -1}; pg8::StaticOrder S; S.init(MP, D, G, bx, 1 + ((DUP_MASK >> 7) & 1));
        pg8::gemm_phase(lds, g, S, pg8::EpiY{RB, a.out + O_Y});

        small_gemm<22>(lds, Z + (size_t)MP * FF, FF, WDN, FF, FF, vcu, G, SEpiY{RB, a.out + O_Y});    }
    if (AMP_PHASE == 7 || AMP_PHASE == 99) { asm volatile("s_waitcnt vmcnt(0)" ::: "memory"); __syncthreads(); AMP(7); }
#undef IN
#undef SEAM
}

#ifndef MK_N_LAUNCHES
#define MK_N_LAUNCHES 1
#endif
extern "C" void kernel_launch(void* const* d_in, const int* in_sizes, int n_in, void* d_out, int out_size, void* d_ws, size_t ws_size, hipStream_t stream) {
    static int grid = 0;
    if (grid == 0) {
        int dev = 0, cus = 0, per_cu = 0;
        if (n_in != 19 || ws_size < WS_END) { fprintf(stderr, "kernel_launch: unexpected inputs (n_in %d, ws %zu)\n", n_in, ws_size); grid = -1; return; }
        hipGetDevice(&dev); hipDeviceGetAttribute(&cus, hipDeviceAttributeMultiprocessorCount, dev);
        if (hipFuncSetAttribute((const void*)fwd_megakernel, hipFuncAttributeMaxDynamicSharedMemorySize, LDS_BYTES) != hipSuccess) { fprintf(stderr, "kernel_launch: hipFuncSetAttribute failed\n"); grid = -1; return; }
        if (hipOccupancyMaxActiveBlocksPerMultiprocessor(&per_cu, (const void*)fwd_megakernel, 512, LDS_BYTES) != hipSuccess || per_cu < 1) { fprintf(stderr, "kernel_launch: occupancy query says %d\n", per_cu); per_cu = 1; }
        (void)hipGetLastError();
        grid = cus * 1;
        if (per_cu < 1) grid = -1;
    }
    if (grid < 0) return;
    if (hipMemsetAsync((char*)d_ws + WS_BAR, 0, WS_BAR_BYTES, stream) != hipSuccess) { fprintf(stderr, "kernel_launch: memset failed\n"); return; }
    Args a{};
    for (int i = 0; i < 19; ++i) a.in[i] = (const float*)d_in[i];
    a.out = (float*)d_out; a.ws = (unsigned char*)d_ws;
#if MK_N_LAUNCHES == 1
    a.ph_lo = 0; a.ph_hi = 8;
    hipLaunchKernelGGL(fwd_megakernel, dim3(grid), dim3(512), LDS_BYTES, stream, a);
    if (hipPeekAtLastError() != hipSuccess) fprintf(stderr, "kernel_launch: launch failed (grid %d)\n", grid);
#else
    for (int p = 0; p < 8; ++p) { a.ph_lo = p; a.ph_hi = p + 1; hipLaunchKernelGGL(fwd_megakernel, dim3(grid), dim3(512), LDS_BYTES, stream, a); }
#endif
}
```

```cpp
#include <hip/hip_runtime.h>
#include <hip/hip_cooperative_groups.h>
#include <cstdio>
#include <cstdint>
namespace cg = cooperative_groups;

#define LAS __attribute__((address_space(3)))
#ifndef AMP_PHASE
#define AMP_PHASE -1
#endif
typedef unsigned short bf16_t;
typedef short bf16x8 __attribute__((ext_vector_type(8)));
typedef short s16x4 __attribute__((ext_vector_type(4)));
typedef float f32x4 __attribute__((ext_vector_type(4)));
typedef float f32x16 __attribute__((ext_vector_type(16)));
typedef unsigned u32x4 __attribute__((ext_vector_type(4)));
typedef unsigned u32x2 __attribute__((ext_vector_type(2)));

constexpr int D = 1024, SEQ = 2048, NB = 8, MP = NB * SEQ, NS = 128, MV = MP + NS, MPAD = 16640;
constexpr int INW = 3328, FF = 2816, PW = 512;
constexpr int ZC_Q = 512, ZC_K = 1024, ZC_V = 1152, ZC_GA = 1280, ZC_GB = 2304;
constexpr float EPS = 1e-6f;
constexpr float LOG2E = 1.4426950408889634f;
constexpr float C2 = 0.125f * LOG2E;
constexpr size_t O_Y = 0, O_KP = 16908288, O_VP = 17039360, O_PP = 17170432, O_KS = 17231872, O_VS = 19329024, O_PS = 21426176;
constexpr size_t MiB = 1u << 20;
constexpr size_t WS_SUMSQ = 0;
constexpr size_t WS_SPOOL = 1 * MiB + 65536;
constexpr size_t WS_BAR = 1 * MiB, WS_BAR_BYTES = 16384;
constexpr size_t WS_WIN = 2 * MiB, WS_MIX = 9 * MiB, WS_WCAT = 10 * MiB, WS_WOUT = 12 * MiB, WS_WGU = 14 * MiB, WS_WDN = 25 * MiB;
constexpr size_t WS_RA = 32 * MiB;
constexpr size_t WS_RB = 65 * MiB;
constexpr size_t WS_YPRE = 98 * MiB;
constexpr size_t WS_Z = 115 * MiB;
constexpr size_t WS_END = 222 * MiB;
constexpr int LDS_BYTES = 147456;
constexpr int LDS_MISC = 135168;

__device__ __forceinline__ unsigned cvt_pk_bf16(float lo, float hi) { unsigned r; asm("v_cvt_pk_bf16_f32 %0, %1, %2" : "=v"(r) : "v"(lo), "v"(hi)); return r; }
__device__ __forceinline__ float bflo(unsigned u) { return __uint_as_float(u << 16); }
__device__ __forceinline__ float bfhi(unsigned u) { return __uint_as_float(u & 0xffff0000u); }
__device__ __forceinline__ float bf1(bf16_t u) { return __uint_as_float(((unsigned)u) << 16); }
__device__ __forceinline__ float fsigmoid(float x) { return __builtin_amdgcn_rcpf(1.0f + __builtin_amdgcn_exp2f(-x * LOG2E)); }
__device__ __forceinline__ float wave_sum(float v) {
#pragma unroll
    for (int o = 1; o < 64; o <<= 1) v += __shfl_xor(v, o);
    return v;
}
__device__ __forceinline__ float wave_max(float v) {
#pragma unroll
    for (int o = 1; o < 64; o <<= 1) v = fmaxf(v, __shfl_xor(v, o));
    return v;
}
#define LDS_WAIT() asm volatile("s_waitcnt lgkmcnt(0)" ::: "memory")

namespace pg8 {
constexpr int BM = 256, BK = 64, HALF = 128, HTB = HALF * BK * 2, STAGE_BYTES = 8 * HTB, NXCD = 8, WGM = 8;
__host__ __device__ __forceinline__ int lds_byte(int r, int c) { const int st = (r >> 4) * 2 + (c >> 5), rr = r & 15, cc = c & 31, ob = rr * 64 + cc * 2; return st * 1024 + (ob ^ (((ob >> 9) & 1) << 5)); }
__host__ __device__ __forceinline__ void stage_rc(int b, int& R, int& C) { const int st = b / 1024, sb = b % 1024, swz = sb ^ (((sb >> 9) & 1) << 5); R = (st >> 1) * 16 + swz / 64; C = (st & 1) * 32 + (swz % 64) / 2; }
__host__ __device__ __forceinline__ int perm32(int rho) { const int n = rho >> 4, i = rho & 15; return 8 * (i >> 2) + 4 * n + (i & 3); }

struct Unit { int pm, pn, last; };
struct Gemm { const bf16_t* A; const bf16_t* Bt; int lda, ldb, K, a_pn_bytes, midt; };

struct StaticOrder {
    int nM, nN, nwg, G, c, per, reps;
    __device__ void init(int M, int N, int G_, int c_, int reps_ = 1) { nM = M / BM; nN = N / BM; nwg = nM * nN; G = G_; c = c_; per = c < nwg ? (nwg - c + G - 1) / G : 0; reps = reps_; }
    __device__ bool next(int i, Unit& u) const {
        if (i >= per * reps) return false;
        const int pass = i / per; u.last = (pass == reps - 1);
        const long L = (long)(i - pass * per) * G + c;
        int wgid = (int)L; { const int q = nwg / NXCD, r = nwg % NXCD, xcd = wgid % NXCD, off = wgid / NXCD; wgid = (xcd < r ? xcd * (q + 1) : r * (q + 1) + (xcd - r) * q) + off; }
        const int nig = WGM * nN, gid = wgid / nig, fm = gid * WGM, gsz = (nM - fm) < WGM ? (nM - fm) : WGM;
        u.pm = fm + ((wgid % nig) % gsz); u.pn = (wgid % nig) / gsz; return true;
    }
};

template <class Epi>
__device__ __forceinline__ void gemm_phase(LAS unsigned char* lds, const Gemm g, const StaticOrder& S, const Epi& E) {
    const int tid = threadIdx.x, wid = __builtin_amdgcn_readfirstlane(tid >> 6), lane = tid & 63, wr = wid >> 2, wc = wid & 3, fr = lane & 15, fq = lane >> 4;
    const int K = g.K, nt = K / BK;
    unsigned voffA[2], voffB[2];
#pragma unroll
    for (int i = 0; i < 2; ++i) { int R, C; stage_rc(tid * 16 + i * 8192, R, C); const int Rb = (R & ~31) + perm32(R & 31);
        voffA[i] = (unsigned)(R * g.lda + C) * 2u; voffB[i] = (unsigned)(Rb * g.ldb + C) * 2u; }
    const size_t kstep = (size_t)(BK * 2);
    const size_t hstepA = (size_t)HALF * g.lda * 2, hstepB = (size_t)HALF * g.ldb * 2;
    const size_t tstepA = 2 * hstepA, tstepB = 2 * hstepB;
    const unsigned ldsw = (unsigned)wid * 1024u;
    const int aoff = lds_byte(wr * 64 + fr, fq * 8), boff = lds_byte(wc * 32 + fr, fq * 8);
#define PG8_SA(b, h) (((b) * 2 + (h)) * HTB)
#define PG8_SB(b, h) ((4 + (b) * 2 + (h)) * HTB)
#define PG8_STAGE(bufoff, gbase, voff) do { _Pragma("unroll") for (int _i = 0; _i < 2; ++_i) \
        __builtin_amdgcn_global_load_lds((const unsigned*)((const char*)(gbase) + (voff)[_i]), (LAS unsigned*)(lds + (bufoff) + ldsw + _i * 8192), 16, 0, 0); } while (0)
#define PG8_LDA(dst, b, h) do { _Pragma("unroll") for (int m = 0; m < 4; ++m) _Pragma("unroll") for (int k = 0; k < 2; ++k) dst[m][k] = *(const LAS bf16x8*)(lds + PG8_SA(b, h) + aoff + m * 2048 + k * 1024); } while (0)
#define PG8_LDB(dst, b, h) do { _Pragma("unroll") for (int n = 0; n < 2; ++n) _Pragma("unroll") for (int k = 0; k < 2; ++k) dst[n][k] = *(const LAS bf16x8*)(lds + PG8_SB(b, h) + boff + n * 2048 + k * 1024); } while (0)
#define PG8_MMA(ai, bj, At, Bt) do { __builtin_amdgcn_s_setprio(1); _Pragma("unroll") for (int m = 0; m < 4; ++m) _Pragma("unroll") for (int n = 0; n < 2; ++n) _Pragma("unroll") for (int k = 0; k < 2; ++k) \
        acc[ai][bj][m][n] = __builtin_amdgcn_mfma_f32_16x16x32_bf16(Bt[n][k], At[m][k], acc[ai][bj][m][n], 0, 0, 0); __builtin_amdgcn_s_setprio(0); } while (0)
#define PG8_WAIT_V(n) asm volatile("s_waitcnt vmcnt(" #n ")" ::: "memory")
#define PG8_WAIT_L(n) asm volatile("s_waitcnt lgkmcnt(" #n ")" ::: "memory")
#define PG8_BAR __builtin_amdgcn_s_barrier()
#define PG8_SCHED __builtin_amdgcn_sched_barrier(0)
    Unit cur, nxt; int ui = 0;
    if (!S.next(0, cur)) return;
    f32x4 acc[2][2][4][2];
#pragma unroll
    for (int a = 0; a < 2; ++a)
#pragma unroll
        for (int b = 0; b < 2; ++b)
#pragma unroll
            for (int m = 0; m < 4; ++m)
#pragma unroll
                for (int n = 0; n < 2; ++n) acc[a][b][m][n] = (f32x4){0.f, 0.f, 0.f, 0.f};
    bf16x8 At[4][2], B0[2][2], B1[2][2];
    const char* cA = (const char*)g.A + (size_t)cur.pm * tstepA + (size_t)cur.pn * g.a_pn_bytes; const char* cB = (const char*)g.Bt + (size_t)cur.pn * tstepB;
    PG8_STAGE(PG8_SB(0, 0), cB, voffB); PG8_STAGE(PG8_SB(0, 1), cB + hstepB, voffB); PG8_STAGE(PG8_SA(0, 0), cA, voffA); PG8_STAGE(PG8_SA(0, 1), cA + hstepA, voffA);
    if (wr == 1) PG8_BAR;
    PG8_WAIT_V(2); PG8_BAR;
    PG8_STAGE(PG8_SB(1, 0), cB + kstep, voffB); PG8_STAGE(PG8_SA(1, 0), cA + kstep, voffA); PG8_STAGE(PG8_SB(1, 1), cB + hstepB + kstep, voffB);
    PG8_WAIT_V(6); PG8_BAR;
    for (;;) {
        const bool has_next = S.next(ui + 1, nxt);
        const char* nA = has_next ? (const char*)g.A + (size_t)nxt.pm * tstepA + (size_t)nxt.pn * g.a_pn_bytes : cA; const char* nB = has_next ? (const char*)g.Bt + (size_t)nxt.pn * tstepB : cB;
#pragma unroll 1
        for (int t = 0; t < nt; t += 2) {
            const bool last = (t == nt - 2);
            if constexpr (Epi::HAS_MID) { if (t == g.midt) { E.mid(acc, cur, wr, wc, fr, fq); } PG8_SCHED; }
            const char* a1 = cA + (size_t)(t + 1) * kstep;
            const char* a2 = last ? nA : cA + (size_t)(t + 2) * kstep; const char* b2 = last ? nB : cB + (size_t)(t + 2) * kstep;
            const char* a3 = a2 + kstep; const char* b3 = b2 + kstep;
            PG8_LDB(B0, 0, 0); PG8_LDB(B1, 0, 1); PG8_SCHED; PG8_LDA(At, 0, 0); PG8_STAGE(PG8_SA(1, 1), a1 + hstepA, voffA);
            PG8_WAIT_V(8); PG8_WAIT_L(0); PG8_BAR; PG8_MMA(0, 0, At, B0); PG8_MMA(0, 1, At, B1); PG8_BAR; PG8_SCHED;
            PG8_LDA(At, 0, 1); PG8_STAGE(PG8_SB(0, 0), b2, voffB); PG8_STAGE(PG8_SB(0, 1), b2 + hstepB, voffB); PG8_STAGE(PG8_SA(0, 0), a2, voffA);
            PG8_WAIT_V(8); PG8_WAIT_L(0); PG8_BAR; PG8_MMA(1, 0, At, B0); PG8_MMA(1, 1, At, B1); PG8_BAR; PG8_SCHED;
            PG8_LDB(B0, 1, 0); PG8_LDB(B1, 1, 1); PG8_SCHED; PG8_LDA(At, 1, 0); PG8_STAGE(PG8_SA(0, 1), a2 + hstepA, voffA);
            PG8_WAIT_V(8); PG8_WAIT_L(0); PG8_BAR; PG8_MMA(0, 0, At, B0); PG8_MMA(0, 1, At, B1); PG8_BAR; PG8_SCHED;
            PG8_LDA(At, 1, 1); PG8_STAGE(PG8_SB(1, 0), b3, voffB); PG8_STAGE(PG8_SB(1, 1), b3 + hstepB, voffB); PG8_STAGE(PG8_SA(1, 0), a3, voffA);
            PG8_WAIT_V(8); PG8_WAIT_L(0); PG8_BAR; PG8_MMA(1, 0, At, B0); PG8_MMA(1, 1, At, B1); PG8_BAR; PG8_SCHED;
        }
        if (wr == 0) PG8_BAR;
        E(acc, cur, wr, wc, fr, fq);
        if (!has_next) break;
#pragma unroll
        for (int a = 0; a < 2; ++a)
#pragma unroll
            for (int b = 0; b < 2; ++b)
#pragma unroll
                for (int m = 0; m < 4; ++m)
#pragma unroll
                    for (int n = 0; n < 2; ++n) acc[a][b][m][n] = (f32x4){0.f, 0.f, 0.f, 0.f};
        cur = nxt; cA = nA; cB = nB; ++ui;
        if (wr == 1) PG8_BAR;
    }
    PG8_WAIT_V(0);
    PG8_BAR;
#undef PG8_SA
#undef PG8_SB
#undef PG8_STAGE
#undef PG8_LDA
#undef PG8_LDB
#undef PG8_MMA
#undef PG8_WAIT_V
#undef PG8_WAIT_L
#undef PG8_BAR
#undef PG8_SCHED
}

typedef f32x4 Acc[2][2][4][2];
__device__ __forceinline__ u32x4 pack8(const f32x4 v0, const f32x4 v1) { u32x4 w; w.x = cvt_pk_bf16(v0[0], v0[1]); w.y = cvt_pk_bf16(v0[2], v0[3]); w.z = cvt_pk_bf16(v1[0], v1[1]); w.w = cvt_pk_bf16(v1[2], v1[3]); return w; }

struct EpiZ {
    static constexpr bool HAS_MID = false;
    bf16_t* Z;
    __device__ __forceinline__ void operator()(Acc& acc, const Unit& u, int wr, int wc, int fr, int fq) const {
        int row0 = u.pm * BM + wr * 64 + fr; asm volatile("" : "+v"(row0)); const int col0 = u.pn * BM + wc * 32 + 8 * fq; const bool sig = u.pn >= 5;
#pragma unroll
        for (int ai = 0; ai < 2; ++ai)
#pragma unroll
            for (int m = 0; m < 4; ++m) { bf16_t* rowp = Z + (size_t)(row0 + ai * HALF + m * 16) * INW + col0;
                f32x4 a0 = acc[ai][0][m][0], a1 = acc[ai][0][m][1], b0 = acc[ai][1][m][0], b1 = acc[ai][1][m][1];
                if (sig) {
#pragma unroll
                    for (int e = 0; e < 4; ++e) { const float ea0 = __builtin_amdgcn_exp2f(-a0[e] * LOG2E), eb0 = __builtin_amdgcn_exp2f(-b0[e] * LOG2E), ea1 = __builtin_amdgcn_exp2f(-a1[e] * LOG2E), eb1 = __builtin_amdgcn_exp2f(-b1[e] * LOG2E);
                        a0[e] = (1.0f + eb0) * __builtin_amdgcn_rcpf(1.0f + ea0); b0[e] = __builtin_amdgcn_rcpf(1.0f + eb0);
                        a1[e] = (1.0f + eb1) * __builtin_amdgcn_rcpf(1.0f + ea1); b1[e] = __builtin_amdgcn_rcpf(1.0f + eb1); } }
                *(u32x4*)(rowp) = pack8(a0, a1); *(u32x4*)(rowp + HALF) = pack8(b0, b1); }
    }
};
struct EpiBf {
    static constexpr bool HAS_MID = false;
    bf16_t* O; int ldc;
    __device__ __forceinline__ void operator()(Acc& acc, const Unit& u, int wr, int wc, int fr, int fq) const {
        int row0 = u.pm * BM + wr * 64 + fr; asm volatile("" : "+v"(row0)); const int col0 = u.pn * BM + wc * 32 + 8 * fq;
#pragma unroll
        for (int ai = 0; ai < 2; ++ai)
#pragma unroll
            for (int m = 0; m < 4; ++m) { bf16_t* rowp = O + (size_t)(row0 + ai * HALF + m * 16) * ldc + col0;
#pragma unroll
                for (int bj = 0; bj < 2; ++bj) *(u32x4*)(rowp + bj * HALF) = pack8(acc[ai][bj][m][0], acc[ai][bj][m][1]); }
    }
};
struct EpiMerge {
    static constexpr bool HAS_MID = true;
    const bf16_t* Z; bf16_t* O;
    __device__ __forceinline__ void mid(Acc& acc, const Unit& u, int wr, int wc, int fr, int fq) const {
        int row0 = u.pm * BM + wr * 64 + fr; asm volatile("" : "+v"(row0)); const int zc0 = ZC_GA + 512 * u.pn + wc * 32 + 8 * fq;
        u32x4 gw[2][4][2];
#pragma unroll
        for (int ai = 0; ai < 2; ++ai)
#pragma unroll
            for (int m = 0; m < 4; ++m) { const bf16_t* zr = Z + (size_t)(row0 + ai * HALF + m * 16) * INW + zc0;
#pragma unroll
                for (int bj = 0; bj < 2; ++bj) gw[ai][m][bj] = *(const u32x4*)(zr + 256 * bj); }
#pragma unroll
        for (int ai = 0; ai < 2; ++ai)
#pragma unroll
            for (int m = 0; m < 4; ++m)
#pragma unroll
                for (int bj = 0; bj < 2; ++bj) { const u32x4 a = gw[ai][m][bj];
#pragma unroll
                    for (int e = 0; e < 4; ++e) { acc[ai][bj][m][e >> 1][(e & 1) * 2] *= bflo(a[e]); acc[ai][bj][m][e >> 1][(e & 1) * 2 + 1] *= bfhi(a[e]); } }
    }
    __device__ __forceinline__ void operator()(Acc& acc, const Unit& u, int wr, int wc, int fr, int fq) const {
        int row0 = u.pm * BM + wr * 64 + fr; asm volatile("" : "+v"(row0)); const int col0 = u.pn * BM + wc * 32 + 8 * fq, zc0 = ZC_GA + 512 * u.pn + wc * 32 + 8 * fq + 128;
        u32x4 gw[2][4][2];
#pragma unroll
        for (int ai = 0; ai < 2; ++ai)
#pragma unroll
            for (int m = 0; m < 4; ++m) { const bf16_t* zr = Z + (size_t)(row0 + ai * HALF + m * 16) * INW + zc0;
#pragma unroll
                for (int bj = 0; bj < 2; ++bj) gw[ai][m][bj] = *(const u32x4*)(zr + 256 * bj); }
#pragma unroll
        for (int ai = 0; ai < 2; ++ai)
#pragma unroll
            for (int m = 0; m < 4; ++m) { bf16_t* rowp = O + (size_t)(row0 + ai * HALF + m * 16) * D + col0;
#pragma unroll
                for (int bj = 0; bj < 2; ++bj) { const u32x4 b = gw[ai][m][bj]; f32x4 v0 = acc[ai][bj][m][0], v1 = acc[ai][bj][m][1];
                    v0[0] *= bflo(b[0]); v0[1] *= bfhi(b[0]); v0[2] *= bflo(b[1]); v0[3] *= bfhi(b[1]); v1[0] *= bflo(b[2]); v1[1] *= bfhi(b[2]); v1[2] *= bflo(b[3]); v1[3] *= bfhi(b[3]);
                    *(u32x4*)(rowp + bj * HALF) = pack8(v0, v1); } }
    }
};
struct EpiX1 {
    static constexpr bool HAS_MID = false;
    const float* xp; const float* xs; float* out; bf16_t* X1B; float* sumsq;
    __device__ __forceinline__ void operator()(Acc& acc, const Unit& u, int wr, int wc, int fr, int fq) const {
        if (!u.last) return;
        int row0 = u.pm * BM + wr * 64 + fr; asm volatile("" : "+v"(row0)); const int col0 = u.pn * BM + wc * 32 + 8 * fq;
#pragma unroll
        for (int ai = 0; ai < 2; ++ai) {
            f32x4 xv[4][2][2];
#pragma unroll
            for (int m = 0; m < 4; ++m) { const int row = row0 + ai * HALF + m * 16; const bool valid = row < MV;
                const float* xr = (row < MP ? xp + (size_t)row * D : xs + (size_t)(valid ? row - MP : 0) * D) + col0;
#pragma unroll
                for (int bj = 0; bj < 2; ++bj) { xv[m][bj][0] = valid ? __builtin_nontemporal_load((const f32x4*)(xr + bj * HALF)) : (f32x4){0.f, 0.f, 0.f, 0.f}; xv[m][bj][1] = valid ? __builtin_nontemporal_load((const f32x4*)(xr + bj * HALF + 4)) : (f32x4){0.f, 0.f, 0.f, 0.f}; } }
#pragma unroll
            for (int m = 0; m < 4; ++m) { const int row = row0 + ai * HALF + m * 16; float ss = 0.f;
#pragma unroll
                for (int bj = 0; bj < 2; ++bj) { const f32x4 v0 = acc[ai][bj][m][0] + xv[m][bj][0], v1 = acc[ai][bj][m][1] + xv[m][bj][1];
                    ss += (v0[0] * v0[0] + v0[1] * v0[1]) + (v0[2] * v0[2] + v0[3] * v0[3]) + (v1[0] * v1[0] + v1[1] * v1[1]) + (v1[2] * v1[2] + v1[3] * v1[3]);
                    *(u32x4*)(X1B + (size_t)row * D + col0 + bj * HALF) = pack8(v0, v1); }
                ss += __shfl_xor(ss, 16); ss += __shfl_xor(ss, 32);
                if (fq == 0) atomicAdd(sumsq + row, ss); }
            asm volatile("" ::: "memory"); }
    }
};
struct EpiAct {
    static constexpr bool HAS_MID = false;
    const float* sumsq; bf16_t* ACT;
    __device__ __forceinline__ void operator()(Acc& acc, const Unit& u, int wr, int wc, int fr, int fq) const {
        int row0 = u.pm * BM + wr * 64 + fr; asm volatile("" : "+v"(row0)); const int col0 = u.pn * HALF + wc * 32 + 8 * fq;
        float rs[2][4];
#pragma unroll
        for (int ai = 0; ai < 2; ++ai)
#pragma unroll
            for (int m = 0; m < 4; ++m) rs[ai][m] = sumsq[row0 + ai * HALF + m * 16];
#pragma unroll
        for (int ai = 0; ai < 2; ++ai)
#pragma unroll
            for (int m = 0; m < 4; ++m) { const int row = row0 + ai * HALF + m * 16; const float rstd = __builtin_amdgcn_rsqf(rs[ai][m] * (1.0f / D) + EPS);
                f32x4 o[2];
#pragma unroll
                for (int n = 0; n < 2; ++n)
#pragma unroll
                    for (int e = 0; e < 4; ++e) { const float gt = acc[ai][0][m][n][e] * rstd, up = acc[ai][1][m][n][e] * rstd; o[n][e] = gt * up * fsigmoid(gt); }
                *(u32x4*)(ACT + (size_t)row * FF + col0) = pack8(o[0], o[1]); }
    }
};
struct EpiY {
    static constexpr bool HAS_MID = false;
    const bf16_t* X1B; float* out;
    __device__ __forceinline__ void operator()(Acc& acc, const Unit& u, int wr, int wc, int fr, int fq) const {
        if (!u.last) return;
        int row0 = u.pm * BM + wr * 64 + fr; asm volatile("" : "+v"(row0)); const int col0 = u.pn * BM + wc * 32 + 8 * fq;
        u32x4 xw[2][4][2];
#pragma unroll
        for (int ai = 0; ai < 2; ++ai)
#pragma unroll
            for (int m = 0; m < 4; ++m) { const int row = row0 + ai * HALF + m * 16; const bf16_t* xr = X1B + (size_t)row * D + col0;
#pragma unroll
                for (int bj = 0; bj < 2; ++bj) xw[ai][m][bj] = *(const u32x4*)(xr + bj * HALF); }
#pragma unroll
        for (int ai = 0; ai < 2; ++ai)
#pragma unroll
            for (int m = 0; m < 4; ++m) { const int row = row0 + ai * HALF + m * 16;
                if (row < MV) { float* orow = out + (size_t)row * D + col0;
#pragma unroll
                    for (int bj = 0; bj < 2; ++bj) { const u32x4 x = xw[ai][m][bj];
                        *(f32x4*)(orow + bj * HALF) = (f32x4){bflo(x[0]), bfhi(x[0]), bflo(x[1]), bfhi(x[1])} + acc[ai][bj][m][0];
                        *(f32x4*)(orow + bj * HALF + 4) = (f32x4){bflo(x[2]), bfhi(x[2]), bflo(x[3]), bfhi(x[3])} + acc[ai][bj][m][1]; } } }
    }
};
}

struct SrcPlain { const float* W; int N; __device__ __forceinline__ float operator()(int k, int n) const { return __builtin_nontemporal_load(W + (size_t)k * N + n); } };
struct SrcWin { const float* W;
    __device__ __forceinline__ float operator()(int k, int n) const { int c = n; if (n >= ZC_GA) { const int t = (n - ZC_GA) >> 8, j = (n - ZC_GA) & 255; c = (j < 128 ? ZC_GA : ZC_GB) + 128 * t + (j & 127); } return __builtin_nontemporal_load(W + (size_t)k * INW + c); } };
struct SrcMix { const float* mix; const float* scale;
    __device__ __forceinline__ float operator()(int k, int n) const { return mix[((size_t)(n >> 7) * 128 + k) * 128 + (n & 127)] * scale[n]; } };
struct SrcCat { const float* wp; const float* wa;
    __device__ __forceinline__ float operator()(int k, int n) const { return __builtin_nontemporal_load(k < 512 ? wp + (size_t)k * D + n : wa + (size_t)(k - 512) * D + n); } };
struct SrcGU { const float* wg; const float* wu; const float* nrm;
    __device__ __forceinline__ float operator()(int k, int n) const { const int t = n >> 8, j = n & 255, col = 128 * t + (j & 127); const float* w = (const float*)((uintptr_t)wg + (uintptr_t)(j >> 7) * ((uintptr_t)wu - (uintptr_t)wg)); return __builtin_nontemporal_load(w + (size_t)k * FF + col) * nrm[k]; } };

template <class Src>
__device__ __forceinline__ void transpose_item(const Src src, bf16_t* WT, int ldk, int nblk, int item, LAS float* scr, int lane) {
    const int kb = item / nblk, nb = item % nblk, k0 = 64 * kb, n0 = 32 * nb;
    float tv[32];
#pragma unroll
    for (int i = 0; i < 32; ++i) tv[i] = src(k0 + 2 * i + (lane >> 5), n0 + (lane & 31));
#pragma unroll
    for (int i = 0; i < 32; ++i) scr[(2 * i + (lane >> 5)) * 33 + (lane & 31)] = tv[i];
    LDS_WAIT();
    const int c = lane & 7;
#pragma unroll
    for (int j = 0; j < 4; ++j) { const int n = (lane >> 3) + 8 * j; const LAS float* s = scr + (8 * c) * 33 + n;
        u32x4 o; o.x = cvt_pk_bf16(s[0 * 33], s[1 * 33]); o.y = cvt_pk_bf16(s[2 * 33], s[3 * 33]); o.z = cvt_pk_bf16(s[4 * 33], s[5 * 33]); o.w = cvt_pk_bf16(s[6 * 33], s[7 * 33]);
        *(u32x4*)(WT + (size_t)(n0 + n) * ldk + k0 + 8 * c) = o; }
    LDS_WAIT();
}

struct Args { const float* in[19]; float* out; unsigned char* ws; int ph_lo, ph_hi; };

template <int NSTEPS, class Epi>
__device__ __forceinline__ void small_gemm(LAS unsigned char* lds, const bf16_t* A, int lda, const bf16_t* Bt, int ldb, int K, int vcu, int G, const Epi& E) {
    const int tid = threadIdx.x, lane = tid & 63, wave = __builtin_amdgcn_readfirstlane(tid >> 6), fr = lane & 15, fq = lane >> 4, rh = wave & 1, ks = wave >> 1;
    const int kq = K >> 2;
    for (int u = vcu; u < 256; u += G) {
        const int r0 = 32 * (u & 3) + 16 * rh, n0 = 16 * (u >> 2);
        const bf16_t* ap = A + (size_t)(r0 + fr) * lda + ks * kq + 8 * fq; const bf16_t* bp = Bt + (size_t)(n0 + fr) * ldb + ks * kq + 8 * fq;
        f32x4 acc = (f32x4){0.f, 0.f, 0.f, 0.f};
        bf16x8 af[NSTEPS], bf[NSTEPS];
#pragma unroll
        for (int s = 0; s < NSTEPS; ++s) { af[s] = *(const bf16x8*)(ap + 32 * s); bf[s] = *(const bf16x8*)(bp + 32 * s); }
#pragma unroll
        for (int s = 0; s < NSTEPS; ++s) acc = __builtin_amdgcn_mfma_f32_16x16x32_bf16(bf[s], af[s], acc, 0, 0, 0);
        LAS f32x4* red = (LAS f32x4*)lds;
        red[(ks * 2 + rh) * 64 + lane] = acc;
        __syncthreads();
        if (ks == 0) { const f32x4 p0 = red[(0 * 2 + rh) * 64 + lane], p1 = red[(1 * 2 + rh) * 64 + lane], p2 = red[(2 * 2 + rh) * 64 + lane], p3 = red[(3 * 2 + rh) * 64 + lane];
            E(p0, p1, p2, p3, r0 + fr, n0 + 4 * fq, fq); }
        __syncthreads();
    }
}
struct SEpiMerge { const bf16_t* Z; bf16_t* O;
    __device__ __forceinline__ void operator()(f32x4 p0, f32x4 p1, f32x4 p2, f32x4 p3, int n, int c, int fq) const {
        const bf16_t* zr = Z + (size_t)(MP + n) * INW + ZC_GA + 256 * (c >> 7) + (c & 127); const u32x2 r = *(const u32x2*)zr, b = *(const u32x2*)(zr + 128);
        const f32x4 pool = p0 + p1, attn = p2 + p3;
        u32x2 w; w.x = cvt_pk_bf16(bflo(b.x) * (bflo(r.x) * pool[0] + attn[0]), bfhi(b.x) * (bfhi(r.x) * pool[1] + attn[1]));
        w.y = cvt_pk_bf16(bflo(b.y) * (bflo(r.y) * pool[2] + attn[2]), bfhi(b.y) * (bfhi(r.y) * pool[3] + attn[3]));
        *(u32x2*)(O + (size_t)(MP + n) * D + c) = w; } };
struct SEpiX1 { const float* xs; float* out; bf16_t* X1B; float* sumsq;
    __device__ __forceinline__ void operator()(f32x4 p0, f32x4 p1, f32x4 p2, f32x4 p3, int n, int c, int fq) const {
        const f32x4 v = *(const f32x4*)(xs + (size_t)n * D + c) + ((p0 + p1) + (p2 + p3));
        u32x2 w; w.x = cvt_pk_bf16(v[0], v[1]); w.y = cvt_pk_bf16(v[2], v[3]); *(u32x2*)(X1B + (size_t)(MP + n) * D + c) = w;
        float ss = (v[0] * v[0] + v[1] * v[1]) + (v[2] * v[2] + v[3] * v[3]); ss += __shfl_xor(ss, 16); ss += __shfl_xor(ss, 32);
        if (fq == 0) atomicAdd(sumsq + MP + n, ss); } };
struct SEpiY { const bf16_t* X1B; float* out;
    __device__ __forceinline__ void operator()(f32x4 p0, f32x4 p1, f32x4 p2, f32x4 p3, int n, int c, int fq) const {
        const u32x2 x = *(const u32x2*)(X1B + (size_t)(MP + n) * D + c);
        *(f32x4*)(out + (size_t)(MP + n) * D + c) = (f32x4){bflo(x.x), bfhi(x.x), bflo(x.y), bfhi(x.y)} + ((p0 + p1) + (p2 + p3)); } };

__device__ __forceinline__ int crow(int r, int hi) { return (r & 3) + 8 * (r >> 2) + 4 * hi; }
constexpr int KS_STRIDE = 144, VT_STRIDE = 520, LDS_VT = 256 * KS_STRIDE  , LDS_SMP = 131072;

__device__ __forceinline__ void attn_prompt_unit(const Args& a, LAS unsigned char* lds, int unit) {
    const int tid = threadIdx.x, lane = tid & 63, wave = __builtin_amdgcn_readfirstlane(tid >> 6);
    const int kh = unit & 1, qb = (unit >> 1) & 15, b = unit >> 5;
    const bf16_t* Z = (const bf16_t*)(a.ws + WS_Z); bf16_t* YY = (bf16_t*)(a.ws + WS_RB);
    const float* qnw = a.in[7]; const float* knw = a.in[8]; const float* sinks = a.in[9];
    const size_t rowbase = (size_t)b * SEQ; const int key0 = (qb - 1) * 128;
    const int hq = 4 * kh + (wave >> 1), ql = lane & 31, h = lane >> 5;
    u32x4 qraw[2][4];
#pragma unroll
    for (int gi = 0; gi < 2; ++gi) { const bf16_t* qp = Z + (rowbase + (size_t)qb * 128 + 32 * (2 * (wave & 1) + gi) + ql) * INW + ZC_Q + hq * 64 + 8 * h;
#pragma unroll
        for (int ds = 0; ds < 4; ++ds) qraw[gi][ds] = *(const u32x4*)(qp + 16 * ds); }
    u32x4 vraw[4];
#pragma unroll
    for (int i = 0; i < 4; ++i) { const int c = tid + 512 * i, key = c & 255, dch = c >> 8, pos = key0 + key;
        vraw[i] = (u32x4){0u, 0u, 0u, 0u};
        if (pos >= 0) vraw[i] = *(const u32x4*)(Z + (rowbase + pos) * INW + ZC_V + kh * 64 + 8 * dch); }
    {
        const int j = tid >> 1, half = tid & 1, pos = key0 + j; float v[32];
        if (pos >= 0) { const u32x4* src = (const u32x4*)(Z + (rowbase + pos) * INW + ZC_K + kh * 64 + 32 * half);
#pragma unroll
            for (int c = 0; c < 4; ++c) { const u32x4 w = src[c];
#pragma unroll
                for (int e = 0; e < 4; ++e) { v[c * 8 + 2 * e] = bflo(w[e]); v[c * 8 + 2 * e + 1] = bfhi(w[e]); } } }
        else {
#pragma unroll
            for (int i = 0; i < 32; ++i) v[i] = 0.f; }
        float ss = 0.f;
#pragma unroll
        for (int i = 0; i < 32; ++i) ss += v[i] * v[i];
        ss += __shfl_xor(ss, 1);
        const float rstd = __builtin_amdgcn_rsqf(ss * (1.0f / 64) + EPS);
#pragma unroll
        for (int c = 0; c < 8; ++c) { const f32x4 w = *(const f32x4*)(knw + 32 * half + 4 * c);
#pragma unroll
            for (int e = 0; e < 4; ++e) v[4 * c + e] = v[4 * c + e] * rstd * w[e]; }
        LAS u32x4* dst = (LAS u32x4*)(lds + j * KS_STRIDE + 64 * half);
#pragma unroll
        for (int c = 0; c < 4; ++c) { u32x4 w;
#pragma unroll
            for (int e = 0; e < 4; ++e) w[e] = cvt_pk_bf16(v[c * 8 + 2 * e], v[c * 8 + 2 * e + 1]);
            dst[c] = w; }
        if (qb == 15 && j >= 128) { float* o = a.out + O_KP + ((size_t)(b * 128 + (j - 128)) * 2 + kh) * 64 + 32 * half;
#pragma unroll
            for (int c = 0; c < 8; ++c) *(f32x4*)(o + 4 * c) = (f32x4){v[4 * c], v[4 * c + 1], v[4 * c + 2], v[4 * c + 3]}; }
    }
#pragma unroll
    for (int i = 0; i < 4; ++i) { const int c = tid + 512 * i, key = c & 255, dch = c >> 8, pos = key0 + key;
        const u32x4 w = vraw[i];
        LAS bf16_t* vt = (LAS bf16_t*)(lds + LDS_VT) + key;
#pragma unroll
        for (int e = 0; e < 4; ++e) { vt[(8 * dch + 2 * e) * (VT_STRIDE / 2)] = (bf16_t)(w[e] & 0xffffu); vt[(8 * dch + 2 * e + 1) * (VT_STRIDE / 2)] = (bf16_t)(w[e] >> 16); }
        if (qb == 15 && key >= 128) { float* o = a.out + O_VP + ((size_t)(b * 128 + (key - 128)) * 2 + kh) * 64 + 8 * dch;
            *(f32x4*)o = (f32x4){bflo(w[0]), bfhi(w[0]), bflo(w[1]), bfhi(w[1])}; *(f32x4*)(o + 4) = (f32x4){bflo(w[2]), bfhi(w[2]), bflo(w[3]), bfhi(w[3])}; } }
    __syncthreads();
    const float sink2 = sinks[hq] * LOG2E;
    f32x16 scs[2][5];
#pragma unroll
    for (int gi = 0; gi < 2; ++gi) {
        const int g = 2 * (wave & 1) + gi;
        bf16x8 qf[4];
        { float v[32];
#pragma unroll
            for (int ds = 0; ds < 4; ++ds) { const u32x4 w = qraw[gi][ds];
#pragma unroll
                for (int e = 0; e < 4; ++e) { v[ds * 8 + 2 * e] = bflo(w[e]); v[ds * 8 + 2 * e + 1] = bfhi(w[e]); } }
            float ss = 0.f;
#pragma unroll
            for (int i = 0; i < 32; ++i) ss += v[i] * v[i];
            ss += __shfl_xor(ss, 32);
            const float sc = __builtin_amdgcn_rsqf(ss * (1.0f / 64) + EPS) * C2;
#pragma unroll
            for (int ds = 0; ds < 4; ++ds) { const f32x4 w0 = *(const f32x4*)(qnw + 16 * ds + 8 * h), w1 = *(const f32x4*)(qnw + 16 * ds + 8 * h + 4); u32x4 p;
                p.x = cvt_pk_bf16(v[ds * 8 + 0] * sc * w0[0], v[ds * 8 + 1] * sc * w0[1]); p.y = cvt_pk_bf16(v[ds * 8 + 2] * sc * w0[2], v[ds * 8 + 3] * sc * w0[3]);
                p.z = cvt_pk_bf16(v[ds * 8 + 4] * sc * w1[0], v[ds * 8 + 5] * sc * w1[1]); p.w = cvt_pk_bf16(v[ds * 8 + 6] * sc * w1[2], v[ds * 8 + 7] * sc * w1[3]);
                qf[ds] = __builtin_bit_cast(bf16x8, p); } }
        __builtin_amdgcn_s_setprio(1);
#pragma unroll
        for (int i = 0; i < 5; ++i) { f32x16 acc = {};
#pragma unroll
            for (int ds = 0; ds < 4; ++ds) { const bf16x8 kf = *(const LAS bf16x8*)(lds + (32 * (g + i) + ql) * KS_STRIDE + 32 * ds + 16 * h);
                acc = __builtin_amdgcn_mfma_f32_32x32x16_bf16(kf, qf[ds], acc, 0, 0, 0); }
            scs[gi][i] = acc; }
        __builtin_amdgcn_s_setprio(0);
    }
    __builtin_amdgcn_sched_barrier(0);
#pragma unroll
    for (int gi = 0; gi < 2; ++gi) {
        const int g = 2 * (wave & 1) + gi; const size_t qrow = rowbase + (size_t)qb * 128 + 32 * g + ql;
        f32x16 (&sc)[5] = scs[gi];
        const int dsel = ql - 4 * h; float mx = -1e30f;
#pragma unroll
        for (int i = 0; i < 5; ++i) {
            if (qb == 0 && g + i < 4) {
#pragma unroll
                for (int r = 0; r < 16; ++r) sc[i][r] = -1e30f;
            } else {
#pragma unroll
                for (int r = 0; r < 16; ++r) { float s = sc[i][r];
                    if (i == 0) s = (crow(r, 0) >= dsel) ? s : -1e30f;
                    if (i == 4) s = (crow(r, 0) <= dsel) ? s : -1e30f;
                    sc[i][r] = s; mx = fmaxf(mx, s); } } }
        mx = fmaxf(mx, __shfl_xor(mx, 32));
        const float mref = fmaxf(mx, sink2); float lsum = 0.f;
#pragma unroll
        for (int i = 0; i < 5; ++i)
#pragma unroll
            for (int r = 0; r < 16; ++r) { const float p = __builtin_amdgcn_exp2f(sc[i][r] - mref); sc[i][r] = p; lsum += p; }
        lsum += __shfl_xor(lsum, 32);
        const float inv = 1.0f / (lsum + __builtin_amdgcn_exp2f(sink2 - mref));
        f32x16 o[2]; o[0] = (f32x16){}; o[1] = (f32x16){};
        __builtin_amdgcn_s_setprio(1);
#pragma unroll
        for (int i = 0; i < 5; ++i)
#pragma unroll
            for (int s2 = 0; s2 < 2; ++s2) { u32x4 pw;
#pragma unroll
                for (int e = 0; e < 4; ++e) pw[e] = cvt_pk_bf16(sc[i][8 * s2 + 2 * e], sc[i][8 * s2 + 2 * e + 1]);
                const bf16x8 pf = __builtin_bit_cast(bf16x8, pw);
#pragma unroll
                for (int dt = 0; dt < 2; ++dt) { const LAS unsigned char* vp = lds + LDS_VT + (32 * dt + ql) * VT_STRIDE + 2 * (32 * (g + i) + 16 * s2 + 4 * h);
                    const u32x2 lo = *(const LAS u32x2*)vp, hi2 = *(const LAS u32x2*)(vp + 16);
                    const u32x4 vw = (u32x4){lo.x, lo.y, hi2.x, hi2.y};
                    o[dt] = __builtin_amdgcn_mfma_f32_32x32x16_bf16(__builtin_bit_cast(bf16x8, vw), pf, o[dt], 0, 0, 0); } }
        __builtin_amdgcn_s_setprio(0);
        bf16_t* yp = YY + qrow * D + 512 + hq * 64 + 4 * h;
#pragma unroll
        for (int dt = 0; dt < 2; ++dt)
#pragma unroll
            for (int rq = 0; rq < 4; ++rq) { u32x2 w; w.x = cvt_pk_bf16(o[dt][4 * rq] * inv, o[dt][4 * rq + 1] * inv); w.y = cvt_pk_bf16(o[dt][4 * rq + 2] * inv, o[dt][4 * rq + 3] * inv);
                *(u32x2*)(yp + 32 * dt + 8 * rq) = w; }
        __builtin_amdgcn_sched_barrier(0);
    }
    __syncthreads();
}

__device__ __forceinline__ void attn_sample_unit(const Args& a, LAS unsigned char* lds, int su) {
    const int tid = threadIdx.x, lane = tid & 63, wave = __builtin_amdgcn_readfirstlane(tid >> 6);
    const int n = su >> 1, kh = su & 1;
    const float* ck = a.in[2] + (size_t)n * 16384; const float* cv = a.in[3] + (size_t)n * 16384;
    if (wave < 4) {
        const int hq = 4 * kh + wave;
        const bf16_t* zrow = (const bf16_t*)(a.ws + WS_Z) + (size_t)(MP + n) * INW; bf16_t* YY = (bf16_t*)(a.ws + WS_RB);
        LAS float* qs = (LAS float*)(lds + LDS_SMP + wave * 1024); LAS float* ps = qs + 64;
        const float xq = bf1(zrow[ZC_Q + hq * 64 + lane]); const float ssq = wave_sum(xq * xq);
        const float qn = xq * __builtin_amdgcn_rsqf(ssq * (1.0f / 64) + EPS) * a.in[7][lane] * C2;
        const float xk = bf1(zrow[ZC_K + kh * 64 + lane]); const float ssk = wave_sum(xk * xk);
        const float kn = xk * __builtin_amdgcn_rsqf(ssk * (1.0f / 64) + EPS) * a.in[8][lane];
        const float vn = bf1(zrow[ZC_V + kh * 64 + lane]);
        const float s_new = wave_sum(qn * kn);
        if (wave == 0) { a.out[O_KS + (size_t)n * 16384 + (127 * 2 + kh) * 64 + lane] = kn; a.out[O_VS + (size_t)n * 16384 + (127 * 2 + kh) * 64 + lane] = vn; }
        qs[lane] = qn; LDS_WAIT();
        float s0 = 0.f, s1 = 0.f;
        { const f32x4* k0 = (const f32x4*)(ck + (size_t)(lane * 2 + kh) * 64); const f32x4* k1 = (const f32x4*)(ck + (size_t)((lane + 64) * 2 + kh) * 64);
#pragma unroll
            for (int c = 0; c < 16; ++c) { const f32x4 q4 = *(const LAS f32x4*)(qs + 4 * c), x0 = k0[c], x1 = k1[c];
                s0 += (q4[0] * x0[0] + q4[1] * x0[1]) + (q4[2] * x0[2] + q4[3] * x0[3]); s1 += (q4[0] * x1[0] + q4[1] * x1[1]) + (q4[2] * x1[2] + q4[3] * x1[3]); } }
        const float sink2 = a.in[9][hq] * LOG2E;
        const float mref = fmaxf(fmaxf(wave_max(fmaxf(s0, s1)), s_new), sink2);
        const float p0 = __builtin_amdgcn_exp2f(s0 - mref), p1 = __builtin_amdgcn_exp2f(s1 - mref), pn = __builtin_amdgcn_exp2f(s_new - mref);
        const float l = wave_sum(p0 + p1) + pn + __builtin_amdgcn_exp2f(sink2 - mref);
        ps[lane] = p0; ps[lane + 64] = p1; LDS_WAIT();
        const int kg = lane >> 4, dc = lane & 15;
        f32x4 o = (f32x4){0.f, 0.f, 0.f, 0.f};
#pragma unroll 16
        for (int j = 0; j < 32; ++j) { const int key = 4 * j + kg; const f32x4 v = *(const f32x4*)(cv + (size_t)(key * 2 + kh) * 64 + 4 * dc); o += v * ps[key]; }
#pragma unroll
        for (int e = 0; e < 4; ++e) { o[e] += __shfl_xor(o[e], 16); o[e] += __shfl_xor(o[e], 32); }
        if (kg == 0) { const f32x4 vn4 = (f32x4){bf1(zrow[ZC_V + kh * 64 + 4 * dc]), bf1(zrow[ZC_V + kh * 64 + 4 * dc + 1]), bf1(zrow[ZC_V + kh * 64 + 4 * dc + 2]), bf1(zrow[ZC_V + kh * 64 + 4 * dc + 3])};
            const float il = 1.0f / l; const f32x4 r = (o + vn4 * pn) * il;
            u32x2 w; w.x = cvt_pk_bf16(r[0], r[1]); w.y = cvt_pk_bf16(r[2], r[3]);
            *(u32x2*)(YY + (size_t)(MP + n) * D + 512 + hq * 64 + 4 * dc) = w; }
    }
}

constexpr int PL_STRIDE = 272;
template <int W>
__device__ __forceinline__ void pool_task(const Args& a, LAS unsigned char* wl, int blk, int g, int lane) {
    const bf16_t* Z = (const bf16_t*)(a.ws + WS_Z); bf16_t* YY = (bf16_t*)(a.ws + WS_RB); const bf16_t* WM = (const bf16_t*)(a.ws + WS_MIX);
    const int r0 = 32 * blk, row = lane & 31, h = lane >> 5;
    f32x16 acc[4];
#pragma unroll
    for (int nt = 0; nt < 4; ++nt) acc[nt] = (f32x16){};
    if (r0 < MP) {
        const int t0 = r0 & (SEQ - 1), b = r0 >> 11;
#pragma unroll
        for (int it = 0; it < 12; ++it) { const int rr = 4 * it + (lane >> 4);
            if (rr < 47) { u32x4 v = (u32x4){0u, 0u, 0u, 0u};
                if (t0 > 0 || rr >= 15) v = *(const u32x4*)(Z + (size_t)(r0 - 15 + rr) * INW + 128 * g + 8 * (lane & 15));
                *(LAS u32x4*)(wl + rr * PL_STRIDE + 16 * (lane & 15)) = v; } }
        LDS_WAIT();
        const int t = t0 + row; const float rc = 1.0f / (float)min(W, t + 1);
        const bf16_t* wmp = WM + (size_t)(128 * g + row) * 128 + 8 * h;
        bf16x8 bnx[4];
#pragma unroll
        for (int nt = 0; nt < 4; ++nt) bnx[nt] = *(const bf16x8*)(wmp + (size_t)(32 * nt) * 128);
#pragma unroll 1
        for (int ks = 0; ks < 8; ++ks) {
            bf16x8 bcur[4];
#pragma unroll
            for (int nt = 0; nt < 4; ++nt) bcur[nt] = bnx[nt];
            if (ks < 7) {
#pragma unroll
                for (int nt = 0; nt < 4; ++nt) bnx[nt] = *(const bf16x8*)(wmp + (size_t)(32 * nt) * 128 + 16 * (ks + 1)); }
            const LAS unsigned char* base = wl + (15 + row) * PL_STRIDE + (16 * ks + 8 * h) * 2;
            float s[8], u[8];
            { const u32x4 x = *(const LAS u32x4*)base;
#pragma unroll
                for (int e = 0; e < 4; ++e) { u[2 * e] = bflo(x[e]); u[2 * e + 1] = bfhi(x[e]); s[2 * e] = u[2 * e]; s[2 * e + 1] = u[2 * e + 1]; } }
#pragma unroll
            for (int i = 1; i < W; ++i) { const u32x4 x = *(const LAS u32x4*)(base - i * PL_STRIDE);
#pragma unroll
                for (int e = 0; e < 4; ++e) { s[2 * e] += bflo(x[e]); s[2 * e + 1] += bfhi(x[e]); } }
            u32x4 y;
#pragma unroll
            for (int e = 0; e < 4; ++e) y[e] = cvt_pk_bf16(s[2 * e] * rc - u[2 * e], s[2 * e + 1] * rc - u[2 * e + 1]);
            const bf16x8 af = __builtin_bit_cast(bf16x8, y);
            if (t >= SEQ - 15) { float* o = a.out + O_PP + ((size_t)b * 15 + (t - (SEQ - 15))) * PW + 128 * g + 16 * ks + 8 * h;
                *(f32x4*)o = (f32x4){u[0], u[1], u[2], u[3]}; *(f32x4*)(o + 4) = (f32x4){u[4], u[5], u[6], u[7]}; }
#pragma unroll
            for (int nt = 0; nt < 4; ++nt) acc[nt] = __builtin_amdgcn_mfma_f32_32x32x16_bf16(af, bcur[nt], acc[nt], 0, 0, 0);
        }
    } else {
        const int n = r0 - MP + row; const float* sp = (const float*)(a.ws + WS_SPOOL) + (size_t)n * PW; float* po = a.out + O_PS + (size_t)n * 15 * PW; const float rc = 1.0f / (float)W;
        const int cb = 128 * g + 8 * h;
        u32x4 xn = *(const u32x4*)(Z + (size_t)(MP + n) * INW + cb); f32x4 s0n = *(const f32x4*)(sp + cb), s1n = *(const f32x4*)(sp + cb + 4);
#pragma unroll 1
        for (int ks = 0; ks < 8; ++ks) {
            const int c0 = cb + 16 * ks;
            float s[8], u[8];
            { const u32x4 x = xn; const f32x4 s0 = s0n, s1 = s1n;
                if (ks < 7) { xn = *(const u32x4*)(Z + (size_t)(MP + n) * INW + c0 + 16); s0n = *(const f32x4*)(sp + c0 + 16); s1n = *(const f32x4*)(sp + c0 + 20); }
#pragma unroll
                for (int e = 0; e < 4; ++e) { u[2 * e] = bflo(x[e]); u[2 * e + 1] = bfhi(x[e]); }
#pragma unroll
                for (int e = 0; e < 4; ++e) { s[e] = u[e] + s0[e]; s[4 + e] = u[4 + e] + s1[e]; } }
            *(f32x4*)(po + 14 * PW + c0) = (f32x4){u[0], u[1], u[2], u[3]}; *(f32x4*)(po + 14 * PW + c0 + 4) = (f32x4){u[4], u[5], u[6], u[7]};
            u32x4 y;
#pragma unroll
            for (int e = 0; e < 4; ++e) y[e] = cvt_pk_bf16(s[2 * e] * rc - u[2 * e], s[2 * e + 1] * rc - u[2 * e + 1]);
            const bf16x8 af = __builtin_bit_cast(bf16x8, y);
#pragma unroll
            for (int nt = 0; nt < 4; ++nt) { const bf16x8 bfr = *(const bf16x8*)(WM + (size_t)(128 * g + 32 * nt + row) * 128 + 16 * ks + 8 * h);
                acc[nt] = __builtin_amdgcn_mfma_f32_32x32x16_bf16(af, bfr, acc[nt], 0, 0, 0); }
        }
    }
#pragma unroll
    for (int nt = 0; nt < 4; ++nt)
#pragma unroll
        for (int r = 0; r < 16; ++r) YY[(size_t)(r0 + crow(r, h)) * D + 128 * g + 32 * nt + row] = (bf16_t)(cvt_pk_bf16(acc[nt][r], 0.f) & 0xffffu);
    LDS_WAIT();
}
__device__ __forceinline__ void pool_one(const Args& a, LAS unsigned char* wl, int blk, int g, int lane) {
    if (g == 0) pool_task<2>(a, wl, blk, 0, lane); else if (g == 1) pool_task<4>(a, wl, blk, 1, lane); else if (g == 2) pool_task<8>(a, wl, blk, 2, lane); else pool_task<16>(a, wl, blk, 3, lane);
}
__device__ __forceinline__ void roll_copies(const Args& a, int gtid, int gthreads) {
    { const f32x4* src = (const f32x4*)a.in[4]; f32x4* dst = (f32x4*)(a.out + O_PS);
        for (int i0 = gtid; i0 < NS * 1792; i0 += 2 * gthreads) { const int i1 = i0 + gthreads; const bool two = i1 < NS * 1792;
            const int n0 = i0 / 1792, j0 = i0 - n0 * 1792, n1 = two ? i1 / 1792 : 0, j1 = two ? i1 - n1 * 1792 : 0;
            const f32x4 v0 = src[(size_t)n0 * 1920 + 128 + j0], v1 = src[(size_t)n1 * 1920 + 128 + j1];
            dst[(size_t)n0 * 1920 + j0] = v0; if (two) dst[(size_t)n1 * 1920 + j1] = v1; } }
    { const f32x4* src = (const f32x4*)a.in[4]; f32x4* S4 = (f32x4*)(a.ws + WS_SPOOL);
        for (int i = gtid; i < NS * 128; i += gthreads) { const int n = i >> 7, c4 = i & 127, W = 2 << (c4 >> 5); f32x4 acc = (f32x4){0.f, 0.f, 0.f, 0.f};
#pragma unroll
            for (int k = 1; k < 16; ++k) { if (k < W) acc += src[(size_t)(n * 15 + 15 - k) * 128 + c4]; }
            S4[(size_t)n * 128 + c4] = acc; } }
    { const f32x4* sk = (const f32x4*)a.in[2]; const f32x4* sv = (const f32x4*)a.in[3]; f32x4* dk = (f32x4*)(a.out + O_KS); f32x4* dv = (f32x4*)(a.out + O_VS);
        constexpr int PER = 127 * 32;
        for (int i0 = gtid; i0 < NS * PER; i0 += 2 * gthreads) { const int i1 = i0 + gthreads; const bool two = i1 < NS * PER;
            const int n0 = i0 / PER, j0 = i0 - n0 * PER, n1 = two ? i1 / PER : 0, j1 = two ? i1 - n1 * PER : 0;
            const f32x4 k0 = sk[(size_t)n0 * 4096 + 32 + j0], k1 = sk[(size_t)n1 * 4096 + 32 + j1], v0 = sv[(size_t)n0 * 4096 + 32 + j0], v1 = sv[(size_t)n1 * 4096 + 32 + j1];
            dk[(size_t)n0 * 4096 + j0] = k0; dv[(size_t)n0 * 4096 + j0] = v0; if (two) { dk[(size_t)n1 * 4096 + j1] = k1; dv[(size_t)n1 * 4096 + j1] = v1; } } }
}

#define XB_TMO      128
#define XB_XCNT(j)  (256  + 64 * (j))
#define XB_XSUB(j)  (1280 + 64 * (j))
#define XB_XGEN(j)  (2304 + 64 * (j))
#define XB_TOP      3328
#define XB_TOPGEN   3392
#define XCD_BAR_WORDS 3456
#define XB_SPIN_CAP (1u << 18)
__device__ __forceinline__ unsigned xb_ld(unsigned* p)              { return __hip_atomic_load(p, __ATOMIC_RELAXED, __HIP_MEMORY_SCOPE_AGENT); }
__device__ __forceinline__ unsigned xb_add(unsigned* p, unsigned v) { return __hip_atomic_fetch_add(p, v, __ATOMIC_RELAXED, __HIP_MEMORY_SCOPE_AGENT); }
__device__ __forceinline__ unsigned xb_xcc_id() { return (unsigned)__builtin_amdgcn_s_getreg((3 << 11) | 20) & 0xFu; }
#define XB_SPIN(cond, bar) do { unsigned _sp = 0; while (cond) { __builtin_amdgcn_s_sleep(1); \
    if ((++_sp & 255u) == 0u) { if (xb_ld(&(bar)[XB_TMO])) break; if (_sp > XB_SPIN_CAP) { atomicAdd(&(bar)[XB_TMO], 1u); break; } } } } while (0)
struct XcdBarrier { unsigned* bar; unsigned x; volatile LAS unsigned* st; };
__device__ __forceinline__ XcdBarrier xcd_barrier_post(unsigned* bar, volatile LAS unsigned* st) {
    XcdBarrier b; b.bar = bar; b.x = xb_xcc_id(); b.st = st;
    if (threadIdx.x == 0) (void)xb_add(&bar[XB_XCNT(b.x)], 1u);
    return b;
}
__device__ __forceinline__ void xcd_barrier_complete(unsigned* bar, unsigned x, unsigned& nloc, unsigned& nx) {
    const unsigned G = gridDim.x * gridDim.y * gridDim.z;
    unsigned sum, cnt, mine, sp = 0u;
    for (;;) {
        sum = 0u; cnt = 0u; mine = 0u;
#pragma unroll
        for (unsigned j = 0; j < 16; ++j) { const unsigned c = xb_ld(&bar[XB_XCNT(j)]); sum += c; cnt += (c > 0u) ? 1u : 0u; mine = (j == x) ? c : mine; }
        if (sum == G) break;
        __builtin_amdgcn_s_sleep(1);
        if ((++sp & 255u) == 0u) { if (xb_ld(&bar[XB_TMO])) break; if (sp > XB_SPIN_CAP) { atomicAdd(&bar[XB_TMO], 1u); break; } }
    }
    nloc = mine > 0u ? mine : 1u; nx = cnt > 0u ? cnt : 1u;
}
__device__ __forceinline__ void xcd_barrier(const XcdBarrier& b) {
    asm volatile("s_waitcnt vmcnt(0)" ::: "memory");
    __syncthreads();
    if (threadIdx.x == 0) {
        unsigned* bar = b.bar;
        __builtin_amdgcn_s_waitcnt(0);
        unsigned nloc = b.st[0], nx = b.st[1];
        if (nloc == 0u) { xcd_barrier_complete(bar, b.x, nloc, nx); b.st[0] = nloc; b.st[1] = nx; }
        const unsigned old = xb_add(&bar[XB_XSUB(b.x)], 1u);
        const unsigned gen = old / nloc;
        if (old + 1u == (gen + 1u) * nloc) {
            __builtin_amdgcn_fence(__ATOMIC_RELEASE, "agent");
            asm volatile("s_waitcnt vmcnt(0)" ::: "memory");
            const unsigned og = xb_add(&bar[XB_TOP], 1u);
            const unsigned tg = og / nx;
            if (og + 1u == (tg + 1u) * nx) xb_add(&bar[XB_TOPGEN], 1u);
            else XB_SPIN(xb_ld(&bar[XB_TOPGEN]) == tg, bar);
            __builtin_amdgcn_fence(__ATOMIC_ACQUIRE, "agent");
            xb_add(&bar[XB_XGEN(b.x)], 1u);
            asm volatile("s_waitcnt vmcnt(0)" ::: "memory");
        } else {
            XB_SPIN(xb_ld(&bar[XB_XGEN(b.x)]) == gen, bar);
            __builtin_amdgcn_fence(__ATOMIC_ACQUIRE, "agent");
            asm volatile("s_waitcnt vmcnt(0)" ::: "memory");
        }
    }
    __syncthreads();
}

__global__ void __launch_bounds__(512, 2) fwd_megakernel(Args a) {
    extern __shared__ __attribute__((aligned(16))) unsigned char lds_raw[];
    LAS unsigned char* lds = (LAS unsigned char*)lds_raw;
    const int tid = threadIdx.x, lane = tid & 63, wave = __builtin_amdgcn_readfirstlane(tid >> 6);
    const int G = gridDim.x, bx = blockIdx.x;
    const int vcu = (G % 8 == 0) ? (bx % 8) * (G / 8) + bx / 8 : bx;
    unsigned char* ws = a.ws;
    bf16_t* WIN = (bf16_t*)(ws + WS_WIN); bf16_t* WMIX = (bf16_t*)(ws + WS_MIX); bf16_t* WCAT = (bf16_t*)(ws + WS_WCAT); bf16_t* WOUT = (bf16_t*)(ws + WS_WOUT);
    bf16_t* WGU = (bf16_t*)(ws + WS_WGU); bf16_t* WDN = (bf16_t*)(ws + WS_WDN);
    bf16_t* RA = (bf16_t*)(ws + WS_RA); bf16_t* RB = (bf16_t*)(ws + WS_RB); bf16_t* Z = (bf16_t*)(ws + WS_Z);
    float* SUMSQ = (float*)(ws + WS_SUMSQ);
    const int lo = a.ph_lo, hi = a.ph_hi;
    if (tid < 2) ((volatile LAS unsigned*)(lds + LDS_MISC))[tid] = 0u;
    __syncthreads();
    if (AMP_PHASE >= 0 && tid == 0) *(volatile LAS unsigned long long*)(lds + LDS_MISC + 16) = __builtin_amdgcn_s_memrealtime();
    XcdBarrier xbar = xcd_barrier_post((unsigned*)(ws + WS_BAR), (volatile LAS unsigned*)(lds + LDS_MISC));
#ifndef PH_MASK
#define PH_MASK 255
#endif
#define IN(k) (((PH_MASK >> (k)) & 1) && lo <= (k) && (k) < hi)
#ifndef DUP_MASK
#define DUP_MASK 0
#endif
#ifndef SMALL_REP
#define SMALL_REP 0
#endif
#ifndef EXTRA_SYNCS
#define EXTRA_SYNCS 0
#endif
#define REP(k) for (int rep_ = 0; rep_ < 1 + ((DUP_MASK >> (k)) & 1); ++rep_)
#define LASTREP(k) (rep_ == ((DUP_MASK >> (k)) & 1))
#define AMP(k) do { if (AMP_PHASE >= 0 && bx == 0) { volatile LAS unsigned long long* tp_ = (volatile LAS unsigned long long*)(lds + LDS_MISC + 16); const unsigned long long now_ = __builtin_amdgcn_s_memrealtime(); \
        if ((k) == AMP_PHASE || AMP_PHASE == 99) { const unsigned long long dt_ = now_ - tp_[0]; while (__builtin_amdgcn_s_memrealtime() - now_ < dt_) __builtin_amdgcn_s_sleep(8); } \
        __syncthreads(); if (tid == 0) tp_[0] = __builtin_amdgcn_s_memrealtime(); __syncthreads(); } } while (0)
#define SEAM(k) do { if (IN(k) && IN((k) + 1)) { xcd_barrier(xbar); for (int xs_ = 0; xs_ < EXTRA_SYNCS; ++xs_) xcd_barrier(xbar); AMP(k); } } while (0)

    if (IN(0)) REP(0) {
        LAS float* scr = (LAS float*)(lds + wave * 16384);
        const int gw = vcu * 8 + wave, NGW = G * 8;
        constexpr int I_IN = 16 * 104, I_MIX = 2 * 16;
        for (int it = gw; it < I_IN + I_MIX; it += NGW) {
            if (it < I_IN) transpose_item(SrcWin{a.in[6]}, WIN, D, 104, it, scr, lane);
            else transpose_item(SrcMix{a.in[10], a.in[11]}, WMIX, 128, 16, it - I_IN, scr, lane);
        }
        const float* g1 = a.in[5];
        constexpr int RPI = 4;
        for (int m0 = gw; m0 < MPAD; m0 += RPI * NGW) {
            f32x4 v[RPI][4];
#pragma unroll
            for (int q = 0; q < RPI; ++q) { const int m = m0 + q * NGW;
                if (m < MV) { const f32x4* xr = (const f32x4*)(m < MP ? a.in[0] + (size_t)m * D : a.in[1] + (size_t)(m - MP) * D) + lane;
#pragma unroll
                    for (int j = 0; j < 4; ++j) v[q][j] = __builtin_nontemporal_load(xr + 64 * j); }
                else {
#pragma unroll
                    for (int j = 0; j < 4; ++j) v[q][j] = (f32x4){0.f, 0.f, 0.f, 0.f}; } }
            f32x4 gg[4];
#pragma unroll
            for (int j = 0; j < 4; ++j) gg[j] = ((const f32x4*)g1)[lane + 64 * j];
#pragma unroll
            for (int q = 0; q < RPI; ++q) { const int m = m0 + q * NGW;
                if (m < MPAD) { float sq = 0.f;
#pragma unroll
                    for (int j = 0; j < 4; ++j) sq += (v[q][j].x * v[q][j].x + v[q][j].y * v[q][j].y) + (v[q][j].z * v[q][j].z + v[q][j].w * v[q][j].w);
                    const float rstd = __builtin_amdgcn_rsqf(wave_sum(sq) * (1.f / D) + EPS);
                    unsigned long long* o8 = (unsigned long long*)(RA + (size_t)m * D) + lane;
#pragma unroll
                    for (int j = 0; j < 4; ++j)
                        o8[64 * j] = (unsigned long long)cvt_pk_bf16(v[q][j].x * rstd * gg[j].x, v[q][j].y * rstd * gg[j].y) | ((unsigned long long)cvt_pk_bf16(v[q][j].z * rstd * gg[j].z, v[q][j].w * rstd * gg[j].w) << 32);
                    if (m >= MV) { unsigned long long* y8 = (unsigned long long*)(RB + (size_t)m * D) + lane;
#pragma unroll
                        for (int j = 0; j < 4; ++j) y8[64 * j] = 0ull; } } }
        }
        for (int i = vcu * 512 + tid; i < MPAD; i += G * 512) SUMSQ[i] = 0.f;
    }
    SEAM(0);
    if (IN(1)) {
        pg8::Gemm g{RA, WIN, D, D, D, 0, -1}; pg8::StaticOrder S; S.init(MPAD, INW, G, bx, 1 + ((DUP_MASK >> 1) & 1));
        pg8::gemm_phase(lds, g, S, pg8::EpiZ{Z});
        { const int maxper = (S.nwg + G - 1) / G, rem = S.nwg - (maxper - 1) * G; const bool all = rem >= G; const int nid = all ? G : G - rem, rk = all ? bx : bx - rem;
            if (rk >= 0) { LAS float* scr = (LAS float*)(lds + wave * 16384);
                constexpr int I_CAT = 16 * 32, I_OUT = 16 * 32, I_GU = 16 * 176, I_DN = 44 * 32;
                for (int it = rk * 8 + wave; it < I_CAT + I_OUT + I_GU + I_DN; it += nid * 8) {
                    int r = it;
                    if (r < I_CAT) { transpose_item(SrcCat{a.in[12], a.in[13]}, WCAT, D, 32, r, scr, lane); continue; } r -= I_CAT;
                    if (r < I_OUT) { transpose_item(SrcPlain{a.in[14], D}, WOUT, D, 32, r, scr, lane); continue; } r -= I_OUT;
                    if (r < I_GU) { transpose_item(SrcGU{a.in[16], a.in[17], a.in[15]}, WGU, D, 176, r, scr, lane); continue; } r -= I_GU;
                    transpose_item(SrcPlain{a.in[18], D}, WDN, FF, 32, r, scr, lane);
                }
                roll_copies(a, rk * 512 + tid, nid * 512); } }
    }
    SEAM(1);
    if (IN(2)) REP(2) {
        for (int u = vcu; u < 256; u += G) attn_prompt_unit(a, lds, u);
        if (wave < 4) { for (int su = vcu; su < 2 * NS; su += G) attn_sample_unit(a, lds, su); }
        for (int bb = 2 * vcu; bb < MP / 32; bb += 2 * G) {
            const int blk = bb + (wave & 1), g = wave < 4 ? (wave >> 1) : 2 + ((wave - 4) >> 1);
            pool_one(a, lds + wave * 16384, blk, g, lane);
        }
        if (wave == 4) { for (int lt = vcu; lt < (NS / 32) * 4; lt += G) pool_one(a, lds + wave * 16384, MP / 32 + (lt >> 2), lt & 3, lane); }
    }
    SEAM(2);
    if (IN(4)) {
        pg8::Gemm g{RB, WCAT, D, D, D, 0, 8}; pg8::StaticOrder S; S.init(MP, D, G, bx, 1 + ((DUP_MASK >> 4) & 1));
        pg8::gemm_phase(lds, g, S, pg8::EpiMerge{Z, RA});

        for (int sr_ = 0; sr_ < 1 + SMALL_REP; ++sr_) small_gemm<8>(lds, RB + (size_t)MP * D, D, WCAT, D, D, vcu, G, SEpiMerge{Z, RA});    }
    SEAM(4);
    if (IN(5)) {
        pg8::Gemm g{RA, WOUT, D, D, D, 0, -1}; pg8::StaticOrder S; S.init(MP, D, G, bx, 1 + ((DUP_MASK >> 5) & 1));
        pg8::gemm_phase(lds, g, S, pg8::EpiX1{a.in[0], a.in[1], a.out + O_Y, RB, SUMSQ});

        small_gemm<8>(lds, RA + (size_t)MP * D, D, WOUT, D, D, vcu, G, SEpiX1{a.in[1], a.out + O_Y, RB, SUMSQ});    }
    SEAM(5);
    if (IN(6)) {
        pg8::Gemm g{RB, WGU, D, D, D, 0, -1}; pg8::StaticOrder S; S.init(MPAD, 2 * FF, G, bx, 1 + ((DUP_MASK >> 6) & 1));
        pg8::gemm_phase(lds, g, S, pg8::EpiAct{SUMSQ, Z});
    }
    SEAM(6);
    if (IN(7)) {
        pg8::Gemm g{Z, WDN, FF, FF, FF, 0, -1}; pg8::StaticOrder S; S.init(MP, D, G, bx, 1 + ((DUP_MASK >> 7) & 1));
        pg8::gemm_phase(lds, g, S, pg8::EpiY{RB, a.out + O_Y});

        small_gemm<22>(lds, Z + (size_t)MP * FF, FF, WDN, FF, FF, vcu, G, SEpiY{RB, a.out + O_Y});    }
    if (AMP_PHASE == 7 || AMP_PHASE == 99) { asm volatile("s_waitcnt vmcnt(0)" ::: "memory"); __syncthreads(); AMP(7); }
#undef IN
#undef SEAM
}

#ifndef MK_N_LAUNCHES
#define MK_N_LAUNCHES 1
#endif
extern "C" void kernel_launch(void* const* d_in, const int* in_sizes, int n_in, void* d_out, int out_size, void* d_ws, size_t ws_size, hipStream_t stream) {
    static int grid = 0;
    if (grid == 0) {
        int dev = 0, cus = 0, per_cu = 0;
        if (n_in != 19 || ws_size < WS_END) { fprintf(stderr, "kernel_launch: unexpected inputs (n_in %d, ws %zu)\n", n_in, ws_size); grid = -1; return; }
        hipGetDevice(&dev); hipDeviceGetAttribute(&cus, hipDeviceAttributeMultiprocessorCount, dev);
        if (hipFuncSetAttribute((const void*)fwd_megakernel, hipFuncAttributeMaxDynamicSharedMemorySize, LDS_BYTES) != hipSuccess) { fprintf(stderr, "kernel_launch: hipFuncSetAttribute failed\n"); grid = -1; return; }
        if (hipOccupancyMaxActiveBlocksPerMultiprocessor(&per_cu, (const void*)fwd_megakernel, 512, LDS_BYTES) != hipSuccess || per_cu < 1) { fprintf(stderr, "kernel_launch: occupancy query says %d\n", per_cu); per_cu = 1; }
        (void)hipGetLastError();
        grid = cus * 1;
        if (per_cu < 1) grid = -1;
    }
    if (grid < 0) return;
    if (hipMemsetAsync((char*)d_ws + WS_BAR, 0, WS_BAR_BYTES, stream) != hipSuccess) { fprintf(stderr, "kernel_launch: memset failed\n"); return; }
    Args a{};
    for (int i = 0; i < 19; ++i) a.in[i] = (const float*)d_in[i];
    a.out = (float*)d_out; a.ws = (unsigned char*)d_ws;
#if MK_N_LAUNCHES == 1
    a.ph_lo = 0; a.ph_hi = 8;
    hipLaunchKernelGGL(fwd_megakernel, dim3(grid), dim3(512), LDS_BYTES, stream, a);
    if (hipPeekAtLastError() != hipSuccess) fprintf(stderr, "kernel_launch: launch failed (grid %d)\n", grid);
#else
    for (int p = 0; p < 8; ++p) { a.ph_lo = p; a.ph_hi = p + 1; hipLaunchKernelGGL(fwd_megakernel, dim3(grid), dim3(512), LDS_BYTES, stream, a); }
#endif
}
```
